# Optimizing an MI355X kernel written in HIP

```python
import jax, jax.numpy as jnp
from jax import lax
import numpy as np

D_MODEL = 2048
BATCH = 8
SEQ = 2048
DEPTH = 2

CHUNK = 64
N_MIXERS = 2
N_LAYERS_A = (DEPTH + 1) // 2
N_LAYERS_B = DEPTH // 2
D_FF = 4 * D_MODEL
EPS = 1e-6

A_HEADS = 16
A_NOPE = 128
A_ROPE = 64
A_V = D_MODEL // A_HEADS
A_Q_RANK = D_MODEL // 4
A_KV_RANK = D_MODEL // 8
IDX_HEADS = 16
IDX_DIM = 64
IDX_ROPE = 32
TOPK_MAX = 256
Q_BLOCK = 128
ROPE_BASE = 10000.0
A_SCALE = (A_NOPE + A_ROPE) ** -0.5
A_SPLITS = [A_Q_RANK, A_Q_RANK + A_KV_RANK, A_Q_RANK + A_KV_RANK + A_ROPE,
            A_Q_RANK + A_KV_RANK + A_ROPE + IDX_DIM]
A_IN = A_Q_RANK + A_KV_RANK + A_ROPE + IDX_DIM + IDX_HEADS

R_HEAD = 64
R_HEADS = D_MODEL // R_HEAD
R_DECAY_LORA = 96
R_AAA_LORA = 96
R_GATE_LORA = 256
R_GN_EPS = R_HEAD * 1e-5

kernel_name = "hybrid_dsa_rwkv7_adaln_trunk"


def rms_norm(x):
    xf = x.astype(jnp.float32)
    return (xf * lax.rsqrt(jnp.mean(xf * xf, axis=-1, keepdims=True) + EPS)).astype(x.dtype)


def layer_norm(x, eps):
    xf = x.astype(jnp.float32)
    mu = jnp.mean(xf, axis=-1, keepdims=True)
    var = jnp.mean(jnp.square(xf - mu), axis=-1, keepdims=True)
    return ((xf - mu) * lax.rsqrt(var + eps)).astype(x.dtype)


def rope_angles(positions, dim):
    inv = 1.0 / (ROPE_BASE ** (jnp.arange(0, dim, 2, dtype=jnp.float32) / dim))
    ang = positions.astype(jnp.float32)[..., None] * inv
    return jnp.cos(ang), jnp.sin(ang)


def apply_rope(x, cos, sin):
    x1, x2 = jnp.split(x, 2, axis=-1)
    c = cos[:, :, None, :].astype(x.dtype)
    s = sin[:, :, None, :].astype(x.dtype)
    return jnp.concatenate([x1 * c - x2 * s, x2 * c + x1 * s], axis=-1)


def dsa_mixer(h, cos_a, sin_a, cos_i, sin_i, w_in, q_norm_g, kv_norm_g, w_uq, w_qidx,
              kidx_ln_g, kidx_ln_b, w_uk, w_uv, w_o):
    B, S, _ = h.shape
    topk = min(TOPK_MAX, S // 4)
    proj = h @ w_in
    c_q, c_kv, k_rope, k_idx, w_idx = jnp.split(proj, A_SPLITS, axis=-1)
    c_q = rms_norm(c_q) * q_norm_g
    c_kv = rms_norm(c_kv) * kv_norm_g
    q = (c_q @ w_uq).reshape(B, S, A_HEADS, A_NOPE + A_ROPE)
    q_nope = q[..., :A_NOPE]
    q_rope = apply_rope(q[..., A_NOPE:], cos_a, sin_a)
    k_rope = apply_rope(k_rope[:, :, None, :], cos_a, sin_a)[:, :, 0, :]
    keys = jnp.concatenate([c_kv, k_rope], axis=-1)
    q_idx = (c_q @ w_qidx).reshape(B, S, IDX_HEADS, IDX_DIM)
    q_idx = jnp.concatenate([apply_rope(q_idx[..., :IDX_ROPE], cos_i, sin_i), q_idx[..., IDX_ROPE:]], axis=-1)
    k_idx = layer_norm(k_idx, EPS) * kidx_ln_g + kidx_ln_b
    k_idx = jnp.concatenate([apply_rope(k_idx[:, :, None, :IDX_ROPE], cos_i, sin_i)[:, :, 0, :],
                             k_idx[..., IDX_ROPE:]], axis=-1)
    w_idx = w_idx * (IDX_HEADS ** -0.5 * IDX_DIM ** -0.5)

    nb = S // Q_BLOCK

    def to_blocks(t):
        return jnp.moveaxis(t.reshape((B, nb, Q_BLOCK) + t.shape[2:]), 1, 0)

    def block(args):
        bi, qn, qr, qi, wi = args
        t = bi * Q_BLOCK + jnp.arange(Q_BLOCK)
        q_chunk = t // CHUNK
        allowed = (jnp.arange(S)[None, :] // CHUNK) <= q_chunk[:, None]
        rel = jax.nn.relu(jnp.einsum('bqhd,bsd->bqhs', qi, k_idx))
        score = jnp.einsum('bqhs,bqh->bqs', rel, wi).astype(jnp.float32)
        score = jnp.where(allowed[None], score, -jnp.inf)
        _, idx = lax.top_k(score, topk)
        valid = (idx // CHUNK) <= q_chunk[None, :, None]
        sel = jax.vmap(lambda kb, ib: kb[ib])(keys, idx)
        c_sel = sel[..., :A_KV_RANK]
        kr_sel = sel[..., A_KV_RANK:]
        q_lat = jnp.einsum('bqhd,rhd->bqhr', qn, w_uk)
        logits = (jnp.einsum('bqhr,bqkr->bqhk', q_lat, c_sel)
                  + jnp.einsum('bqhd,bqkd->bqhk', qr, kr_sel)).astype(jnp.float32) * A_SCALE
        logits = jnp.where(valid[:, :, None, :], logits, -jnp.inf)
        p = jax.nn.softmax(logits, axis=-1).astype(h.dtype)
        o_lat = jnp.einsum('bqhk,bqkr->bqhr', p, c_sel)
        o = jnp.einsum('bqhr,rhd->bqhd', o_lat, w_uv)
        return o.reshape(B, Q_BLOCK, A_HEADS * A_V)

    out = lax.map(block, (jnp.arange(nb), to_blocks(q_nope), to_blocks(q_rope),
                          to_blocks(q_idx), to_blocks(w_idx)))
    out = jnp.moveaxis(out, 0, 1).reshape(B, S, A_HEADS * A_V)
    return out @ w_o


def rwkv7_mixer(h, mu, w_r, w_k, w_v, w_o, w0, w_w1, w_w2, a0, w_a1, w_a2, w_g1, w_g2,
                k_k, k_a, r_k, gn_g, gn_b):
    B, S, D = h.shape
    h_prev = jnp.pad(h, ((0, 0), (1, 0), (0, 0)))[:, :-1]
    delta = h_prev - h
    xr = h + delta * mu[0]
    xw = h + delta * mu[1]
    xk = h + delta * mu[2]
    xv = h + delta * mu[3]
    xa = h + delta * mu[4]
    xg = h + delta * mu[5]
    r = xr @ w_r
    k = xk @ w_k
    v = xv @ w_v
    w_log = -jax.nn.softplus(-(w0 + jnp.tanh(xw @ w_w1) @ w_w2)) - 0.5
    decay = jnp.exp(-jnp.exp(w_log.astype(jnp.float32)))
    a = jax.nn.sigmoid(a0 + (xa @ w_a1) @ w_a2)
    g = jax.nn.sigmoid(xg @ w_g1) @ w_g2

    def heads(t):
        return t.reshape(B, S, R_HEADS, R_HEAD)

    kk = heads(k * k_k).astype(jnp.float32)
    kk = kk / jnp.maximum(jnp.sqrt(jnp.sum(kk * kk, axis=-1, keepdims=True)), 1e-12)
    k = k * (1 + (a - 1) * k_a)
    rh, kh, vh, ah, dh = heads(r), heads(k), heads(v), heads(a), heads(decay)

    def step(state, inp):
        r_t, k_t, v_t, w_t, kk_t, a_t = inp
        sa = jnp.einsum('bhij,bhj->bhi', state, -kk_t)
        state = (state * w_t[:, :, None, :] + sa[..., None] * (kk_t * a_t)[:, :, None, :]
                 + v_t[..., None] * k_t[:, :, None, :])
        return state, jnp.einsum('bhij,bhj->bhi', state, r_t)

    def seq_first(t):
        return jnp.moveaxis(t.astype(jnp.float32), 1, 0)

    state0 = jnp.zeros((B, R_HEADS, R_HEAD, R_HEAD), jnp.float32)
    _, o = lax.scan(step, state0, (seq_first(rh), seq_first(kh), seq_first(vh),
                                   seq_first(dh), seq_first(kk), seq_first(ah)))
    o = jnp.moveaxis(o, 0, 1)
    o = layer_norm(o, R_GN_EPS).reshape(B, S, D).astype(h.dtype) * gn_g + gn_b
    bonus = jnp.sum(rh * kh * r_k, axis=-1, keepdims=True) * vh
    o = o + bonus.reshape(B, S, D)
    return (o * g) @ w_o


def setup_inputs(seed: int = 0) -> dict:
    key = jax.random.key(seed)
    ks = iter(jax.random.split(key, 48))

    def nrm(shape, scale):
        return jax.random.normal(next(ks), shape, jnp.float32) * scale

    def gain(shape):
        return 1.0 + nrm(shape, 0.02)

    NA, NB, D = N_LAYERS_A, N_LAYERS_B, D_MODEL
    start = jax.random.randint(next(ks), (BATCH, 1), 0, 1024, dtype=jnp.int32)
    positions = start + jnp.arange(SEQ, dtype=jnp.int32)[None, :]
    return {
        "x": nrm((BATCH, SEQ, D), 1.0),
        "c": nrm((BATCH, D), 1.0),
        "positions": positions,
        "ada_w": nrm((DEPTH, D, 6 * D), 0.5 * D ** -0.5),
        "ada_b": nrm((DEPTH, 6 * D), 0.02),
        "mlp_w1": nrm((DEPTH, D, D_FF), D ** -0.5),
        "mlp_w2": nrm((DEPTH, D_FF, D), D_FF ** -0.5),
        "final_g": gain((D,)),
        "a_w_in": nrm((NA, D, A_IN), D ** -0.5),
        "a_q_norm_g": gain((NA, A_Q_RANK)),
        "a_kv_norm_g": gain((NA, A_KV_RANK)),
        "a_w_uq": nrm((NA, A_Q_RANK, A_HEADS * (A_NOPE + A_ROPE)), A_Q_RANK ** -0.5),
        "a_w_qidx": nrm((NA, A_Q_RANK, IDX_HEADS * IDX_DIM), A_Q_RANK ** -0.5),
        "a_kidx_ln_g": gain((NA, IDX_DIM)),
        "a_kidx_ln_b": nrm((NA, IDX_DIM), 0.02),
        "a_w_uk": nrm((NA, A_KV_RANK, A_HEADS, A_NOPE), A_KV_RANK ** -0.5),
        "a_w_uv": nrm((NA, A_KV_RANK, A_HEADS, A_V), A_KV_RANK ** -0.5),
        "a_w_o": nrm((NA, A_HEADS * A_V, D), (A_HEADS * A_V) ** -0.5),
        "b_mu": jax.random.uniform(next(ks), (NB, 6, D), jnp.float32),
        "b_w_r": nrm((NB, D, D), D ** -0.5),
        "b_w_k": nrm((NB, D, D), D ** -0.5),
        "b_w_v": nrm((NB, D, D), D ** -0.5),
        "b_w_o": nrm((NB, D, D), D ** -0.5),
        "b_w0": nrm((NB, D), 1.0) - 0.5,
        "b_w_w1": nrm((NB, D, R_DECAY_LORA), D ** -0.5),
        "b_w_w2": nrm((NB, R_DECAY_LORA, D), 0.5 * R_DECAY_LORA ** -0.5),
        "b_a0": nrm((NB, D), 0.5),
        "b_w_a1": nrm((NB, D, R_AAA_LORA), D ** -0.5),
        "b_w_a2": nrm((NB, R_AAA_LORA, D), 0.5 * R_AAA_LORA ** -0.5),
        "b_w_g1": nrm((NB, D, R_GATE_LORA), D ** -0.5),
        "b_w_g2": nrm((NB, R_GATE_LORA, D), R_GATE_LORA ** -0.5),
        "b_k_k": 0.85 + nrm((NB, D), 0.05),
        "b_k_a": 1.0 + nrm((NB, D), 0.05),
        "b_r_k": nrm((NB, R_HEADS, R_HEAD), 0.1),
        "b_gn_g": gain((NB, D)),
        "b_gn_b": nrm((NB, D), 0.02),
    }


def reference(x, c, positions, ada_w, ada_b, mlp_w1, mlp_w2, final_g,
              a_w_in, a_q_norm_g, a_kv_norm_g, a_w_uq, a_w_qidx, a_kidx_ln_g, a_kidx_ln_b,
              a_w_uk, a_w_uv, a_w_o,
              b_mu, b_w_r, b_w_k, b_w_v, b_w_o, b_w0, b_w_w1, b_w_w2, b_a0, b_w_a1, b_w_a2,
              b_w_g1, b_w_g2, b_k_k, b_k_a, b_r_k, b_gn_g, b_gn_b):
    cos_a, sin_a = rope_angles(positions, A_ROPE)
    cos_i, sin_i = rope_angles(positions, IDX_ROPE)
    c_act = jax.nn.silu(c)
    for i in range(DEPTH):
        mod = c_act @ ada_w[i] + ada_b[i]
        sh1, sc1, g1, sh2, sc2, g2 = [m[:, None, :] for m in jnp.split(mod, 6, axis=-1)]
        hmix = rms_norm(x) * (1 + sc1) + sh1
        j = i // N_MIXERS
        if i % N_MIXERS == 0:
            y = dsa_mixer(hmix, cos_a, sin_a, cos_i, sin_i, a_w_in[j], a_q_norm_g[j], a_kv_norm_g[j],
                          a_w_uq[j], a_w_qidx[j], a_kidx_ln_g[j], a_kidx_ln_b[j],
                          a_w_uk[j], a_w_uv[j], a_w_o[j])
        else:
            y = rwkv7_mixer(hmix, b_mu[j], b_w_r[j], b_w_k[j], b_w_v[j], b_w_o[j], b_w0[j],
                            b_w_w1[j], b_w_w2[j], b_a0[j], b_w_a1[j], b_w_a2[j], b_w_g1[j], b_w_g2[j],
                            b_k_k[j], b_k_a[j], b_r_k[j], b_gn_g[j], b_gn_b[j])
        x = x + g1 * y
        hff = rms_norm(x) * (1 + sc2) + sh2
        x = x + g2 * (jnp.square(jax.nn.relu(hff @ mlp_w1[i])) @ mlp_w2[i])
    return rms_norm(x) * final_g
```

```cpp
#include <hip/hip_runtime.h>
#include <hip/hip_cooperative_groups.h>
#include <cstdio>
#include <cstdint>
namespace cg = cooperative_groups;

#define LAS __attribute__((address_space(3)))
typedef unsigned short bf16_t;
typedef short bf16x8 __attribute__((ext_vector_type(8)));
typedef short s16x4 __attribute__((ext_vector_type(4)));
typedef float f32x4 __attribute__((ext_vector_type(4)));
typedef float f32x16 __attribute__((ext_vector_type(16)));
typedef unsigned u32x4 __attribute__((ext_vector_type(4)));
typedef unsigned u32x2 __attribute__((ext_vector_type(2)));

constexpr int T_ = 16384, D_ = 2048, S_ = 2048, FF_ = 8192;
constexpr size_t MiB = 1048576;
constexpr size_t WS_MOD = 0, WS_COSA = 1 * MiB, WS_SINA = 3 * MiB, WS_COSI = 5 * MiB, WS_SINI = 6 * MiB, WS_CNT = 7 * MiB;
constexpr size_t WS_X = 8 * MiB;
constexpr size_t WS_WT_RKV = 136 * MiB, WS_WT_L2 = 163 * MiB, WS_WT_BO = 166 * MiB;
constexpr size_t WS_WT_IN = 174 * MiB, WS_WT_Q = 178 * MiB, WS_WT_UK = 182 * MiB, WS_WT_UV = 184 * MiB, WS_WT_O = 186 * MiB, WS_WT_1_0 = 194 * MiB, WS_WT_2_0 = 226 * MiB;
constexpr size_t WS_HMIX = 258 * MiB, WS_PROJ = 322 * MiB, WS_SCORES = 258 * MiB, WS_OLAT = 258 * MiB, WS_QALL = 386 * MiB, WS_O = 386 * MiB, WS_QLAT = 514 * MiB;
constexpr size_t WS_CQ = 642 * MiB, WS_KEYS = 658 * MiB, WS_KIDX = 668 * MiB, WS_WIDX = 670 * MiB, WS_SEL = 671 * MiB;
constexpr size_t WS_HFF = 258 * MiB, WS_H1 = 322 * MiB;
constexpr size_t WS_MIX = 258 * MiB;
constexpr size_t WS_KBUF = 174 * MiB, WS_VBUF = 642 * MiB, WS_MID = 706 * MiB;
constexpr size_t WS_RBUF = 322 * MiB, WS_WDEC = 450 * MiB, WS_ABUF = 578 * MiB, WS_GBUF = 386 * MiB, WS_SCANOUT = 258 * MiB;
constexpr size_t WS_WT_1_1 = 578 * MiB, WS_WT_2_1 = 610 * MiB;
constexpr int LDS_BYTES = 147520;

struct Params { const float* in[36]; float* out; unsigned char* ws; };

__device__ __forceinline__ bf16_t f2bf(float f) { unsigned u = __float_as_uint(f); u += 0x7FFFu + ((u >> 16) & 1u); return (bf16_t)(u >> 16); }
__device__ __forceinline__ float bf2f(unsigned b) { return __uint_as_float(b << 16); }
__device__ __forceinline__ unsigned cvt_pk_bf16(float lo, float hi) { unsigned r; asm volatile("v_cvt_pk_bf16_f32 %0, %1, %2" : "=v"(r) : "v"(lo), "v"(hi)); return r; }
__device__ __forceinline__ float dpp_f(float x, const int ctrl_sel) {
    const int v = __builtin_bit_cast(int, x); int r;
    if (ctrl_sel == 0) r = __builtin_amdgcn_update_dpp(0, v, 0xB1, 0xF, 0xF, true);
    else if (ctrl_sel == 1) r = __builtin_amdgcn_update_dpp(0, v, 0x4E, 0xF, 0xF, true);
    else if (ctrl_sel == 2) r = __builtin_amdgcn_update_dpp(0, v, 0x141, 0xF, 0xF, true);
    else r = __builtin_amdgcn_update_dpp(0, v, 0x140, 0xF, 0xF, true);
    return __builtin_bit_cast(float, r);
}
__device__ __forceinline__ int otid() { int t = threadIdx.x; asm volatile("" : "+v"(t)); return t; }
__device__ __forceinline__ int obid() { int t = blockIdx.x; asm volatile("" : "+s"(t)); return t; }
__device__ __forceinline__ int ogrid() { int t = gridDim.x; asm volatile("" : "+s"(t)); return t; }
constexpr size_t WS_BAR = 7 * MiB + 512 * 1024;
__device__ __forceinline__ void fast_sync(unsigned* ctr, unsigned& target, unsigned nblk) {
    target += nblk;
    asm volatile("s_waitcnt vmcnt(0) lgkmcnt(0)" ::: "memory");
    __syncthreads();
    if (threadIdx.x == 0) {
        __builtin_amdgcn_fence(__ATOMIC_RELEASE, "agent");
        asm volatile("s_waitcnt vmcnt(0)" ::: "memory");
        __hip_atomic_fetch_add(ctr, 1u, __ATOMIC_RELAXED, __HIP_MEMORY_SCOPE_AGENT);
        while (__hip_atomic_load(ctr, __ATOMIC_RELAXED, __HIP_MEMORY_SCOPE_AGENT) < target) __builtin_amdgcn_s_sleep(2);
        __builtin_amdgcn_fence(__ATOMIC_ACQUIRE, "agent");
        asm volatile("s_waitcnt vmcnt(0)" ::: "memory");
    }
    __syncthreads();
}

#define XB_TMO      128
#define XB_XCNT(j)  (256  + 64 * (j))
#define XB_XSUB(j)  (1280 + 64 * (j))
#define XB_XGEN(j)  (2304 + 64 * (j))
#define XB_TOP      3328
#define XB_TOPGEN   3392
#define XCD_BAR_WORDS 3456
#define XB_SPIN_CAP (1u << 22)
__device__ __forceinline__ unsigned xb_ld(unsigned* p)              { return __hip_atomic_load(p, __ATOMIC_RELAXED, __HIP_MEMORY_SCOPE_AGENT); }
__device__ __forceinline__ unsigned xb_add(unsigned* p, unsigned v) { return __hip_atomic_fetch_add(p, v, __ATOMIC_RELAXED, __HIP_MEMORY_SCOPE_AGENT); }
__device__ __forceinline__ unsigned xb_xcc_id() { return (unsigned)__builtin_amdgcn_s_getreg((3 << 11) | 20) & 0xFu; }
#define XB_SPIN(cond, bar) do { unsigned _sp = 0; while (cond) { __builtin_amdgcn_s_sleep(1); \
    if ((++_sp & 255u) == 0u) { if (xb_ld(&(bar)[XB_TMO])) break; if (_sp > XB_SPIN_CAP) { atomicAdd(&(bar)[XB_TMO], 1u); break; } } } } while (0)
struct XcdBarrier { unsigned* bar; unsigned x; volatile LAS unsigned* st; };
__device__ __forceinline__ XcdBarrier xcd_barrier_post(unsigned* bar, volatile LAS unsigned* st) {
    XcdBarrier b; b.bar = bar; b.x = xb_xcc_id(); b.st = st;
    if (threadIdx.x == 0) { const unsigned rank = xb_add(&bar[XB_XCNT(b.x)], 1u); st[2] = rank; st[3] = b.x; }
    return b;
}
__device__ __forceinline__ void xcd_barrier_complete(unsigned* bar, unsigned x, unsigned& nloc, unsigned& nx, bool& uniform32) {
    const unsigned G = gridDim.x * gridDim.y * gridDim.z;
    unsigned sum, cnt, mine, sp = 0u;
    for (;;) {
        sum = 0u; cnt = 0u; mine = 0u;
        unsigned cc[16];
#pragma unroll
        for (unsigned j = 0; j < 16; ++j) cc[j] = xb_ld(&bar[XB_XCNT(j)]);
        uniform32 = true;
#pragma unroll
        for (unsigned j = 0; j < 16; ++j) { const unsigned c = cc[j]; sum += c; cnt += (c > 0u) ? 1u : 0u; mine = (j == x) ? c : mine; uniform32 = uniform32 && (c == (j < 8 ? 32u : 0u)); }
        if (sum == G) break;
        __builtin_amdgcn_s_sleep(1);
        if ((++sp & 255u) == 0u) { if (xb_ld(&bar[XB_TMO])) break; if (sp > XB_SPIN_CAP) { atomicAdd(&bar[XB_TMO], 1u); break; } }
    }
    nloc = mine > 0u ? mine : 1u; nx = cnt > 0u ? cnt : 1u;
}
__device__ __forceinline__ void xcd_barrier(const XcdBarrier& b) {
    asm volatile("s_waitcnt vmcnt(0)" ::: "memory");
    __syncthreads();
    if (threadIdx.x == 0) {
        unsigned* bar = b.bar;
        __builtin_amdgcn_s_waitcnt(0);
        unsigned nloc = b.st[0], nx = b.st[1];
        if (nloc == 0u) { bool uni; xcd_barrier_complete(bar, b.x, nloc, nx, uni); b.st[0] = nloc; b.st[1] = nx; if (!uni || gridDim.x != 256) b.st[2] = 0xFFFFFFFFu; }
        const unsigned old = xb_add(&bar[XB_XSUB(b.x)], 1u);
        const unsigned gen = old / nloc;
        if (old + 1u == (gen + 1u) * nloc) {
            __builtin_amdgcn_fence(__ATOMIC_RELEASE, "agent");
            asm volatile("s_waitcnt vmcnt(0)" ::: "memory");
            const unsigned og = xb_add(&bar[XB_TOP], 1u);
            const unsigned tg = og / nx;
            if (og + 1u == (tg + 1u) * nx) xb_add(&bar[XB_TOPGEN], 1u);
            else XB_SPIN(xb_ld(&bar[XB_TOPGEN]) == tg, bar);
            __builtin_amdgcn_fence(__ATOMIC_ACQUIRE, "agent");
            xb_add(&bar[XB_XGEN(b.x)], 1u);
            asm volatile("s_waitcnt vmcnt(0)" ::: "memory");
        } else {
            XB_SPIN(xb_ld(&bar[XB_XGEN(b.x)]) == gen, bar);
            __builtin_amdgcn_fence(__ATOMIC_ACQUIRE, "agent");
            asm volatile("s_waitcnt vmcnt(0)" ::: "memory");
        }
    }
    __syncthreads();
}
__device__ __forceinline__ float red8(float x) { x += dpp_f(x, 0); x += dpp_f(x, 1); x += dpp_f(x, 2); return x; }
__device__ __forceinline__ float red16(float x) { x = red8(x); x += dpp_f(x, 3); return x; }
__device__ __forceinline__ float red64(float x) { x = red16(x); x += __shfl_xor(x, 16); x += __shfl_xor(x, 32); return x; }

namespace pg8 {
constexpr int BM = 256, BK = 64, HALF = 128, HTB = HALF * BK * 2, STAGE_BYTES = 8 * HTB, NXCD = 8, WGM = 8;
__device__ __forceinline__ int lds_byte(int r, int c) { const int st = (r >> 4) * 2 + (c >> 5), rr = r & 15, cc = c & 31, ob = rr * 64 + cc * 2; return st * 1024 + (ob ^ (((ob >> 9) & 1) << 5)); }
__device__ __forceinline__ void stage_rc(int b, int& R, int& C) { const int st = b / 1024, sb = b % 1024, swz = sb ^ (((sb >> 9) & 1) << 5); R = (st >> 1) * 16 + swz / 64; C = (st & 1) * 32 + (swz % 64) / 2; }
__device__ __forceinline__ int perm32(int rho) { const int n = rho >> 4, i = rho & 15; return 8 * (i >> 2) + 4 * n + (i & 3); }
struct Unit { int pm, pn; };
struct Gemm { const bf16_t* A; const bf16_t* Bt; int M, N, K, lda, ldb, amode; };
__device__ __forceinline__ size_t a_off_bytes(const Gemm& g, int pn) {
    switch (g.amode) {
        case 1: return (size_t)(pn >> 1) * 256 * 2;
        case 2: return (size_t)pn * 512 * 2;
        case 3: return (size_t)(pn < 16 ? (pn >> 3) : (pn - 14)) * ((size_t)T_ * D_ * 2);
        case 4: return (size_t)(pn >> 3) * ((size_t)T_ * 256 * 2);
        default: return 0;
    }
}
struct StaticOrder {
    int nM, nN, nwg, G, c;
    __device__ void init(int M, int N, int G_, int c_) { nM = M / BM; nN = N / BM; nwg = nM * nN; G = G_; c = c_; }
    __device__ bool next(int i, Unit& u) const {
        const long L = (long)i * G + c; if (L >= nwg) return false;
        int wgid = (int)L; { const int q = nwg / NXCD, r = nwg % NXCD, xcd = wgid % NXCD, off = wgid / NXCD; wgid = (xcd < r ? xcd * (q + 1) : r * (q + 1) + (xcd - r) * q) + off; }
        const int nig = WGM * nN, gid = wgid / nig, fm = gid * WGM, gsz = (nM - fm) < WGM ? (nM - fm) : WGM;
        u.pm = fm + ((wgid % nig) % gsz); u.pn = (wgid % nig) / gsz; return true;
    }
};

template <class Epi>
__device__ __forceinline__ void gemm_phase(LAS unsigned char* lds, const Gemm g, const StaticOrder& S, const Epi& E) {
    const int tid = otid(), wid = __builtin_amdgcn_readfirstlane(tid >> 6), lane = tid & 63, wr = wid >> 2, wc = wid & 3, fr = lane & 15, fq = lane >> 4;
    const int K = g.K, nt = K / BK;
    unsigned voffA[2], voffB[2];
#pragma unroll
    for (int i = 0; i < 2; ++i) { int R, C; stage_rc(tid * 16 + i * 8192, R, C); const int Rb = (R & ~31) + perm32(R & 31);
        voffA[i] = (unsigned)(R * g.lda + C) * 2u; voffB[i] = (unsigned)(Rb * g.ldb + C) * 2u; }
    const size_t kstep = (size_t)(BK * 2);
    const size_t hstepA = (size_t)HALF * g.lda * 2, hstepB = (size_t)HALF * g.ldb * 2;
    const size_t tstepA = 2 * hstepA, tstepB = 2 * hstepB;
    const unsigned ldsw = (unsigned)wid * 1024u;
    const int aoff = lds_byte(wr * 64 + fr, fq * 8), boff = lds_byte(wc * 32 + fr, fq * 8);
#define PG8_SA(b, h) (((b) * 2 + (h)) * HTB)
#define PG8_SB(b, h) ((4 + (b) * 2 + (h)) * HTB)
#define PG8_STAGE(bufoff, gbase, voff) do { _Pragma("unroll") for (int _i = 0; _i < 2; ++_i) \
        __builtin_amdgcn_global_load_lds((const unsigned*)((const char*)(gbase) + (voff)[_i]), (LAS unsigned*)(lds + (bufoff) + ldsw + _i * 8192), 16, 0, 0); } while (0)
#define PG8_LDA(dst, b, h) do { _Pragma("unroll") for (int m = 0; m < 4; ++m) _Pragma("unroll") for (int k = 0; k < 2; ++k) dst[m][k] = *(const LAS bf16x8*)(lds + PG8_SA(b, h) + aoff + m * 2048 + k * 1024); } while (0)
#define PG8_LDB(dst, b, h) do { _Pragma("unroll") for (int n = 0; n < 2; ++n) _Pragma("unroll") for (int k = 0; k < 2; ++k) dst[n][k] = *(const LAS bf16x8*)(lds + PG8_SB(b, h) + boff + n * 2048 + k * 1024); } while (0)
#define PG8_MMA(ai, bj, At, Bt) do { __builtin_amdgcn_s_setprio(1); _Pragma("unroll") for (int m = 0; m < 4; ++m) _Pragma("unroll") for (int n = 0; n < 2; ++n) _Pragma("unroll") for (int k = 0; k < 2; ++k) \
        acc[ai][bj][m][n] = __builtin_amdgcn_mfma_f32_16x16x32_bf16(Bt[n][k], At[m][k], acc[ai][bj][m][n], 0, 0, 0); __builtin_amdgcn_s_setprio(0); } while (0)
#define PG8_WAIT_V(n) asm volatile("s_waitcnt vmcnt(" #n ")" ::: "memory")
#define PG8_WAIT_L(n) asm volatile("s_waitcnt lgkmcnt(" #n ")" ::: "memory")
#define PG8_BAR __builtin_amdgcn_s_barrier()
#define PG8_SCHED __builtin_amdgcn_sched_barrier(0)
    Unit cur, nxt; int ui = 0;
    if (!S.next(0, cur)) return;
    f32x4 acc[2][2][4][2];
#pragma unroll
    for (int a = 0; a < 2; ++a)
#pragma unroll
        for (int b = 0; b < 2; ++b)
#pragma unroll
            for (int m = 0; m < 4; ++m)
#pragma unroll
                for (int n = 0; n < 2; ++n) acc[a][b][m][n] = (f32x4){0.f, 0.f, 0.f, 0.f};
    bf16x8 At[4][2], B0[2][2], B1[2][2];
    const char* cA = (const char*)g.A + (size_t)cur.pm * tstepA + a_off_bytes(g, cur.pn); const char* cB = (const char*)g.Bt + (size_t)cur.pn * tstepB;
    PG8_STAGE(PG8_SB(0, 0), cB, voffB); PG8_STAGE(PG8_SA(0, 0), cA, voffA); PG8_STAGE(PG8_SB(0, 1), cB + hstepB, voffB); PG8_STAGE(PG8_SA(0, 1), cA + hstepA, voffA);
    if (wr == 1) PG8_BAR;
    PG8_WAIT_V(4); PG8_BAR;
    PG8_STAGE(PG8_SB(1, 0), cB + kstep, voffB); PG8_STAGE(PG8_SA(1, 0), cA + kstep, voffA); PG8_STAGE(PG8_SB(1, 1), cB + hstepB + kstep, voffB);
    PG8_WAIT_V(6); PG8_BAR;
    for (;;) {
        const bool has_next = S.next(ui + 1, nxt);
        const char* nA = has_next ? (const char*)g.A + (size_t)nxt.pm * tstepA + a_off_bytes(g, nxt.pn) : cA; const char* nB = has_next ? (const char*)g.Bt + (size_t)nxt.pn * tstepB : cB;
        for (int t = 0; t < nt; t += 2) {
            const bool last = (t == nt - 2);
            const char* a1 = cA + (size_t)(t + 1) * kstep;
            const char* a2 = last ? nA : cA + (size_t)(t + 2) * kstep; const char* b2 = last ? nB : cB + (size_t)(t + 2) * kstep;
            const char* a3 = a2 + kstep; const char* b3 = b2 + kstep;
            PG8_LDB(B0, 0, 0); PG8_SCHED; PG8_LDA(At, 0, 0); PG8_STAGE(PG8_SA(1, 1), a1 + hstepA, voffA);
            PG8_WAIT_L(8); PG8_BAR; PG8_WAIT_L(0); PG8_MMA(0, 0, At, B0); PG8_BAR; PG8_SCHED;
            PG8_LDB(B1, 0, 1); PG8_STAGE(PG8_SB(0, 0), b2, voffB);
            PG8_BAR; PG8_WAIT_L(0); PG8_MMA(0, 1, At, B1); PG8_BAR;
            PG8_LDA(At, 0, 1); PG8_STAGE(PG8_SA(0, 0), a2, voffA);
            PG8_BAR; PG8_WAIT_L(0); PG8_MMA(1, 0, At, B0); PG8_BAR; PG8_SCHED;
            PG8_STAGE(PG8_SB(0, 1), b2 + hstepB, voffB);
            PG8_WAIT_V(6); PG8_BAR; PG8_MMA(1, 1, At, B1); PG8_BAR;
            PG8_LDB(B0, 1, 0); PG8_SCHED; PG8_LDA(At, 1, 0); PG8_STAGE(PG8_SA(0, 1), a2 + hstepA, voffA);
            PG8_WAIT_L(8); PG8_BAR; PG8_WAIT_L(0); PG8_MMA(0, 0, At, B0); PG8_BAR; PG8_SCHED;
            PG8_LDB(B1, 1, 1); PG8_STAGE(PG8_SB(1, 0), b3, voffB);
            PG8_BAR; PG8_WAIT_L(0); PG8_MMA(0, 1, At, B1); PG8_BAR;
            PG8_LDA(At, 1, 1); PG8_STAGE(PG8_SA(1, 0), a3, voffA);
            PG8_BAR; PG8_WAIT_L(0); PG8_MMA(1, 0, At, B0); PG8_BAR; PG8_SCHED;
            PG8_STAGE(PG8_SB(1, 1), b3 + hstepB, voffB);
            PG8_WAIT_V(6); PG8_BAR; PG8_MMA(1, 1, At, B1); PG8_BAR;
        }
        E(acc, cur, wr, wc, fr, fq);
        if (!has_next) break;
#pragma unroll
        for (int a = 0; a < 2; ++a)
#pragma unroll
            for (int b = 0; b < 2; ++b)
#pragma unroll
                for (int m = 0; m < 4; ++m)
#pragma unroll
                    for (int n = 0; n < 2; ++n) acc[a][b][m][n] = (f32x4){0.f, 0.f, 0.f, 0.f};
        cur = nxt; cA = nA; cB = nB; ++ui;
    }
    PG8_WAIT_V(0);
    if (wr == 0) PG8_BAR;
    PG8_BAR;
#undef PG8_SA
#undef PG8_SB
#undef PG8_STAGE
#undef PG8_LDA
#undef PG8_LDB
#undef PG8_MMA
#undef PG8_WAIT_V
#undef PG8_WAIT_L
#undef PG8_BAR
#undef PG8_SCHED
}
}

enum { M_F32 = 0, M_BF16 = 1, M_QROPE = 2, M_RESID = 3, M_RELU2 = 4, M_L1A = 5, M_L1B = 6 };
__device__ __forceinline__ float sigmoidf_(float x) { return 1.f / (1.f + __expf(-x)); }
__device__ __forceinline__ float tanhf_(float x) { const float e = __expf(-2.f * fabsf(x)); const float t = (1.f - e) / (1.f + e); return x < 0.f ? -t : t; }
__device__ __forceinline__ void st_bf16x8(bf16_t* p, const f32x4& a, const f32x4& b) {
    u32x4 o; o[0] = cvt_pk_bf16(a[0], a[1]); o[1] = cvt_pk_bf16(a[2], a[3]); o[2] = cvt_pk_bf16(b[0], b[1]); o[3] = cvt_pk_bf16(b[2], b[3]); *(u32x4*)p = o;
}
template <int MODE> struct Epi {
    void* o0; void* o1; void* o2; void* o3; void* o4; const float* f0; const float* f1; const float* f2; const float* f3; int ldc;
    __device__ __forceinline__ void operator()(const f32x4 (&acc)[2][2][4][2], const pg8::Unit& u, int wr, int wc, int fr, int fq) const {
        const int row0 = u.pm * 256 + wr * 64 + fr, colb = u.pn * 256 + wc * 32 + 8 * fq;
#pragma unroll
        for (int ai = 0; ai < 2; ++ai)
#pragma unroll
            for (int m = 0; m < 4; ++m) {
                const int row = row0 + ai * 128 + m * 16;
#pragma unroll
                for (int bj = 0; bj < 2; ++bj) {
                    const int col = colb + bj * 128;
                    f32x4 v0 = acc[ai][bj][m][0], v1 = acc[ai][bj][m][1];
                    if constexpr (MODE == M_F32) {
                        float* dst = (float*)o0 + (size_t)row * ldc + col; *(f32x4*)dst = v0; *(f32x4*)(dst + 4) = v1;
                    } else if constexpr (MODE == M_BF16) {
                        st_bf16x8((bf16_t*)o0 + (size_t)row * ldc + col, v0, v1);
                    } else if constexpr (MODE == M_QROPE) {
                        if (u.pn >= 8) {
                            const bool isq = u.pn < 12; const int gpar = wc & 1;
                            if (isq || gpar == 0) {
                                const float* ct = isq ? f0 + (size_t)row * 32 + gpar * 16 + 4 * fq : f2 + (size_t)row * 16 + 4 * fq;
                                const float* st = isq ? f1 + (size_t)row * 32 + gpar * 16 + 4 * fq : f3 + (size_t)row * 16 + 4 * fq;
                                const f32x4 c = *(const f32x4*)ct, s = *(const f32x4*)st;
                                const f32x4 a = v0 * c - v1 * s, b = v1 * c + v0 * s; v0 = a; v1 = b;
                            }
                        }
                        st_bf16x8((bf16_t*)o0 + (size_t)row * ldc + col, v0, v1);
                    } else if constexpr (MODE == M_RESID) {
                        const int b = row >> 11;
                        const float* gp = f1 + (size_t)b * 12288 + col; const float* xin = f0 + (size_t)row * D_ + col;
                        const f32x4 g0 = *(const f32x4*)gp, g1 = *(const f32x4*)(gp + 4), x0 = *(const f32x4*)xin, x1 = *(const f32x4*)(xin + 4);
                        float* dst = (float*)o0 + (size_t)row * D_ + col; *(f32x4*)dst = x0 + g0 * v0; *(f32x4*)(dst + 4) = x1 + g1 * v1;
                    } else if constexpr (MODE == M_RELU2) {
#pragma unroll
                        for (int i = 0; i < 4; ++i) { float a = fmaxf(v0[i], 0.f), b = fmaxf(v1[i], 0.f); v0[i] = a * a; v1[i] = b * b; }
                        st_bf16x8((bf16_t*)o0 + (size_t)row * ldc + col, v0, v1);
                    } else if constexpr (MODE == M_L1A) {
                        if (u.pn < 16) { bf16_t* base = (bf16_t*)(u.pn < 8 ? o0 : o1); st_bf16x8(base + (size_t)row * D_ + (col & 2047), v0, v1); }
                        else {
                            bf16_t* base = (bf16_t*)(u.pn == 16 ? o2 : (u.pn == 17 ? o3 : o4));
                            if (u.pn == 16) {
#pragma unroll
                                for (int i = 0; i < 4; ++i) { v0[i] = tanhf_(v0[i]); v1[i] = tanhf_(v1[i]); }
                            } else if (u.pn == 18) {
#pragma unroll
                                for (int i = 0; i < 4; ++i) { v0[i] = sigmoidf_(v0[i]); v1[i] = sigmoidf_(v1[i]); }
                            }
                            st_bf16x8(base + (size_t)row * 256 + (col & 255), v0, v1);
                        }
                    } else if constexpr (MODE == M_L1B) {
                        const int c = col & 2047;
                        if (u.pn < 8) { float* dst = (float*)o0 + (size_t)row * D_ + c; *(f32x4*)dst = v0; *(f32x4*)(dst + 4) = v1; }
                        else if (u.pn < 16) { st_bf16x8((bf16_t*)o1 + (size_t)row * D_ + c, v0, v1);
                        } else st_bf16x8((bf16_t*)o2 + (size_t)row * D_ + c, v0, v1);
                    }
                }
            }
    }
};
template <int MODE> __device__ __forceinline__ void run_gemm(int vbid, LAS unsigned char* lds, const void* A, int lda, const void* Bt, int ldb, int M, int N, int K, int amode, const Epi<MODE>& E) {
    pg8::Gemm g; g.A = (const bf16_t*)A; g.Bt = (const bf16_t*)Bt; g.M = M; g.N = N; g.K = K; g.lda = lda; g.ldb = ldb; g.amode = amode;
    pg8::StaticOrder S; S.init(M, N, ogrid(), vbid);
    pg8::gemm_phase<Epi<MODE>>(lds, g, S, E);
}

__device__ __forceinline__ void p0_mod(const Params& p, unsigned char* shm) {
    const int bid = obid(), nb = ogrid();
    if (bid >= 384) return;
    float* cact = (float*)shm; float* red = cact + 8 * 2048;
    const int tid = otid(), wid = tid >> 6, lane = tid & 63;
    for (int i = tid; i < 8 * 2048; i += 512) { const float v = p.in[1][i]; cact[i] = v / (1.f + __expf(-v)); }
    __syncthreads();
    float* mod = (float*)(p.ws + WS_MOD);
    for (int item = bid; item < 384; item += nb) {
        const int l = item / 192, c0 = (item % 192) * 64;
        const float* W = p.in[3] + (size_t)l * 2048 * 12288 + c0 + lane;
        float acc[8];
#pragma unroll
        for (int b = 0; b < 8; ++b) acc[b] = 0.f;
        const int k0 = wid * 256;
#pragma unroll 16
        for (int k = 0; k < 256; ++k) {
            const float wv = W[(size_t)(k0 + k) * 12288];
#pragma unroll
            for (int b = 0; b < 8; ++b) acc[b] += cact[b * 2048 + k0 + k] * wv;
        }
#pragma unroll
        for (int b = 0; b < 8; ++b) red[(wid * 8 + b) * 64 + lane] = acc[b];
        __syncthreads();
        { const int b = tid >> 6; float s = 0.f;
#pragma unroll
          for (int w = 0; w < 8; ++w) s += red[(w * 8 + b) * 64 + lane];
          mod[(size_t)(l * 8 + b) * 12288 + c0 + lane] = s + p.in[4][l * 12288 + c0 + lane]; }
        __syncthreads();
    }
}
__device__ __forceinline__ void p0_rope(const Params& p) {
    float* cosA = (float*)(p.ws + WS_COSA); float* sinA = (float*)(p.ws + WS_SINA); float* cosI = (float*)(p.ws + WS_COSI); float* sinI = (float*)(p.ws + WS_SINI);
    const int* pos = (const int*)p.in[2];
    const int nb_ = ogrid(); for (int i = obid() * 512 + otid(); i < T_ * 32; i += nb_ * 512) {
        const int t = i >> 5, f = i & 31; const float ps = (float)pos[t];
        { const float inv = 1.0f / powf(10000.f, (float)(2 * f) / 64.f); const float ang = ps * inv; const double a = (double)ang; const double k = rint(a * 0.15915494309189535);
          const float r = (float)(a - k * 6.283185307179586); cosA[i] = __cosf(r); sinA[i] = __sinf(r); }
        if (f < 16) { const float inv = 1.0f / powf(10000.f, (float)(2 * f) / 32.f); const float ang = ps * inv; const double a = (double)ang; const double k = rint(a * 0.15915494309189535);
          const float r = (float)(a - k * 6.283185307179586); cosI[t * 16 + f] = __cosf(r); sinI[t * 16 + f] = __sinf(r); }
    }
}
__device__ __forceinline__ int ropeperm(int j) { const int half = j >> 5, f = j & 31; return (f >> 4) * 32 + 8 * ((f & 15) >> 2) + 4 * half + (f & 3); }
__device__ __forceinline__ int idxperm(int j) { if (j >= 32) return j; const int half = j >> 4, f = j & 15; return 8 * (f >> 2) + 4 * half + (f & 3); }

struct Job { const float* src; bf16_t* dst; int modeC, sK, sN, skst, snst, dN, dK, dld, k0, nblk, kblk, rowmap; };
__device__ __forceinline__ Job mkjob(const float* src, void* dst, int sK, int sN, int skst, int dN, int dK) {
    Job J; J.src = src; J.dst = (bf16_t*)dst; J.modeC = 0; J.sK = sK; J.sN = sN; J.skst = skst; J.snst = 1; J.dN = dN; J.dK = dK; J.dld = dK; J.k0 = 0; J.nblk = 1 << 30; J.kblk = 0; J.rowmap = 0; return J;
}
constexpr int NJOBS_EARLY = 40, NJOBS_ALL = 42;
__device__ __forceinline__ Job get_job(const Params& p, int j) {
    unsigned char* ws = p.ws;
    if (j == 0) return mkjob(p.in[8], ws + WS_WT_IN, 2048, 912, 912, 1024, 2048);
    if (j == 1) { Job J = mkjob(p.in[11], ws + WS_WT_Q, 512, 3072, 3072, 3072, 512); J.rowmap = 1; return J; }
    if (j == 2) { Job J = mkjob(p.in[12], ws + WS_WT_Q, 512, 1024, 1024, 1024, 512); J.rowmap = 2; return J; }
    if (j < 19) { const int h = j - 3; Job J = mkjob(p.in[15] + h * 128, (bf16_t*)(ws + WS_WT_UK) + (size_t)h * 256 * 256, 128, 256, 1, 256, 256); J.modeC = 1; J.snst = 2048; J.k0 = (h & 1) * 128; return J; }
    if (j < 27) { const int hp = j - 19; Job J = mkjob(p.in[16] + hp * 256, (bf16_t*)(ws + WS_WT_UV) + (size_t)hp * 256 * 512, 256, 256, 2048, 256, 512); J.nblk = 128; J.kblk = 256; return J; }
    if (j == 27) return mkjob(p.in[17], ws + WS_WT_O, 2048, 2048, 2048, 2048, 2048);
    if (j == 28) return mkjob(p.in[5], ws + WS_WT_1_0, 2048, 8192, 8192, 8192, 2048);
    if (j == 29) return mkjob(p.in[6], ws + WS_WT_2_0, 8192, 2048, 2048, 2048, 8192);
    if (j == 30) return mkjob(p.in[19], (bf16_t*)(ws + WS_WT_RKV), 2048, 2048, 2048, 2048, 2048);
    if (j == 31) return mkjob(p.in[20], (bf16_t*)(ws + WS_WT_RKV) + (size_t)2048 * 2048, 2048, 2048, 2048, 2048, 2048);
    if (j == 32) return mkjob(p.in[21], (bf16_t*)(ws + WS_WT_RKV) + (size_t)4096 * 2048, 2048, 2048, 2048, 2048, 2048);
    if (j == 33) return mkjob(p.in[24], (bf16_t*)(ws + WS_WT_RKV) + (size_t)6144 * 2048, 2048, 96, 96, 256, 2048);
    if (j == 34) return mkjob(p.in[27], (bf16_t*)(ws + WS_WT_RKV) + (size_t)6400 * 2048, 2048, 96, 96, 256, 2048);
    if (j == 35) return mkjob(p.in[29], (bf16_t*)(ws + WS_WT_RKV) + (size_t)6656 * 2048, 2048, 256, 256, 256, 2048);
    if (j == 36) return mkjob(p.in[25], (bf16_t*)(ws + WS_WT_L2), 96, 2048, 2048, 2048, 256);
    if (j == 37) return mkjob(p.in[28], (bf16_t*)(ws + WS_WT_L2) + (size_t)2048 * 256, 96, 2048, 2048, 2048, 256);
    if (j == 38) return mkjob(p.in[30], (bf16_t*)(ws + WS_WT_L2) + (size_t)4096 * 256, 256, 2048, 2048, 2048, 256);
    if (j == 39) return mkjob(p.in[22], ws + WS_WT_BO, 2048, 2048, 2048, 2048, 2048);
    if (j == 40) return mkjob(p.in[5] + (size_t)2048 * 8192, ws + WS_WT_1_1, 2048, 8192, 8192, 8192, 2048);
    return mkjob(p.in[6] + (size_t)8192 * 2048, ws + WS_WT_2_1, 8192, 2048, 2048, 2048, 8192);
}
__device__ __forceinline__ int job_rowmap(const Job& J, int n) {
    if (J.rowmap == 1) { const int h = n / 192, d = n % 192; return d < 128 ? h * 128 + d : 2048 + h * 64 + ropeperm(d - 128); }
    if (J.rowmap == 2) { const int h = n >> 6, jj = n & 63; return 3072 + h * 64 + idxperm(jj); }
    return n;
}
__device__ __forceinline__ void conv_decode(const Params& p, int jlo, int ti, Job& J, int& n0, int& k0t, const volatile int* jtab) {
    int j = jlo; while (ti >= jtab[j + 1]) ++j;
    const int rem = ti - jtab[j]; J = get_job(p, j);
    const int nnt = J.dN >> 8; k0t = (rem / nnt) * 64; n0 = (rem % nnt) * 256;
}
__device__ __forceinline__ void conv_load(const Job& J, int n0, int k0t, int tid, f32x4 (&R)[8]) {
    if (!J.modeC) {
#pragma unroll
        for (int i = 0; i < 8; ++i) {
            const int kr = (tid >> 6) + 8 * i, n = n0 + (tid & 63) * 4; const int kk = k0t + kr - (J.k0 + (n / J.nblk) * J.kblk);
            R[i] = (f32x4){0.f, 0.f, 0.f, 0.f};
            if (n < J.sN && kk >= 0 && kk < J.sK) R[i] = *(const f32x4*)(J.src + (size_t)kk * J.skst + n);
        }
    } else {
#pragma unroll
        for (int i = 0; i < 4; ++i) {
            const int n = (tid >> 3) + 64 * i, k8 = (tid & 7) * 8; const int kk = k0t + k8 - J.k0;
            R[2 * i] = (f32x4){0.f, 0.f, 0.f, 0.f}; R[2 * i + 1] = R[2 * i];
            if (n0 + n < J.sN && kk >= 0 && kk + 7 < J.sK) { const float* sp = J.src + (size_t)(n0 + n) * J.snst + kk; R[2 * i] = *(const f32x4*)sp; R[2 * i + 1] = *(const f32x4*)(sp + 4); }
        }
    }
}
__device__ __forceinline__ void convert_jobs(const Params& p, unsigned char* shm, int jlo, int jhi, unsigned* ctr) {
    float* tile = (float*)shm;
    volatile int* nextp = (volatile int*)(shm + 66048);
    const int tid = otid();
    volatile int* jtab = (volatile int*)(shm + 66112);
    __syncthreads();
    if (tid == 0) { int acc = 0; for (int j = jlo; j < jhi; ++j) { jtab[j] = acc; const Job Jt = get_job(p, j); acc += (Jt.dN >> 8) * (Jt.dK >> 6); } jtab[jhi] = acc; }
    __syncthreads();
    const int total = jtab[jhi];
    if (tid == 0) *nextp = (int)__hip_atomic_fetch_add(ctr, 1u, __ATOMIC_RELAXED, __HIP_MEMORY_SCOPE_AGENT);
    __syncthreads();
    int ti = *nextp;
    Job J; int n0 = 0, k0t = 0; f32x4 R[8];
    if (ti < total) { conv_decode(p, jlo, ti, J, n0, k0t, jtab); conv_load(J, n0, k0t, tid, R); }
    while (ti < total) {
        if (!J.modeC) {
#pragma unroll
            for (int i = 0; i < 8; ++i) { const int kr = (tid >> 6) + 8 * i, n4 = (tid & 63) * 4; float* d = tile + kr * 257 + n4; d[0] = R[i][0]; d[1] = R[i][1]; d[2] = R[i][2]; d[3] = R[i][3]; }
        } else {
#pragma unroll
            for (int i = 0; i < 4; ++i) { const int n = (tid >> 3) + 64 * i, k8 = (tid & 7) * 8;
#pragma unroll
                for (int e = 0; e < 4; ++e) { tile[(k8 + e) * 257 + n] = R[2 * i][e]; tile[(k8 + 4 + e) * 257 + n] = R[2 * i + 1][e]; } }
        }
        if (tid == 0) *nextp = (int)__hip_atomic_fetch_add(ctr, 1u, __ATOMIC_RELAXED, __HIP_MEMORY_SCOPE_AGENT);
        __syncthreads();
        const int tnx = *nextp;
        const Job Jc = J; const int n0c = n0, k0c = k0t;
        if (tnx < total) { conv_decode(p, jlo, tnx, J, n0, k0t, jtab); conv_load(J, n0, k0t, tid, R); }
#pragma unroll
        for (int i = 0; i < 4; ++i) {
            const int n = (tid >> 3) + 64 * i, k8 = (tid & 7) * 8;
            float v[8];
#pragma unroll
            for (int e = 0; e < 8; ++e) v[e] = tile[(k8 + e) * 257 + n];
            u32x4 o; o[0] = cvt_pk_bf16(v[0], v[1]); o[1] = cvt_pk_bf16(v[2], v[3]); o[2] = cvt_pk_bf16(v[4], v[5]); o[3] = cvt_pk_bf16(v[6], v[7]);
            *(u32x4*)(Jc.dst + (size_t)job_rowmap(Jc, n0c + n) * Jc.dld + k0c + k8) = o;
        }
        __syncthreads();
        ti = tnx;
    }
}

__device__ __forceinline__ void norm_phase(int vbx, const float* xin, const float* sh, const float* sc, bf16_t* outb, float* outf, const float* fg) {
    const int tid_ = otid(); const int lane = tid_ & 63; const int gw = obid() * 8 + (tid_ >> 6), nw = ogrid() * 8; (void)vbx;
    for (int row = gw; row < T_; row += nw) {
        const float* xr = xin + (size_t)row * D_; const int b = row >> 11;
        f32x4 v[8]; float ss = 0.f;
#pragma unroll
        for (int j = 0; j < 8; ++j) { v[j] = *(const f32x4*)(xr + (lane + 64 * j) * 4); ss += v[j][0] * v[j][0] + v[j][1] * v[j][1] + v[j][2] * v[j][2] + v[j][3] * v[j][3]; }
        ss = red64(ss); const float rstd = rsqrtf(ss * (1.f / D_) + 1e-6f);
#pragma unroll
        for (int j = 0; j < 8; ++j) {
            const int c = (lane + 64 * j) * 4;
            if (outf) { const f32x4 g = *(const f32x4*)(fg + c); *(f32x4*)(outf + (size_t)row * D_ + c) = v[j] * rstd * g; }
            else { const f32x4 s1 = *(const f32x4*)(sc + (size_t)b * 12288 + c), s0 = *(const f32x4*)(sh + (size_t)b * 12288 + c);
                const f32x4 o = v[j] * rstd * (s1 + 1.f) + s0; u32x2 pk; pk[0] = cvt_pk_bf16(o[0], o[1]); pk[1] = cvt_pk_bf16(o[2], o[3]); *(u32x2*)(outb + (size_t)row * D_ + c) = pk; }
        }
    }
}
__device__ __forceinline__ void mix_phase(const Params& p, const float* xin, const float* sh, const float* sc) {
    const int tid_ = otid(); const int lane = tid_ & 63; const int gw = obid() * 8 + (tid_ >> 6), nw = ogrid() * 8;
    bf16_t* mix = (bf16_t*)(p.ws + WS_MIX); const float* mu = p.in[18];
    for (int r0 = gw * 8; r0 < T_; r0 += nw * 8) {
        const int b = r0 >> 11;
        f32x4 hp[8];
        for (int rr = -1; rr < 8; ++rr) {
            const int row = r0 + rr;
            f32x4 h[8];
            if (rr < 0 && (r0 & 2047) == 0) {
#pragma unroll
                for (int j = 0; j < 8; ++j) h[j] = (f32x4){0.f, 0.f, 0.f, 0.f};
            } else {
                const float* xr = xin + (size_t)row * D_; float ss = 0.f;
#pragma unroll
                for (int j = 0; j < 8; ++j) { h[j] = *(const f32x4*)(xr + (lane + 64 * j) * 4); ss += h[j][0] * h[j][0] + h[j][1] * h[j][1] + h[j][2] * h[j][2] + h[j][3] * h[j][3]; }
                ss = red64(ss); const float rstd = rsqrtf(ss * (1.f / D_) + 1e-6f);
#pragma unroll
                for (int j = 0; j < 8; ++j) { const int c = (lane + 64 * j) * 4; const f32x4 s1 = *(const f32x4*)(sc + (size_t)b * 12288 + c), s0 = *(const f32x4*)(sh + (size_t)b * 12288 + c); h[j] = h[j] * rstd * (s1 + 1.f) + s0; }
            }
            if (rr >= 0) {
#pragma unroll 1
                for (int q = 0; q < 6; ++q) {
                    const int mq = (q == 1) ? 2 : (q == 2) ? 3 : (q == 3) ? 1 : q;
                    f32x4 m[8];
#pragma unroll
                    for (int j = 0; j < 8; ++j) m[j] = *(const f32x4*)(mu + mq * D_ + (lane + 64 * j) * 4);
#pragma unroll
                    for (int j = 0; j < 8; ++j) {
                        const int c = (lane + 64 * j) * 4; const f32x4 o = h[j] + (hp[j] - h[j]) * m[j]; u32x2 pk; pk[0] = cvt_pk_bf16(o[0], o[1]); pk[1] = cvt_pk_bf16(o[2], o[3]);
                        *(u32x2*)(mix + (size_t)q * T_ * D_ + (size_t)row * D_ + c) = pk;
                    }
                }
            }
#pragma unroll
            for (int j = 0; j < 8; ++j) hp[j] = h[j];
        }
    }
}
__device__ __forceinline__ void projrow_phase(const Params& p) {
    const int tid_ = otid(); const int lane = tid_ & 63; const int gw = obid() * 8 + (tid_ >> 6), nw = ogrid() * 8;
    const float* proj = (const float*)(p.ws + WS_PROJ); bf16_t* cq = (bf16_t*)(p.ws + WS_CQ); bf16_t* keys = (bf16_t*)(p.ws + WS_KEYS); bf16_t* kidx = (bf16_t*)(p.ws + WS_KIDX); float* widx = (float*)(p.ws + WS_WIDX);
    const float* cosA = (const float*)(p.ws + WS_COSA); const float* sinA = (const float*)(p.ws + WS_SINA); const float* cosI = (const float*)(p.ws + WS_COSI); const float* sinI = (const float*)(p.ws + WS_SINI);
    const float* qg = p.in[9]; const float* kvg = p.in[10]; const float* lng = p.in[13]; const float* lnb = p.in[14];
    for (int row = gw; row < T_; row += nw) {
        const float* pr = proj + (size_t)row * 1024;
        f32x4 v[4];
#pragma unroll
        for (int j = 0; j < 4; ++j) v[j] = *(const f32x4*)(pr + (lane + 64 * j) * 4);
        float sq = 0.f, skv = 0.f;
#pragma unroll
        for (int e = 0; e < 4; ++e) { sq += v[0][e] * v[0][e] + v[1][e] * v[1][e]; skv += v[2][e] * v[2][e]; }
        sq = red64(sq); skv = red64(skv);
        const float rq = rsqrtf(sq * (1.f / 512.f) + 1e-6f), rkv = rsqrtf(skv * (1.f / 256.f) + 1e-6f);
#pragma unroll
        for (int j = 0; j < 2; ++j) { const int c = (lane + 64 * j) * 4; const f32x4 g = *(const f32x4*)(qg + c); const f32x4 o = v[j] * rq * g; u32x2 pk; pk[0] = cvt_pk_bf16(o[0], o[1]); pk[1] = cvt_pk_bf16(o[2], o[3]); *(u32x2*)(cq + (size_t)row * 512 + c) = pk; }
        { const int c = lane * 4; const f32x4 g = *(const f32x4*)(kvg + c); const f32x4 o = v[2] * rkv * g; u32x2 pk; pk[0] = cvt_pk_bf16(o[0], o[1]); pk[1] = cvt_pk_bf16(o[2], o[3]); *(u32x2*)(keys + (size_t)row * 320 + c) = pk; }
        f32x4 x = v[3];
        float s1 = x[0] + x[1] + x[2] + x[3]; s1 = red16(s1); const float mean = s1 * (1.f / 64.f);
        f32x4 xc = x - mean; float s2 = xc[0] * xc[0] + xc[1] * xc[1] + xc[2] * xc[2] + xc[3] * xc[3]; s2 = red16(s2); const float rs = rsqrtf(s2 * (1.f / 64.f) + 1e-6f);
        f32x4 y = x;
        if (lane >= 16 && lane < 32) { const int jj = (lane - 16) * 4; const f32x4 g = *(const f32x4*)(lng + jj), bb = *(const f32x4*)(lnb + jj); y = xc * rs * g + bb; }
        f32x4 part8, part4;
#pragma unroll
        for (int e = 0; e < 4; ++e) { part8[e] = __shfl_xor(y[e], 8); part4[e] = __shfl_xor(y[e], 4); }
        if (lane < 16) {
            const int l2 = lane & 7; const f32x4 c = *(const f32x4*)(cosA + (size_t)row * 32 + 4 * l2), s = *(const f32x4*)(sinA + (size_t)row * 32 + 4 * l2);
            f32x4 o; if (lane < 8) o = y * c - part8 * s; else o = y * c + part8 * s;
            const int pphys = (l2 >> 2) * 32 + 8 * (l2 & 3) + (lane < 8 ? 0 : 4);
            u32x2 pk; pk[0] = cvt_pk_bf16(o[0], o[1]); pk[1] = cvt_pk_bf16(o[2], o[3]); *(u32x2*)(keys + (size_t)row * 320 + 256 + pphys) = pk;
        } else if (lane < 32) {
            const int ll = lane - 16; f32x4 o = y; int pphys = ll * 4;
            if (ll < 8) { const int l2 = ll & 3; const f32x4 c = *(const f32x4*)(cosI + (size_t)row * 16 + 4 * l2), s = *(const f32x4*)(sinI + (size_t)row * 16 + 4 * l2);
                if (ll < 4) o = y * c - part4 * s; else o = y * c + part4 * s; pphys = 8 * l2 + (ll < 4 ? 0 : 4); }
            u32x2 pk; pk[0] = cvt_pk_bf16(o[0], o[1]); pk[1] = cvt_pk_bf16(o[2], o[3]); *(u32x2*)(kidx + (size_t)row * 64 + pphys) = pk;
        } else if (lane < 36) {
            *(f32x4*)(widx + (size_t)row * 16 + (lane - 32) * 4) = x * (1.f / 32.f);
        }
    }
}

__device__ __forceinline__ void score_phase(const Params& p, int vbx) {
    const int tid_ = otid(); const int lane = tid_ & 63, l32 = lane & 31, hh = lane >> 5; const int gw = obid() * 8 + (tid_ >> 6), nw = ogrid() * 8;
    const bf16_t* qall = (const bf16_t*)(p.ws + WS_QALL); const bf16_t* kidx = (const bf16_t*)(p.ws + WS_KIDX); const float* widx = (const float*)(p.ws + WS_WIDX); float* scores = (float*)(p.ws + WS_SCORES);
    const int xb_ = vbx >> 5;
    unsigned* sctr = (unsigned*)(p.ws + WS_BAR) + 48 + 16 * (xb_ & 7);
    for (;;) {
        int tile = 0; if (lane == 0) tile = (int)__hip_atomic_fetch_add(sctr, 1u, __ATOMIC_RELAXED, __HIP_MEMORY_SCOPE_AGENT);
        tile = __builtin_amdgcn_readfirstlane(tile); if (tile >= 528) break;
        const int b = xb_ & 7, L = 527 - tile;
        int qc = (int)((sqrtf(8.f * (float)L + 1.f) - 1.f) * 0.5f); while ((qc + 1) * (qc + 2) / 2 <= L) ++qc; while (qc * (qc + 1) / 2 > L) --qc;
        const int kt = L - qc * (qc + 1) / 2;
        const int t0 = b * S_ + qc * 64, key0 = b * S_ + kt * 64;
        bf16x8 kf[2][4];
#pragma unroll
        for (int mt = 0; mt < 2; ++mt)
#pragma unroll
            for (int ks = 0; ks < 4; ++ks) kf[mt][ks] = *(const bf16x8*)(kidx + (size_t)(key0 + mt * 32 + l32) * 64 + ks * 16 + hh * 8);
        f32x16 sc[2][2];
#pragma unroll
        for (int mt = 0; mt < 2; ++mt)
#pragma unroll
            for (int nt = 0; nt < 2; ++nt)
#pragma unroll
                for (int i = 0; i < 16; ++i) sc[mt][nt][i] = 0.f;
        bf16x8 qn[2][4]; float wn[2];
#pragma unroll
        for (int nt = 0; nt < 2; ++nt) {
#pragma unroll
            for (int ks = 0; ks < 4; ++ks) qn[nt][ks] = *(const bf16x8*)(qall + (size_t)(t0 + nt * 32 + l32) * 4096 + 3072 + ks * 16 + hh * 8);
            wn[nt] = widx[(size_t)(t0 + nt * 32 + l32) * 16];
        }
        for (int h = 0; h < 16; ++h) {
            bf16x8 qf[2][4]; float w[2];
#pragma unroll
            for (int nt = 0; nt < 2; ++nt) {
#pragma unroll
                for (int ks = 0; ks < 4; ++ks) qf[nt][ks] = qn[nt][ks];
                w[nt] = wn[nt];
            }
            { const int h1 = (h + 1) & 15;
#pragma unroll
              for (int nt = 0; nt < 2; ++nt) {
#pragma unroll
                for (int ks = 0; ks < 4; ++ks) qn[nt][ks] = *(const bf16x8*)(qall + (size_t)(t0 + nt * 32 + l32) * 4096 + 3072 + h1 * 64 + ks * 16 + hh * 8);
                wn[nt] = widx[(size_t)(t0 + nt * 32 + l32) * 16 + h1];
              } }
#pragma unroll
            for (int mt = 0; mt < 2; ++mt)
#pragma unroll
                for (int nt = 0; nt < 2; ++nt) {
                    f32x16 a;
#pragma unroll
                    for (int i = 0; i < 16; ++i) a[i] = 0.f;
#pragma unroll
                    for (int ks = 0; ks < 4; ++ks) a = __builtin_amdgcn_mfma_f32_32x32x16_bf16(kf[mt][ks], qf[nt][ks], a, 0, 0, 0);
#pragma unroll
                    for (int i = 0; i < 16; ++i) sc[mt][nt][i] += w[nt] * fmaxf(a[i], 0.f);
                }
        }
#pragma unroll
        for (int mt = 0; mt < 2; ++mt)
#pragma unroll
            for (int nt = 0; nt < 2; ++nt)
#pragma unroll
                for (int q4 = 0; q4 < 4; ++q4) {
                    f32x4 o; o[0] = sc[mt][nt][q4 * 4]; o[1] = sc[mt][nt][q4 * 4 + 1]; o[2] = sc[mt][nt][q4 * 4 + 2]; o[3] = sc[mt][nt][q4 * 4 + 3];
                    *(f32x4*)(scores + (size_t)(t0 + nt * 32 + l32) * S_ + kt * 64 + mt * 32 + q4 * 8 + hh * 4) = o;
                }
    }
}
template <int NI> __device__ __forceinline__ void topk_select(const float* sr, unsigned short* srow, int qc, int lane, unsigned long long ltmask) {
    unsigned u[NI];
#pragma unroll
    for (int i = 0; i < NI; ++i) {
        unsigned bits = 0u;
        if (i <= qc) { bits = __float_as_uint(sr[i * 64 + lane]); bits = (bits & 0x80000000u) ? ~bits : (bits | 0x80000000u); if (bits == 0u) bits = 1u; }
        u[i] = bits;
    }
    unsigned thr = 0u;
    for (int bit = 31; bit >= 0; --bit) {
        const unsigned cand = thr | (1u << bit); int c = 0;
#pragma unroll
        for (int i = 0; i < NI; ++i) c += __popcll(__ballot(u[i] >= cand));
        if (c >= 256) { thr = cand; if (c == 256) break; }
    }
    int cgt = 0;
#pragma unroll
    for (int i = 0; i < NI; ++i) cgt += __popcll(__ballot(u[i] > thr));
    const int need = 256 - cgt; int eqtaken = 0, base = 0;
#pragma unroll
    for (int i = 0; i < NI; ++i) {
        const bool eq = (u[i] == thr); const unsigned long long em = __ballot(eq);
        const int rank = eqtaken + __popcll(em & ltmask);
        const bool take = (u[i] > thr) || (eq && rank < need);
        const unsigned long long tm = __ballot(take);
        if (take) srow[base + __popcll(tm & ltmask)] = (unsigned short)(i * 64 + lane);
        base += __popcll(tm); eqtaken += __popcll(em);
    }
}
__device__ __forceinline__ void topk_phase(const Params& p) {
    const int tid_ = otid(); const int lane = tid_ & 63; const int gw = obid() * 8 + (tid_ >> 6), nw = ogrid() * 8;
    const float* scores = (const float*)(p.ws + WS_SCORES); unsigned short* sel = (unsigned short*)(p.ws + WS_SEL); int* cnt = (int*)(p.ws + WS_CNT);
    const unsigned long long ltmask = (1ull << lane) - 1ull;
    for (int t0 = gw; t0 < T_; t0 += nw) {
        const int bq = t0 >> 11; const int t = (bq << 11) | (((t0 & 2047) + 261 * bq) & 2047);
        const int s = t & 2047, qc = s >> 6; const int nvalid = (qc + 1) * 64;
        unsigned short* srow = sel + (size_t)t * 256;
        if (nvalid <= 256) {
#pragma unroll
            for (int i = 0; i < 4; ++i) { const int k = i * 64 + lane; srow[k] = (unsigned short)(k < nvalid ? k : 0); }
            if (lane == 0) cnt[t] = nvalid;
            continue;
        }
        const float* sr = scores + (size_t)t * S_;
        if (qc < 8) topk_select<8>(sr, srow, qc, lane, ltmask);
        else if (qc < 16) topk_select<16>(sr, srow, qc, lane, ltmask);
        else if (qc < 24) topk_select<24>(sr, srow, qc, lane, ltmask);
        else topk_select<32>(sr, srow, qc, lane, ltmask);
        if (lane == 0) cnt[t] = 256;
    }
}


constexpr int SROW = 2052;
__device__ __forceinline__ void scoretopk_phase(const Params& p, unsigned char* shm, int vbx) {
    float* scl = (float*)shm;
    volatile int* nextp = (volatile int*)(shm + 16 * SROW * 4);
    const int tid = otid(); const int wid = tid >> 6, lane = tid & 63, l16 = lane & 15, g = lane >> 4;
    const bf16_t* qall = (const bf16_t*)(p.ws + WS_QALL); const bf16_t* kidx = (const bf16_t*)(p.ws + WS_KIDX); const float* widx = (const float*)(p.ws + WS_WIDX);
    unsigned short* sel = (unsigned short*)(p.ws + WS_SEL); int* cnt = (int*)(p.ws + WS_CNT);
    const unsigned long long ltmask = (1ull << lane) - 1ull;
    for (int bi = 0; bi < 8; ++bi) {
    const int b = ((vbx >> 5) + bi) & 7;
    unsigned* sctr = (unsigned*)(p.ws + WS_BAR) + 48 + 16 * b;
    for (;;) {
        __syncthreads();
        if (tid == 0) *nextp = (int)__hip_atomic_fetch_add(sctr, 1u, __ATOMIC_RELAXED, __HIP_MEMORY_SCOPE_AGENT);
        __syncthreads();
        const int task = *nextp; if (task >= 128) break;
        const int qg = 127 - task; const int t0 = b * S_ + qg * 16; const int qc = qg >> 2; const int nvalid = (qc + 1) * 64;
        if (nvalid <= 256) {
#pragma unroll
            for (int qq = 0; qq < 2; ++qq) {
                const int t = t0 + 2 * wid + qq; unsigned short* srow = sel + (size_t)t * 256;
#pragma unroll
                for (int i = 0; i < 4; ++i) { const int k = i * 64 + lane; srow[k] = (unsigned short)(k < nvalid ? k : 0); }
                if (lane == 0) cnt[t] = nvalid;
            }
            continue;
        }
#pragma unroll 1
        for (int hp = 0; hp < 2; ++hp) {
            bf16x8 qf[8][2]; float w[8];
#pragma unroll
            for (int h = 0; h < 8; ++h) {
#pragma unroll
                for (int ks = 0; ks < 2; ++ks) qf[h][ks] = *(const bf16x8*)(qall + (size_t)(t0 + l16) * 4096 + 3072 + (hp * 8 + h) * 64 + ks * 32 + g * 8);
            }
#pragma unroll
            for (int h4 = 0; h4 < 2; ++h4) { const f32x4 wv = *(const f32x4*)(widx + (size_t)(t0 + l16) * 16 + hp * 8 + h4 * 4); w[h4 * 4] = wv[0]; w[h4 * 4 + 1] = wv[1]; w[h4 * 4 + 2] = wv[2]; w[h4 * 4 + 3] = wv[3]; }
            const int nkt = nvalid >> 4;
            const bf16_t* kr0 = kidx + (size_t)(b * S_ + l16) * 64 + g * 8;
            bf16x8 k0n = *(const bf16x8*)(kr0 + (size_t)wid * 1024), k1n = *(const bf16x8*)(kr0 + (size_t)wid * 1024 + 32);
            for (int kt = wid; kt < nkt; kt += 8) {
                const bf16x8 k0 = k0n, k1 = k1n;
                { const int ktn = (kt + 8 < nkt) ? kt + 8 : kt; k0n = *(const bf16x8*)(kr0 + (size_t)ktn * 1024); k1n = *(const bf16x8*)(kr0 + (size_t)ktn * 1024 + 32); }
                float* dst = scl + l16 * SROW + kt * 16 + g * 4;
                f32x4 sacc = (f32x4){0.f, 0.f, 0.f, 0.f};
                if (hp) sacc = *(const f32x4*)dst;
#pragma unroll
                for (int h = 0; h < 8; ++h) {
                    f32x4 a = (f32x4){0.f, 0.f, 0.f, 0.f};
                    a = __builtin_amdgcn_mfma_f32_16x16x32_bf16(k0, qf[h][0], a, 0, 0, 0);
                    a = __builtin_amdgcn_mfma_f32_16x16x32_bf16(k1, qf[h][1], a, 0, 0, 0);
#pragma unroll
                    for (int i = 0; i < 4; ++i) sacc[i] += w[h] * fmaxf(a[i], 0.f);
                }
                *(f32x4*)dst = sacc;
            }
        }
        __syncthreads();
#pragma unroll 1
        for (int qq = 0; qq < 2; ++qq) {
            const int q = 2 * wid + qq; const int t = t0 + q; unsigned short* srow = sel + (size_t)t * 256; const float* sr = scl + q * SROW;
            if (qc < 8) topk_select<8>(sr, srow, qc, lane, ltmask);
            else if (qc < 16) topk_select<16>(sr, srow, qc, lane, ltmask);
            else if (qc < 24) topk_select<24>(sr, srow, qc, lane, ltmask);
            else topk_select<32>(sr, srow, qc, lane, ltmask);
            if (lane == 0) cnt[t] = 256;
        }
    }
    }
}
typedef short bf16x4v __attribute__((ext_vector_type(4)));
constexpr int ABUF_BYTES = 8 * 1024, AWAVE = 2 * ABUF_BYTES;
__device__ __forceinline__ void attn_phase(const Params& p, LAS unsigned char* lds, int vbx) {
    const int tid_ = otid(); const int wid = __builtin_amdgcn_readfirstlane(tid_ >> 6), lane = tid_ & 63, l16 = lane & 15, g = lane >> 4;
    const int gw = vbx * 8 + wid, nw = ogrid() * 8;
    LAS unsigned char* vl = lds + wid * AWAVE;
    LAS unsigned char* rl = lds + 8 * AWAVE + wid * 2048;
    const unsigned r_rd = (unsigned)((l16 >> 3) * 1024 + (l16 & 7) * 128 + g * 16);
    const bf16_t* qlat = (const bf16_t*)(p.ws + WS_QLAT); const bf16_t* qall = (const bf16_t*)(p.ws + WS_QALL); const bf16_t* keys = (const bf16_t*)(p.ws + WS_KEYS);
    const unsigned short* sel = (const unsigned short*)(p.ws + WS_SEL); bf16_t* olat = (bf16_t*)(p.ws + WS_OLAT);
    const float cs = 0.07216878364870322f * 1.4426950408889634f;
    const float NEG = -1e30f;
    const unsigned a_rd = (unsigned)(l16 * 64 + g * 16);
    const unsigned tr_rd = (unsigned)((g * 4 + ((lane & 15) >> 2)) * 64 + (lane & 3) * 8);
    for (int t = gw * 8; t < T_; t += nw * 8)
    for (int qi = 0; qi < 8; ++qi) {
        const int tq = t + qi; const int b = tq >> 11; const int nv_ = ((((tq & 2047) >> 6) + 1) * 64); const int cnt = nv_ < 256 ? nv_ : 256;
        bf16x8 qf[10];
#pragma unroll
        for (int ks = 0; ks < 8; ++ks) qf[ks] = *(const bf16x8*)(qlat + (size_t)tq * 4096 + l16 * 256 + ks * 32 + g * 8);
#pragma unroll
        for (int ks = 0; ks < 2; ++ks) qf[8 + ks] = *(const bf16x8*)(qall + (size_t)tq * 4096 + 2048 + l16 * 64 + ks * 32 + g * 8);
        f32x4 oacc[16];
#pragma unroll
        for (int rt = 0; rt < 16; ++rt) oacc[rt] = (f32x4){0.f, 0.f, 0.f, 0.f};
        float m = NEG, lsum = 0.f;
        const int nch = cnt >> 4;
        const unsigned short* selr = sel + (size_t)tq * 256;
        const bf16_t* kbase = keys + (size_t)(b * S_) * 320;
        int ja = selr[lane >> 2], jr0 = selr[lane >> 3], jr1 = selr[8 + (lane >> 3)];
        { const char* src = (const char*)(kbase + (size_t)ja * 320) + (lane & 3) * 16;
#pragma unroll
          for (int i = 0; i < 8; ++i) __builtin_amdgcn_global_load_lds((const unsigned*)(src + i * 64), (LAS unsigned*)(vl + i * 1024), 16, 0, 0);
          __builtin_amdgcn_global_load_lds((const unsigned*)((const char*)(kbase + (size_t)jr0 * 320 + 256) + (lane & 7) * 16), (LAS unsigned*)(rl), 16, 0, 0);
          __builtin_amdgcn_global_load_lds((const unsigned*)((const char*)(kbase + (size_t)jr1 * 320 + 256) + (lane & 7) * 16), (LAS unsigned*)(rl + 1024), 16, 0, 0); }
        ja = selr[16 + (lane >> 2)]; jr0 = selr[16 + (lane >> 3)]; jr1 = selr[24 + (lane >> 3)];
        for (int c = 0; c < nch; ++c) {
            LAS unsigned char* buf = vl + (c & 1) * ABUF_BYTES;
            asm volatile("s_waitcnt vmcnt(0)" ::: "memory");
            const bf16x8 r0 = *(const LAS bf16x8*)(rl + r_rd), r1 = *(const LAS bf16x8*)(rl + r_rd + 64);
            asm volatile("s_waitcnt lgkmcnt(0)" ::: "memory");
            if (c + 1 < nch) {
                LAS unsigned char* nb = vl + ((c + 1) & 1) * ABUF_BYTES;
                const char* src = (const char*)(kbase + (size_t)ja * 320) + (lane & 3) * 16;
#pragma unroll
                for (int i = 0; i < 8; ++i) __builtin_amdgcn_global_load_lds((const unsigned*)(src + i * 64), (LAS unsigned*)(nb + i * 1024), 16, 0, 0);
                __builtin_amdgcn_global_load_lds((const unsigned*)((const char*)(kbase + (size_t)jr0 * 320 + 256) + (lane & 7) * 16), (LAS unsigned*)(rl), 16, 0, 0);
                __builtin_amdgcn_global_load_lds((const unsigned*)((const char*)(kbase + (size_t)jr1 * 320 + 256) + (lane & 7) * 16), (LAS unsigned*)(rl + 1024), 16, 0, 0);
                const int cn = (c + 2 < 16) ? c + 2 : 15; ja = selr[cn * 16 + (lane >> 2)]; jr0 = selr[cn * 16 + (lane >> 3)]; jr1 = selr[cn * 16 + 8 + (lane >> 3)];
            }
            f32x4 sv = (f32x4){0.f, 0.f, 0.f, 0.f};
#pragma unroll
            for (int ks = 0; ks < 8; ++ks) { const bf16x8 a = *(const LAS bf16x8*)(buf + ks * 1024 + a_rd); sv = __builtin_amdgcn_mfma_f32_16x16x32_bf16(a, qf[ks], sv, 0, 0, 0); }
            sv = __builtin_amdgcn_mfma_f32_16x16x32_bf16(r0, qf[8], sv, 0, 0, 0); sv = __builtin_amdgcn_mfma_f32_16x16x32_bf16(r1, qf[9], sv, 0, 0, 0);
            float cmax = NEG;
#pragma unroll
            for (int i = 0; i < 4; ++i) { if (c * 16 + g * 4 + i >= cnt) sv[i] = NEG; cmax = fmaxf(cmax, sv[i]); }
            cmax = fmaxf(cmax, __shfl_xor(cmax, 16)); cmax = fmaxf(cmax, __shfl_xor(cmax, 32));
            if (__any((cmax - m) * cs > 6.f)) {
                const float mn = fmaxf(m, cmax); const float alpha = exp2f((m - mn) * cs); m = mn;
                lsum *= alpha;
#pragma unroll
                for (int rt = 0; rt < 16; ++rt) oacc[rt] *= alpha;
            }
            float ps = 0.f;
#pragma unroll
            for (int i = 0; i < 4; ++i) { sv[i] = exp2f((sv[i] - m) * cs); ps += sv[i]; }
            lsum += ps;
            u32x2 pfu; pfu[0] = cvt_pk_bf16(sv[0], sv[1]); pfu[1] = cvt_pk_bf16(sv[2], sv[3]);
            const bf16x4v pf = __builtin_bit_cast(bf16x4v, pfu);
            const unsigned tb = (unsigned)(size_t)buf + tr_rd;
#define TRG4(R4) { bf16x4v a0, a1, a2, a3; \
                asm volatile("ds_read_b64_tr_b16 %0, %4 offset:%5\n\tds_read_b64_tr_b16 %1, %4 offset:%6\n\tds_read_b64_tr_b16 %2, %4 offset:%7\n\tds_read_b64_tr_b16 %3, %4 offset:%8\n\ts_waitcnt lgkmcnt(0)" \
                             : "=&v"(a0), "=&v"(a1), "=&v"(a2), "=&v"(a3) \
                             : "v"(tb), "i"(((R4) * 2) * 1024), "i"(((R4) * 2) * 1024 + 32), "i"(((R4) * 2 + 1) * 1024), "i"(((R4) * 2 + 1) * 1024 + 32) : "memory"); \
                oacc[(R4) * 4 + 0] = __builtin_amdgcn_mfma_f32_16x16x16bf16_1k(a0, pf, oacc[(R4) * 4 + 0], 0, 0, 0); \
                oacc[(R4) * 4 + 1] = __builtin_amdgcn_mfma_f32_16x16x16bf16_1k(a1, pf, oacc[(R4) * 4 + 1], 0, 0, 0); \
                oacc[(R4) * 4 + 2] = __builtin_amdgcn_mfma_f32_16x16x16bf16_1k(a2, pf, oacc[(R4) * 4 + 2], 0, 0, 0); \
                oacc[(R4) * 4 + 3] = __builtin_amdgcn_mfma_f32_16x16x16bf16_1k(a3, pf, oacc[(R4) * 4 + 3], 0, 0, 0); }
            TRG4(0) TRG4(1) TRG4(2) TRG4(3)
#undef TRG4
        }
        lsum += __shfl_xor(lsum, 16); lsum += __shfl_xor(lsum, 32);
        const float inv = 1.f / lsum;
#pragma unroll
        for (int rt = 0; rt < 16; ++rt) { const f32x4 o = oacc[rt] * inv; u32x2 pk; pk[0] = cvt_pk_bf16(o[0], o[1]); pk[1] = cvt_pk_bf16(o[2], o[3]); *(u32x2*)(olat + (size_t)tq * 4096 + l16 * 256 + rt * 16 + g * 4) = pk; }
    }
}

__device__ __forceinline__ void red8x2(float& x0, float& x1) {
    float y0, y1;
    asm volatile("s_nop 1\n\t"
                 "v_add_f32_dpp %0, %2, %2 quad_perm:[1,0,3,2] row_mask:0xf bank_mask:0xf\n\t"
                 "v_add_f32_dpp %1, %3, %3 quad_perm:[1,0,3,2] row_mask:0xf bank_mask:0xf\n\t"
                 "s_nop 0\n\t"
                 "v_add_f32_dpp %0, %0, %0 quad_perm:[2,3,0,1] row_mask:0xf bank_mask:0xf\n\t"
                 "v_add_f32_dpp %1, %1, %1 quad_perm:[2,3,0,1] row_mask:0xf bank_mask:0xf\n\t"
                 "s_nop 0\n\t"
                 "v_add_f32_dpp %0, %0, %0 row_half_mirror row_mask:0xf bank_mask:0xf\n\t"
                 "v_add_f32_dpp %1, %1, %1 row_half_mirror row_mask:0xf bank_mask:0xf\n\t"
                 "s_nop 0"
                 : "=&v"(y0), "=&v"(y1) : "v"(x0), "v"(x1));
    x0 = y0; x1 = y1;
}
constexpr int TC = 32;
typedef float f32x2 __attribute__((ext_vector_type(2)));
__device__ __forceinline__ void scan_phase(const Params& p, unsigned char* shm) {
    const int tid = otid(); const bool seq = tid < 256;
    float* bufs = (float*)shm;
    float* obuf = bufs + 2 * 6 * TC * 64;
    const bf16_t* rbuf = (const bf16_t*)(p.ws + WS_RBUF); const bf16_t* kbuf = (const bf16_t*)(p.ws + WS_KBUF); const bf16_t* vbuf = (const bf16_t*)(p.ws + WS_VBUF);
    const bf16_t* abuf = (const bf16_t*)(p.ws + WS_ABUF); const bf16_t* gbuf = (const bf16_t*)(p.ws + WS_GBUF); const float* wdec = (const float*)(p.ws + WS_WDEC);
    bf16_t* outb = (bf16_t*)(p.ws + WS_SCANOUT);
    const int nb_ = ogrid();
    for (int pair = obid(); pair < 256; pair += nb_) {
        const int b = pair >> 5, h = pair & 31;
        if (seq) {
            const int rp = tid >> 3, cgp = tid & 7;
            f32x2 A0[4], A1[4];
#pragma unroll
            for (int q = 0; q < 4; ++q) { A0[q] = (f32x2){0.f, 0.f}; A1[q] = (f32x2){0.f, 0.f}; }
            __syncthreads();
            for (int c = 0; c <= S_ / TC; ++c) {
                if (c < S_ / TC) {
                    const float* B = bufs + (c & 1) * 6 * TC * 64 + cgp * 8; float* ob = obuf + (c & 1) * TC * 64 + 2 * rp;
                    const float* Bv = bufs + (c & 1) * 6 * TC * 64 + 5 * TC * 64 + 2 * rp;
                    f32x4 xw0 = *(const f32x4*)(B), xw1 = *(const f32x4*)(B + 4), xn0 = *(const f32x4*)(B + TC * 64), xn1 = *(const f32x4*)(B + TC * 64 + 4);
                    f32x4 xb0 = *(const f32x4*)(B + 2 * TC * 64), xb1 = *(const f32x4*)(B + 2 * TC * 64 + 4), xk0 = *(const f32x4*)(B + 3 * TC * 64), xk1 = *(const f32x4*)(B + 3 * TC * 64 + 4);
                    f32x4 xr0 = *(const f32x4*)(B + 4 * TC * 64), xr1 = *(const f32x4*)(B + 4 * TC * 64 + 4); f32x2 xvv = *(const f32x2*)(Bv);
#pragma unroll 4
                    for (int s = 0; s < TC; ++s) {
                        const f32x4 w0 = xw0, w1 = xw1, n0 = xn0, n1 = xn1, b0 = xb0, b1 = xb1, k0 = xk0, k1 = xk1, r0 = xr0, r1 = xr1; const f32x2 vv = xvv;
                        { const float* Bs = B + (s + 1) * 64;
                          xw0 = *(const f32x4*)(Bs); xw1 = *(const f32x4*)(Bs + 4); xn0 = *(const f32x4*)(Bs + TC * 64); xn1 = *(const f32x4*)(Bs + TC * 64 + 4);
                          xb0 = *(const f32x4*)(Bs + 2 * TC * 64); xb1 = *(const f32x4*)(Bs + 2 * TC * 64 + 4); xk0 = *(const f32x4*)(Bs + 3 * TC * 64); xk1 = *(const f32x4*)(Bs + 3 * TC * 64 + 4);
                          xr0 = *(const f32x4*)(Bs + 4 * TC * 64); xr1 = *(const f32x4*)(Bs + 4 * TC * 64 + 4); xvv = *(const f32x2*)(Bv + (s + 1) * 64); }
                        const f32x2 wp[4] = {{w0[0], w0[1]}, {w0[2], w0[3]}, {w1[0], w1[1]}, {w1[2], w1[3]}};
                        const f32x2 np[4] = {{n0[0], n0[1]}, {n0[2], n0[3]}, {n1[0], n1[1]}, {n1[2], n1[3]}};
                        const f32x2 bp[4] = {{b0[0], b0[1]}, {b0[2], b0[3]}, {b1[0], b1[1]}, {b1[2], b1[3]}};
                        const f32x2 kp[4] = {{k0[0], k0[1]}, {k0[2], k0[3]}, {k1[0], k1[1]}, {k1[2], k1[3]}};
                        const f32x2 rq[4] = {{r0[0], r0[1]}, {r0[2], r0[3]}, {r1[0], r1[1]}, {r1[2], r1[3]}};
                        f32x2 t0 = A0[0] * np[0], t1 = A1[0] * np[0];
#pragma unroll
                        for (int q = 1; q < 4; ++q) { t0 = __builtin_elementwise_fma(A0[q], np[q], t0); t1 = __builtin_elementwise_fma(A1[q], np[q], t1); }
                        float sa0 = t0[0] + t0[1], sa1 = t1[0] + t1[1];
                        red8x2(sa0, sa1);
                        const f32x2 s0v = {sa0, sa0}, s1v = {sa1, sa1}, v0v = {vv[0], vv[0]}, v1v = {vv[1], vv[1]};
#pragma unroll
                        for (int q = 0; q < 4; ++q) { A0[q] = __builtin_elementwise_fma(v0v, kp[q], __builtin_elementwise_fma(s0v, bp[q], A0[q] * wp[q])); A1[q] = __builtin_elementwise_fma(v1v, kp[q], __builtin_elementwise_fma(s1v, bp[q], A1[q] * wp[q])); }
                        f32x2 u0 = A0[0] * rq[0], u1 = A1[0] * rq[0];
#pragma unroll
                        for (int q = 1; q < 4; ++q) { u0 = __builtin_elementwise_fma(A0[q], rq[q], u0); u1 = __builtin_elementwise_fma(A1[q], rq[q], u1); }
                        float o0 = u0[0] + u0[1], o1 = u1[0] + u1[1];
                        red8x2(o0, o1);
                        if (cgp == 0) *(f32x2*)(ob + s * 64) = (f32x2){o0, o1};
                    }
                }
                __syncthreads();
            }
        } else {
            const int ht = tid - 256; const int ss0 = ht >> 4, c4 = (ht & 15) * 4; const int ch = h * 64 + c4;
            const f32x4 w0v = *(const f32x4*)(p.in[23] + ch), a0v = *(const f32x4*)(p.in[26] + ch); const f32x4 kkv = *(const f32x4*)(p.in[31] + ch), kav = *(const f32x4*)(p.in[32] + ch), rkv = *(const f32x4*)(p.in[33] + ch), gng = *(const f32x4*)(p.in[34] + ch), gnb = *(const f32x4*)(p.in[35] + ch);
            for (int c = -1; c <= S_ / TC; ++c) {
                const bool do_post = (c >= 1), do_stage = (c + 1 < S_ / TC);
                u32x2 lr[2], lk[2], lv[2], la[2], lg[2]; f32x4 lw[2];
#pragma unroll
                for (int i = 0; i < 2; ++i) {
                    const int ss = ss0 + 16 * i;
                    if (do_stage) { const size_t off = (size_t)(b * S_ + (c + 1) * TC + ss) * D_ + ch; lr[i] = *(const u32x2*)(rbuf + off); lk[i] = *(const u32x2*)(kbuf + off); lv[i] = *(const u32x2*)(vbuf + off); la[i] = *(const u32x2*)(abuf + off); lw[i] = *(const f32x4*)(wdec + off); }
                    if (do_post) { const size_t off = (size_t)(b * S_ + (c - 1) * TC + ss) * D_ + ch; lg[i] = *(const u32x2*)(gbuf + off); }
                }
#pragma unroll
                for (int i = 0; i < 2; ++i) {
                    const int ss = ss0 + 16 * i; const int o = ss * 64 + c4;
                    float* B = bufs + ((c + 1) & 1) * 6 * TC * 64;
                    if (do_post) {
                        const float* obr = obuf + ((c - 1) & 1) * TC * 64;
                        const f32x4 ov = *(const f32x4*)(obr + o), km = *(const f32x4*)(B + 3 * TC * 64 + o), r = *(const f32x4*)(B + 4 * TC * 64 + o), v = *(const f32x4*)(B + 5 * TC * 64 + o);
                        float s1 = ov[0] + ov[1] + ov[2] + ov[3]; s1 = red16(s1); const float mean = s1 * (1.f / 64.f);
                        const f32x4 oc = ov - mean; float s2 = oc[0] * oc[0] + oc[1] * oc[1] + oc[2] * oc[2] + oc[3] * oc[3]; s2 = red16(s2); const float rs = rsqrtf(s2 * (1.f / 64.f) + 64e-5f);
                        const f32x4 rk = r * km * rkv; float bs = rk[0] + rk[1] + rk[2] + rk[3]; bs = red16(bs);
                        const size_t off = (size_t)(b * S_ + (c - 1) * TC + ss) * D_ + ch;
                        f32x4 gg; gg[0] = bf2f(lg[i][0] & 0xffffu); gg[1] = bf2f(lg[i][0] >> 16); gg[2] = bf2f(lg[i][1] & 0xffffu); gg[3] = bf2f(lg[i][1] >> 16);
                        const f32x4 y = (oc * rs * gng + gnb + v * bs) * gg;
                        u32x2 pk; pk[0] = cvt_pk_bf16(y[0], y[1]); pk[1] = cvt_pk_bf16(y[2], y[3]); *(u32x2*)(outb + off) = pk;
                    }
                    if (do_stage) {
                        f32x4 r, k, v, a, wv;
                        r[0] = bf2f(lr[i][0] & 0xffffu); r[1] = bf2f(lr[i][0] >> 16); r[2] = bf2f(lr[i][1] & 0xffffu); r[3] = bf2f(lr[i][1] >> 16);
                        k[0] = bf2f(lk[i][0] & 0xffffu); k[1] = bf2f(lk[i][0] >> 16); k[2] = bf2f(lk[i][1] & 0xffffu); k[3] = bf2f(lk[i][1] >> 16);
                        v[0] = bf2f(lv[i][0] & 0xffffu); v[1] = bf2f(lv[i][0] >> 16); v[2] = bf2f(lv[i][1] & 0xffffu); v[3] = bf2f(lv[i][1] >> 16);
                        a[0] = bf2f(la[i][0] & 0xffffu); a[1] = bf2f(la[i][0] >> 16); a[2] = bf2f(la[i][1] & 0xffffu); a[3] = bf2f(la[i][1] >> 16);
#pragma unroll
                        for (int e = 0; e < 4; ++e) { a[e] = sigmoidf_(a0v[e] + a[e]); const float z = -(w0v[e] + lw[i][e]); const float sp = fmaxf(z, 0.f) + __logf(1.f + __expf(-fabsf(z))); wv[e] = __expf(-__expf(-sp - 0.5f)); }
                        f32x4 kk = k * kkv; float n2 = kk[0] * kk[0] + kk[1] * kk[1] + kk[2] * kk[2] + kk[3] * kk[3]; n2 = red16(n2);
                        const float invn = 1.f / fmaxf(sqrtf(n2), 1e-12f); kk = kk * invn;
                        const f32x4 km = k * ((a - 1.f) * kav + 1.f);
                        *(f32x4*)(B + 0 * TC * 64 + o) = wv; *(f32x4*)(B + 1 * TC * 64 + o) = -kk; *(f32x4*)(B + 2 * TC * 64 + o) = kk * a; *(f32x4*)(B + 3 * TC * 64 + o) = km; *(f32x4*)(B + 4 * TC * 64 + o) = r; *(f32x4*)(B + 5 * TC * 64 + o) = v;
                    }
                }
                __syncthreads();
            }
        }
        __syncthreads();
    }
}

__global__ void __launch_bounds__(512, 2) mega(Params p) {
    extern __shared__ __attribute__((aligned(16))) unsigned char shm[];
    LAS unsigned char* lds = (LAS unsigned char*)shm;
    cg::grid_group grid = cg::this_grid();
    unsigned char* ws = p.ws;
    float* mod = (float*)(ws + WS_MOD); float* X = (float*)(ws + WS_X);
    volatile LAS unsigned* xst = (volatile LAS unsigned*)(lds + LDS_BYTES - 16);
    if (threadIdx.x == 0) { xst[0] = 0u; xst[1] = 0u; xst[2] = 0u; xst[3] = 0u; }
    __syncthreads();
    const XcdBarrier xb = xcd_barrier_post((unsigned*)(ws + WS_BAR + 4096), xst);
    p0_mod(p, shm); p0_rope(p); __syncthreads(); convert_jobs(p, shm, 0, NJOBS_EARLY, (unsigned*)(ws + WS_BAR) + 16);
    if (p.ws == nullptr) grid.sync();
    xcd_barrier(xb);
    __syncthreads();
    int vb; { const unsigned rk = xst[2], xc = xst[3]; vb = (gridDim.x == 256 && rk < 32u && xc < 8u) ? (int)(rk * 8u + xc) : (int)blockIdx.x; asm volatile("" : "+s"(vb)); }
    int vbx; { const unsigned rk = xst[2], xc = xst[3]; vbx = (gridDim.x == 256 && rk < 32u && xc < 8u) ? (int)(xc * 32u + rk) : (int)blockIdx.x; asm volatile("" : "+s"(vbx)); }
    norm_phase(vbx, p.in[0], mod + 0 * 2048, mod + 1 * 2048, (bf16_t*)(ws + WS_HMIX), nullptr, nullptr);
    xcd_barrier(xb);
    { Epi<M_F32> E{}; E.o0 = ws + WS_PROJ; E.ldc = 1024; run_gemm<M_F32>(vb, lds, ws + WS_HMIX, 2048, ws + WS_WT_IN, 2048, T_, 1024, 2048, 0, E); }
    xcd_barrier(xb);
    projrow_phase(p);
    xcd_barrier(xb);
    { Epi<M_QROPE> E{}; E.o0 = ws + WS_QALL; E.ldc = 4096; E.f0 = (const float*)(ws + WS_COSA); E.f1 = (const float*)(ws + WS_SINA); E.f2 = (const float*)(ws + WS_COSI); E.f3 = (const float*)(ws + WS_SINI);
      run_gemm<M_QROPE>(vb, lds, ws + WS_CQ, 512, ws + WS_WT_Q, 512, T_, 4096, 512, 0, E); }
    xcd_barrier(xb);
    { Epi<M_BF16> E{}; E.o0 = ws + WS_QLAT; E.ldc = 4096; run_gemm<M_BF16>(vb, lds, ws + WS_QALL, 4096, ws + WS_WT_UK, 256, T_, 4096, 256, 1, E); }
    scoretopk_phase(p, shm, vbx);
    xcd_barrier(xb);
    attn_phase(p, lds, vbx);
    xcd_barrier(xb);
    { Epi<M_BF16> E{}; E.o0 = ws + WS_O; E.ldc = 2048; run_gemm<M_BF16>(vb, lds, ws + WS_OLAT, 4096, ws + WS_WT_UV, 512, T_, 2048, 512, 2, E); }
    xcd_barrier(xb);
    { Epi<M_RESID> E{}; E.o0 = X; E.f0 = p.in[0]; E.f1 = mod + 2 * 2048; run_gemm<M_RESID>(vb, lds, ws + WS_O, 2048, ws + WS_WT_O, 2048, T_, 2048, 2048, 0, E); }
    xcd_barrier(xb);
    norm_phase(vbx, X, mod + 3 * 2048, mod + 4 * 2048, (bf16_t*)(ws + WS_HFF), nullptr, nullptr);
    xcd_barrier(xb);
    { Epi<M_RELU2> E{}; E.o0 = ws + WS_H1; E.ldc = 8192; run_gemm<M_RELU2>(vb, lds, ws + WS_HFF, 2048, ws + WS_WT_1_0, 2048, T_, 8192, 2048, 0, E); }
    xcd_barrier(xb);
    { Epi<M_RESID> E{}; E.o0 = X; E.f0 = X; E.f1 = mod + 5 * 2048; run_gemm<M_RESID>(vb, lds, ws + WS_H1, 8192, ws + WS_WT_2_0, 8192, T_, 2048, 8192, 0, E); }
    xcd_barrier(xb);
    const float* mod1 = mod + 8 * 12288;
    mix_phase(p, X, mod1 + 0 * 2048, mod1 + 1 * 2048);
    xcd_barrier(xb);
    { Epi<M_L1A> E{}; E.o0 = ws + WS_KBUF; E.o1 = ws + WS_VBUF; E.o2 = ws + WS_MID; E.o3 = ws + WS_MID + 8 * MiB; E.o4 = ws + WS_MID + 16 * MiB;
      run_gemm<M_L1A>(vb, lds, ws + WS_MIX + 64 * MiB, 2048, (bf16_t*)(ws + WS_WT_RKV) + (size_t)2048 * 2048, 2048, T_, 4864, 2048, 3, E); }
    xcd_barrier(xb);
    { Epi<M_BF16> E{}; E.o0 = ws + WS_RBUF; E.ldc = 2048; run_gemm<M_BF16>(vb, lds, ws + WS_MIX, 2048, ws + WS_WT_RKV, 2048, T_, 2048, 2048, 0, E); }
    { Epi<M_F32> E{}; E.o0 = ws + WS_WDEC; E.ldc = 2048; run_gemm<M_F32>(vb, lds, ws + WS_MID, 256, ws + WS_WT_L2, 256, T_, 2048, 256, 0, E); }
    { Epi<M_BF16> E{}; E.o0 = ws + WS_ABUF; E.ldc = 2048; run_gemm<M_BF16>(vb, lds, ws + WS_MID + 8 * MiB, 256, (bf16_t*)(ws + WS_WT_L2) + (size_t)2048 * 256, 256, T_, 2048, 256, 0, E); }
    { Epi<M_BF16> E{}; E.o0 = ws + WS_GBUF; E.ldc = 2048; run_gemm<M_BF16>(vb, lds, ws + WS_MID + 16 * MiB, 256, (bf16_t*)(ws + WS_WT_L2) + (size_t)4096 * 256, 256, T_, 2048, 256, 0, E); }
    xcd_barrier(xb);
    scan_phase(p, shm);
    xcd_barrier(xb);
    { Epi<M_RESID> E{}; E.o0 = X; E.f0 = X; E.f1 = mod1 + 2 * 2048; run_gemm<M_RESID>(vb, lds, ws + WS_SCANOUT, 2048, ws + WS_WT_BO, 2048, T_, 2048, 2048, 0, E); }
    xcd_barrier(xb);
    norm_phase(vbx, X, mod1 + 3 * 2048, mod1 + 4 * 2048, (bf16_t*)(ws + WS_HFF), nullptr, nullptr);
    __syncthreads(); convert_jobs(p, shm, NJOBS_EARLY, NJOBS_ALL, (unsigned*)(ws + WS_BAR) + 32);
    xcd_barrier(xb);
    { Epi<M_RELU2> E{}; E.o0 = ws + WS_H1; E.ldc = 8192; run_gemm<M_RELU2>(vb, lds, ws + WS_HFF, 2048, ws + WS_WT_1_1, 2048, T_, 8192, 2048, 0, E); }
    xcd_barrier(xb);
    { Epi<M_RESID> E{}; E.o0 = X; E.f0 = X; E.f1 = mod1 + 5 * 2048; run_gemm<M_RESID>(vb, lds, ws + WS_H1, 8192, ws + WS_WT_2_1, 8192, T_, 2048, 8192, 0, E); }
    xcd_barrier(xb);
    norm_phase(vbx, X, nullptr, nullptr, nullptr, p.out, p.in[7]);
}

extern "C" void kernel_launch(void* const* d_in, const int* in_sizes, int n_in, void* d_out, int out_size, void* d_ws, size_t ws_size, hipStream_t stream) {
    static int grid = 0;
    if (grid == 0) {
        int dev = 0, cus = 0, per_cu = 0;
        hipGetDevice(&dev); hipDeviceGetAttribute(&cus, hipDeviceAttributeMultiprocessorCount, dev);
        if (hipFuncSetAttribute((const void*)mega, hipFuncAttributeMaxDynamicSharedMemorySize, LDS_BYTES) != hipSuccess) fprintf(stderr, "hipFuncSetAttribute failed\n");
        hipOccupancyMaxActiveBlocksPerMultiprocessor(&per_cu, (const void*)mega, 512, LDS_BYTES);
        if (per_cu < 1) per_cu = 1;
        grid = cus * 1;
        (void)hipGetLastError();
    }
    Params p{};
    for (int i = 0; i < 36; ++i) p.in[i] = (const float*)d_in[i];
    p.out = (float*)d_out; p.ws = (unsigned char*)d_ws;
    (void)hipMemsetAsync((unsigned char*)d_ws + WS_BAR, 0, 32768, stream);
    void* args[] = {&p};
    hipError_t e = hipLaunchCooperativeKernel((const void*)mega, dim3(grid), dim3(512), args, LDS_BYTES, stream);
    if (e != hipSuccess) fprintf(stderr, "cooperative launch failed: %s (grid %d)\n", hipGetErrorString(e), grid);
}
```

```cpp
#include <hip/hip_runtime.h>
#include <hip/hip_cooperative_groups.h>
#include <cstdio>
#include <cstdint>
namespace cg = cooperative_groups;

#define LAS __attribute__((address_space(3)))
typedef unsigned short bf16_t;
typedef short bf16x8 __attribute__((ext_vector_type(8)));
typedef short s16x4 __attribute__((ext_vector_type(4)));
typedef float f32x4 __attribute__((ext_vector_type(4)));
typedef float f32x16 __attribute__((ext_vector_type(16)));
typedef unsigned u32x4 __attribute__((ext_vector_type(4)));
typedef unsigned u32x2 __attribute__((ext_vector_type(2)));

constexpr int T_ = 16384, D_ = 2048, S_ = 2048, FF_ = 8192;
constexpr size_t MiB = 1048576;
constexpr size_t WS_MOD = 0, WS_COSA = 1 * MiB, WS_SINA = 3 * MiB, WS_COSI = 5 * MiB, WS_SINI = 6 * MiB, WS_CNT = 7 * MiB;
constexpr size_t WS_X = 8 * MiB;
constexpr size_t WS_WT_RKV = 136 * MiB, WS_WT_L2 = 163 * MiB, WS_WT_BO = 166 * MiB;
constexpr size_t WS_WT_IN = 174 * MiB, WS_WT_Q = 178 * MiB, WS_WT_UK = 182 * MiB, WS_WT_UV = 184 * MiB, WS_WT_O = 186 * MiB, WS_WT_1_0 = 194 * MiB, WS_WT_2_0 = 226 * MiB;
constexpr size_t WS_HMIX = 258 * MiB, WS_PROJ = 322 * MiB, WS_SCORES = 258 * MiB, WS_OLAT = 258 * MiB, WS_QALL = 386 * MiB, WS_O = 386 * MiB, WS_QLAT = 514 * MiB;
constexpr size_t WS_CQ = 642 * MiB, WS_KEYS = 658 * MiB, WS_KIDX = 668 * MiB, WS_WIDX = 670 * MiB, WS_SEL = 671 * MiB;
constexpr size_t WS_HFF = 258 * MiB, WS_H1 = 322 * MiB;
constexpr size_t WS_MIX = 258 * MiB;
constexpr size_t WS_KBUF = 174 * MiB, WS_VBUF = 642 * MiB, WS_MID = 706 * MiB;
constexpr size_t WS_RBUF = 322 * MiB, WS_WDEC = 450 * MiB, WS_ABUF = 578 * MiB, WS_GBUF = 386 * MiB, WS_SCANOUT = 258 * MiB;
constexpr size_t WS_WT_1_1 = 578 * MiB, WS_WT_2_1 = 610 * MiB;
constexpr int LDS_BYTES = 147520;

struct Params { const float* in[36]; float* out; unsigned char* ws; };

__device__ __forceinline__ bf16_t f2bf(float f) { unsigned u = __float_as_uint(f); u += 0x7FFFu + ((u >> 16) & 1u); return (bf16_t)(u >> 16); }
__device__ __forceinline__ float bf2f(unsigned b) { return __uint_as_float(b << 16); }
__device__ __forceinline__ unsigned cvt_pk_bf16(float lo, float hi) { unsigned r; asm volatile("v_cvt_pk_bf16_f32 %0, %1, %2" : "=v"(r) : "v"(lo), "v"(hi)); return r; }
__device__ __forceinline__ float dpp_f(float x, const int ctrl_sel) {
    const int v = __builtin_bit_cast(int, x); int r;
    if (ctrl_sel == 0) r = __builtin_amdgcn_update_dpp(0, v, 0xB1, 0xF, 0xF, true);
    else if (ctrl_sel == 1) r = __builtin_amdgcn_update_dpp(0, v, 0x4E, 0xF, 0xF, true);
    else if (ctrl_sel == 2) r = __builtin_amdgcn_update_dpp(0, v, 0x141, 0xF, 0xF, true);
    else r = __builtin_amdgcn_update_dpp(0, v, 0x140, 0xF, 0xF, true);
    return __builtin_bit_cast(float, r);
}
__device__ __forceinline__ int otid() { int t = threadIdx.x; asm volatile("" : "+v"(t)); return t; }
__device__ __forceinline__ int obid() { int t = blockIdx.x; asm volatile("" : "+s"(t)); return t; }
__device__ __forceinline__ int ogrid() { int t = gridDim.x; asm volatile("" : "+s"(t)); return t; }
constexpr size_t WS_BAR = 7 * MiB + 512 * 1024;
__device__ __forceinline__ void fast_sync(unsigned* ctr, unsigned& target, unsigned nblk) {
    target += nblk;
    asm volatile("s_waitcnt vmcnt(0) lgkmcnt(0)" ::: "memory");
    __syncthreads();
    if (threadIdx.x == 0) {
        __builtin_amdgcn_fence(__ATOMIC_RELEASE, "agent");
        asm volatile("s_waitcnt vmcnt(0)" ::: "memory");
        __hip_atomic_fetch_add(ctr, 1u, __ATOMIC_RELAXED, __HIP_MEMORY_SCOPE_AGENT);
        while (__hip_atomic_load(ctr, __ATOMIC_RELAXED, __HIP_MEMORY_SCOPE_AGENT) < target) __builtin_amdgcn_s_sleep(2);
        __builtin_amdgcn_fence(__ATOMIC_ACQUIRE, "agent");
        asm volatile("s_waitcnt vmcnt(0)" ::: "memory");
    }
    __syncthreads();
}

#define XB_TMO      128
#define XB_XCNT(j)  (256  + 64 * (j))
#define XB_XSUB(j)  (1280 + 64 * (j))
#define XB_XGEN(j)  (2304 + 64 * (j))
#define XB_TOP      3328
#define XB_TOPGEN   3392
#define XCD_BAR_WORDS 3456
#define XB_SPIN_CAP (1u << 22)
__device__ __forceinline__ unsigned xb_ld(unsigned* p)              { return __hip_atomic_load(p, __ATOMIC_RELAXED, __HIP_MEMORY_SCOPE_AGENT); }
__device__ __forceinline__ unsigned xb_add(unsigned* p, unsigned v) { return __hip_atomic_fetch_add(p, v, __ATOMIC_RELAXED, __HIP_MEMORY_SCOPE_AGENT); }
__device__ __forceinline__ unsigned xb_xcc_id() { return (unsigned)__builtin_amdgcn_s_getreg((3 << 11) | 20) & 0xFu; }
#define XB_SPIN(cond, bar) do { unsigned _sp = 0; while (cond) { __builtin_amdgcn_s_sleep(1); \
    if ((++_sp & 255u) == 0u) { if (xb_ld(&(bar)[XB_TMO])) break; if (_sp > XB_SPIN_CAP) { atomicAdd(&(bar)[XB_TMO], 1u); break; } } } } while (0)
struct XcdBarrier { unsigned* bar; unsigned x; volatile LAS unsigned* st; };
__device__ __forceinline__ XcdBarrier xcd_barrier_post(unsigned* bar, volatile LAS unsigned* st) {
    XcdBarrier b; b.bar = bar; b.x = xb_xcc_id(); b.st = st;
    if (threadIdx.x == 0) { const unsigned rank = xb_add(&bar[XB_XCNT(b.x)], 1u); st[2] = rank; st[3] = b.x; }
    return b;
}
__device__ __forceinline__ void xcd_barrier_complete(unsigned* bar, unsigned x, unsigned& nloc, unsigned& nx) {
    const unsigned G = gridDim.x * gridDim.y * gridDim.z;
    unsigned sum, cnt, mine, sp = 0u;
    for (;;) {
        sum = 0u; cnt = 0u; mine = 0u;
#pragma unroll
        for (unsigned j = 0; j < 16; ++j) { const unsigned c = xb_ld(&bar[XB_XCNT(j)]); sum += c; cnt += (c > 0u) ? 1u : 0u; mine = (j == x) ? c : mine; }
        if (sum == G) break;
        __builtin_amdgcn_s_sleep(1);
        if ((++sp & 255u) == 0u) { if (xb_ld(&bar[XB_TMO])) break; if (sp > XB_SPIN_CAP) { atomicAdd(&bar[XB_TMO], 1u); break; } }
    }
    nloc = mine > 0u ? mine : 1u; nx = cnt > 0u ? cnt : 1u;
}
__device__ __forceinline__ void xcd_barrier(const XcdBarrier& b) {
    asm volatile("s_waitcnt vmcnt(0)" ::: "memory");
    __syncthreads();
    if (threadIdx.x == 0) {
        unsigned* bar = b.bar;
        __builtin_amdgcn_s_waitcnt(0);
        unsigned nloc = b.st[0], nx = b.st[1];
        if (nloc == 0u) { xcd_barrier_complete(bar, b.x, nloc, nx); b.st[0] = nloc; b.st[1] = nx; }
        const unsigned old = xb_add(&bar[XB_XSUB(b.x)], 1u);
        const unsigned gen = old / nloc;
        if (old + 1u == (gen + 1u) * nloc) {
            __builtin_amdgcn_fence(__ATOMIC_RELEASE, "agent");
            asm volatile("s_waitcnt vmcnt(0)" ::: "memory");
            const unsigned og = xb_add(&bar[XB_TOP], 1u);
            const unsigned tg = og / nx;
            if (og + 1u == (tg + 1u) * nx) xb_add(&bar[XB_TOPGEN], 1u);
            else XB_SPIN(xb_ld(&bar[XB_TOPGEN]) == tg, bar);
            __builtin_amdgcn_fence(__ATOMIC_ACQUIRE, "agent");
            xb_add(&bar[XB_XGEN(b.x)], 1u);
            asm volatile("s_waitcnt vmcnt(0)" ::: "memory");
        } else {
            XB_SPIN(xb_ld(&bar[XB_XGEN(b.x)]) == gen, bar);
            __builtin_amdgcn_fence(__ATOMIC_ACQUIRE, "agent");
            asm volatile("s_waitcnt vmcnt(0)" ::: "memory");
        }
    }
    __syncthreads();
}
__device__ __forceinline__ float red8(float x) { x += dpp_f(x, 0); x += dpp_f(x, 1); x += dpp_f(x, 2); return x; }
__device__ __forceinline__ float red16(float x) { x = red8(x); x += dpp_f(x, 3); return x; }
__device__ __forceinline__ float red64(float x) { x = red16(x); x += __shfl_xor(x, 16); x += __shfl_xor(x, 32); return x; }

namespace pg8 {
constexpr int BM = 256, BK = 64, HALF = 128, HTB = HALF * BK * 2, STAGE_BYTES = 8 * HTB, NXCD = 8, WGM = 8;
__device__ __forceinline__ int lds_byte(int r, int c) { const int st = (r >> 4) * 2 + (c >> 5), rr = r & 15, cc = c & 31, ob = rr * 64 + cc * 2; return st * 1024 + (ob ^ (((ob >> 9) & 1) << 5)); }
__device__ __forceinline__ void stage_rc(int b, int& R, int& C) { const int st = b / 1024, sb = b % 1024, swz = sb ^ (((sb >> 9) & 1) << 5); R = (st >> 1) * 16 + swz / 64; C = (st & 1) * 32 + (swz % 64) / 2; }
__device__ __forceinline__ int perm32(int rho) { const int n = rho >> 4, i = rho & 15; return 8 * (i >> 2) + 4 * n + (i & 3); }
struct Unit { int pm, pn; };
struct Gemm { const bf16_t* A; const bf16_t* Bt; int M, N, K, lda, ldb, amode; };
__device__ __forceinline__ size_t a_off_bytes(const Gemm& g, int pn) {
    switch (g.amode) {
        case 1: return (size_t)(pn >> 1) * 256 * 2;
        case 2: return (size_t)pn * 512 * 2;
        case 3: return (size_t)(pn < 16 ? (pn >> 3) : (pn - 14)) * ((size_t)T_ * D_ * 2);
        case 4: return (size_t)(pn >> 3) * ((size_t)T_ * 256 * 2);
        default: return 0;
    }
}
struct StaticOrder {
    int nM, nN, nwg, G, c;
    __device__ void init(int M, int N, int G_, int c_) { nM = M / BM; nN = N / BM; nwg = nM * nN; G = G_; c = c_; }
    __device__ bool next(int i, Unit& u) const {
        const long L = (long)i * G + c; if (L >= nwg) return false;
        int wgid = (int)L; { const int q = nwg / NXCD, r = nwg % NXCD, xcd = wgid % NXCD, off = wgid / NXCD; wgid = (xcd < r ? xcd * (q + 1) : r * (q + 1) + (xcd - r) * q) + off; }
        const int nig = WGM * nN, gid = wgid / nig, fm = gid * WGM, gsz = (nM - fm) < WGM ? (nM - fm) : WGM;
        u.pm = fm + ((wgid % nig) % gsz); u.pn = (wgid % nig) / gsz; return true;
    }
};

template <class Epi>
__device__ __forceinline__ void gemm_phase(LAS unsigned char* lds, const Gemm g, const StaticOrder& S, const Epi& E) {
    const int tid = otid(), wid = __builtin_amdgcn_readfirstlane(tid >> 6), lane = tid & 63, wr = wid >> 2, wc = wid & 3, fr = lane & 15, fq = lane >> 4;
    const int K = g.K, nt = K / BK;
    unsigned voffA[2], voffB[2];
#pragma unroll
    for (int i = 0; i < 2; ++i) { int R, C; stage_rc(tid * 16 + i * 8192, R, C); const int Rb = (R & ~31) + perm32(R & 31);
        voffA[i] = (unsigned)(R * g.lda + C) * 2u; voffB[i] = (unsigned)(Rb * g.ldb + C) * 2u; }
    const size_t kstep = (size_t)(BK * 2);
    const size_t hstepA = (size_t)HALF * g.lda * 2, hstepB = (size_t)HALF * g.ldb * 2;
    const size_t tstepA = 2 * hstepA, tstepB = 2 * hstepB;
    const unsigned ldsw = (unsigned)wid * 1024u;
    const int aoff = lds_byte(wr * 64 + fr, fq * 8), boff = lds_byte(wc * 32 + fr, fq * 8);
#define PG8_SA(b, h) (((b) * 2 + (h)) * HTB)
#define PG8_SB(b, h) ((4 + (b) * 2 + (h)) * HTB)
#define PG8_STAGE(bufoff, gbase, voff) do { _Pragma("unroll") for (int _i = 0; _i < 2; ++_i) \
        __builtin_amdgcn_global_load_lds((const unsigned*)((const char*)(gbase) + (voff)[_i]), (LAS unsigned*)(lds + (bufoff) + ldsw + _i * 8192), 16, 0, 0); } while (0)
#define PG8_LDA(dst, b, h) do { _Pragma("unroll") for (int m = 0; m < 4; ++m) _Pragma("unroll") for (int k = 0; k < 2; ++k) dst[m][k] = *(const LAS bf16x8*)(lds + PG8_SA(b, h) + aoff + m * 2048 + k * 1024); } while (0)
#define PG8_LDB(dst, b, h) do { _Pragma("unroll") for (int n = 0; n < 2; ++n) _Pragma("unroll") for (int k = 0; k < 2; ++k) dst[n][k] = *(const LAS bf16x8*)(lds + PG8_SB(b, h) + boff + n * 2048 + k * 1024); } while (0)
#define PG8_MMA(ai, bj, At, Bt) do { __builtin_amdgcn_s_setprio(1); _Pragma("unroll") for (int m = 0; m < 4; ++m) _Pragma("unroll") for (int n = 0; n < 2; ++n) _Pragma("unroll") for (int k = 0; k < 2; ++k) \
        acc[ai][bj][m][n] = __builtin_amdgcn_mfma_f32_16x16x32_bf16(Bt[n][k], At[m][k], acc[ai][bj][m][n], 0, 0, 0); __builtin_amdgcn_s_setprio(0); } while (0)
#define PG8_WAIT_V(n) asm volatile("s_waitcnt vmcnt(" #n ")" ::: "memory")
#define PG8_WAIT_L(n) asm volatile("s_waitcnt lgkmcnt(" #n ")" ::: "memory")
#define PG8_BAR __builtin_amdgcn_s_barrier()
#define PG8_SCHED __builtin_amdgcn_sched_barrier(0)
    Unit cur, nxt; int ui = 0;
    if (!S.next(0, cur)) return;
    f32x4 acc[2][2][4][2];
#pragma unroll
    for (int a = 0; a < 2; ++a)
#pragma unroll
        for (int b = 0; b < 2; ++b)
#pragma unroll
            for (int m = 0; m < 4; ++m)
#pragma unroll
                for (int n = 0; n < 2; ++n) acc[a][b][m][n] = (f32x4){0.f, 0.f, 0.f, 0.f};
    bf16x8 At[4][2], B0[2][2], B1[2][2];
    const char* cA = (const char*)g.A + (size_t)cur.pm * tstepA + a_off_bytes(g, cur.pn); const char* cB = (const char*)g.Bt + (size_t)cur.pn * tstepB;
    PG8_STAGE(PG8_SB(0, 0), cB, voffB); PG8_STAGE(PG8_SA(0, 0), cA, voffA); PG8_STAGE(PG8_SB(0, 1), cB + hstepB, voffB); PG8_STAGE(PG8_SA(0, 1), cA + hstepA, voffA);
    if (wr == 1) PG8_BAR;
    PG8_WAIT_V(4); PG8_BAR;
    PG8_STAGE(PG8_SB(1, 0), cB + kstep, voffB); PG8_STAGE(PG8_SA(1, 0), cA + kstep, voffA); PG8_STAGE(PG8_SB(1, 1), cB + hstepB + kstep, voffB);
    PG8_WAIT_V(6); PG8_BAR;
    for (;;) {
        const bool has_next = S.next(ui + 1, nxt);
        const char* nA = has_next ? (const char*)g.A + (size_t)nxt.pm * tstepA + a_off_bytes(g, nxt.pn) : cA; const char* nB = has_next ? (const char*)g.Bt + (size_t)nxt.pn * tstepB : cB;
        for (int t = 0; t < nt; t += 2) {
            const bool last = (t == nt - 2);
            const char* a1 = cA + (size_t)(t + 1) * kstep;
            const char* a2 = last ? nA : cA + (size_t)(t + 2) * kstep; const char* b2 = last ? nB : cB + (size_t)(t + 2) * kstep;
            const char* a3 = a2 + kstep; const char* b3 = b2 + kstep;
            PG8_LDB(B0, 0, 0); PG8_SCHED; PG8_LDA(At, 0, 0); PG8_STAGE(PG8_SA(1, 1), a1 + hstepA, voffA);
            PG8_WAIT_L(8); PG8_BAR; PG8_WAIT_L(0); PG8_MMA(0, 0, At, B0); PG8_BAR; PG8_SCHED;
            PG8_LDB(B1, 0, 1); PG8_STAGE(PG8_SB(0, 0), b2, voffB);
            PG8_BAR; PG8_WAIT_L(0); PG8_MMA(0, 1, At, B1); PG8_BAR;
            PG8_LDA(At, 0, 1); PG8_STAGE(PG8_SA(0, 0), a2, voffA);
            PG8_BAR; PG8_WAIT_L(0); PG8_MMA(1, 0, At, B0); PG8_BAR; PG8_SCHED;
            PG8_STAGE(PG8_SB(0, 1), b2 + hstepB, voffB);
            PG8_WAIT_V(6); PG8_BAR; PG8_MMA(1, 1, At, B1); PG8_BAR;
            PG8_LDB(B0, 1, 0); PG8_SCHED; PG8_LDA(At, 1, 0); PG8_STAGE(PG8_SA(0, 1), a2 + hstepA, voffA);
            PG8_WAIT_L(8); PG8_BAR; PG8_WAIT_L(0); PG8_MMA(0, 0, At, B0); PG8_BAR; PG8_SCHED;
            PG8_LDB(B1, 1, 1); PG8_STAGE(PG8_SB(1, 0), b3, voffB);
            PG8_BAR; PG8_WAIT_L(0); PG8_MMA(0, 1, At, B1); PG8_BAR;
            PG8_LDA(At, 1, 1); PG8_STAGE(PG8_SA(1, 0), a3, voffA);
            PG8_BAR; PG8_WAIT_L(0); PG8_MMA(1, 0, At, B0); PG8_BAR; PG8_SCHED;
            PG8_STAGE(PG8_SB(1, 1), b3 + hstepB, voffB);
            PG8_WAIT_V(6); PG8_BAR; PG8_MMA(1, 1, At, B1); PG8_BAR;
        }
        E(acc, cur, wr, wc, fr, fq);
        if (!has_next) break;
#pragma unroll
        for (int a = 0; a < 2; ++a)
#pragma unroll
            for (int b = 0; b < 2; ++b)
#pragma unroll
                for (int m = 0; m < 4; ++m)
#pragma unroll
                    for (int n = 0; n < 2; ++n) acc[a][b][m][n] = (f32x4){0.f, 0.f, 0.f, 0.f};
        cur = nxt; cA = nA; cB = nB; ++ui;
    }
    PG8_WAIT_V(0);
    if (wr == 0) PG8_BAR;
    PG8_BAR;
#undef PG8_SA
#undef PG8_SB
#undef PG8_STAGE
#undef PG8_LDA
#undef PG8_LDB
#undef PG8_MMA
#undef PG8_WAIT_V
#undef PG8_WAIT_L
#undef PG8_BAR
#undef PG8_SCHED
}
}

enum { M_F32 = 0, M_BF16 = 1, M_QROPE = 2, M_RESID = 3, M_RELU2 = 4, M_L1A = 5, M_L1B = 6 };
__device__ __forceinline__ float sigmoidf_(float x) { return 1.f / (1.f + __expf(-x)); }
__device__ __forceinline__ float tanhf_(float x) { const float e = __expf(-2.f * fabsf(x)); const float t = (1.f - e) / (1.f + e); return x < 0.f ? -t : t; }
__device__ __forceinline__ void st_bf16x8(bf16_t* p, const f32x4& a, const f32x4& b) {
    u32x4 o; o[0] = cvt_pk_bf16(a[0], a[1]); o[1] = cvt_pk_bf16(a[2], a[3]); o[2] = cvt_pk_bf16(b[0], b[1]); o[3] = cvt_pk_bf16(b[2], b[3]); *(u32x4*)p = o;
}
template <int MODE> struct Epi {
    void* o0; void* o1; void* o2; void* o3; void* o4; const float* f0; const float* f1; const float* f2; const float* f3; int ldc;
    __device__ __forceinline__ void operator()(const f32x4 (&acc)[2][2][4][2], const pg8::Unit& u, int wr, int wc, int fr, int fq) const {
        const int row0 = u.pm * 256 + wr * 64 + fr, colb = u.pn * 256 + wc * 32 + 8 * fq;
#pragma unroll
        for (int ai = 0; ai < 2; ++ai)
#pragma unroll
            for (int m = 0; m < 4; ++m) {
                const int row = row0 + ai * 128 + m * 16;
#pragma unroll
                for (int bj = 0; bj < 2; ++bj) {
                    const int col = colb + bj * 128;
                    f32x4 v0 = acc[ai][bj][m][0], v1 = acc[ai][bj][m][1];
                    if constexpr (MODE == M_F32) {
                        float* dst = (float*)o0 + (size_t)row * ldc + col; *(f32x4*)dst = v0; *(f32x4*)(dst + 4) = v1;
                    } else if constexpr (MODE == M_BF16) {
                        st_bf16x8((bf16_t*)o0 + (size_t)row * ldc + col, v0, v1);
                    } else if constexpr (MODE == M_QROPE) {
                        if (u.pn >= 8) {
                            const bool isq = u.pn < 12; const int gpar = wc & 1;
                            if (isq || gpar == 0) {
                                const float* ct = isq ? f0 + (size_t)row * 32 + gpar * 16 + 4 * fq : f2 + (size_t)row * 16 + 4 * fq;
                                const float* st = isq ? f1 + (size_t)row * 32 + gpar * 16 + 4 * fq : f3 + (size_t)row * 16 + 4 * fq;
                                const f32x4 c = *(const f32x4*)ct, s = *(const f32x4*)st;
                                const f32x4 a = v0 * c - v1 * s, b = v1 * c + v0 * s; v0 = a; v1 = b;
                            }
                        }
                        st_bf16x8((bf16_t*)o0 + (size_t)row * ldc + col, v0, v1);
                    } else if constexpr (MODE == M_RESID) {
                        const int b = row >> 11;
                        const float* gp = f1 + (size_t)b * 12288 + col; const float* xin = f0 + (size_t)row * D_ + col;
                        const f32x4 g0 = *(const f32x4*)gp, g1 = *(const f32x4*)(gp + 4), x0 = *(const f32x4*)xin, x1 = *(const f32x4*)(xin + 4);
                        float* dst = (float*)o0 + (size_t)row * D_ + col; *(f32x4*)dst = x0 + g0 * v0; *(f32x4*)(dst + 4) = x1 + g1 * v1;
                    } else if constexpr (MODE == M_RELU2) {
#pragma unroll
                        for (int i = 0; i < 4; ++i) { float a = fmaxf(v0[i], 0.f), b = fmaxf(v1[i], 0.f); v0[i] = a * a; v1[i] = b * b; }
                        st_bf16x8((bf16_t*)o0 + (size_t)row * ldc + col, v0, v1);
                    } else if constexpr (MODE == M_L1A) {
                        if (u.pn < 16) { bf16_t* base = (bf16_t*)(u.pn < 8 ? o0 : o1); st_bf16x8(base + (size_t)row * D_ + (col & 2047), v0, v1); }
                        else {
                            bf16_t* base = (bf16_t*)(u.pn == 16 ? o2 : (u.pn == 17 ? o3 : o4));
                            if (u.pn == 16) {
#pragma unroll
                                for (int i = 0; i < 4; ++i) { v0[i] = tanhf_(v0[i]); v1[i] = tanhf_(v1[i]); }
                            } else if (u.pn == 18) {
#pragma unroll
                                for (int i = 0; i < 4; ++i) { v0[i] = sigmoidf_(v0[i]); v1[i] = sigmoidf_(v1[i]); }
                            }
                            st_bf16x8(base + (size_t)row * 256 + (col & 255), v0, v1);
                        }
                    } else if constexpr (MODE == M_L1B) {
                        const int c = col & 2047;
                        if (u.pn < 8) { float* dst = (float*)o0 + (size_t)row * D_ + c; *(f32x4*)dst = v0; *(f32x4*)(dst + 4) = v1; }
                        else if (u.pn < 16) { st_bf16x8((bf16_t*)o1 + (size_t)row * D_ + c, v0, v1);
                        } else st_bf16x8((bf16_t*)o2 + (size_t)row * D_ + c, v0, v1);
                    }
                }
            }
    }
};
template <int MODE> __device__ __forceinline__ void run_gemm(int vbid, LAS unsigned char* lds, const void* A, int lda, const void* Bt, int ldb, int M, int N, int K, int amode, const Epi<MODE>& E) {
    pg8::Gemm g; g.A = (const bf16_t*)A; g.Bt = (const bf16_t*)Bt; g.M = M; g.N = N; g.K = K; g.lda = lda; g.ldb = ldb; g.amode = amode;
    pg8::StaticOrder S; S.init(M, N, ogrid(), vbid);
    pg8::gemm_phase<Epi<MODE>>(lds, g, S, E);
}

__device__ __forceinline__ void p0_mod(const Params& p, unsigned char* shm) {
    const int bid = obid(), nb = ogrid();
    if (bid >= 384) return;
    float* cact = (float*)shm; float* red = cact + 8 * 2048;
    const int tid = otid(), wid = tid >> 6, lane = tid & 63;
    for (int i = tid; i < 8 * 2048; i += 512) { const float v = p.in[1][i]; cact[i] = v / (1.f + __expf(-v)); }
    __syncthreads();
    float* mod = (float*)(p.ws + WS_MOD);
    for (int item = bid; item < 384; item += nb) {
        const int l = item / 192, c0 = (item % 192) * 64;
        const float* W = p.in[3] + (size_t)l * 2048 * 12288 + c0 + lane;
        float acc[8];
#pragma unroll
        for (int b = 0; b < 8; ++b) acc[b] = 0.f;
        const int k0 = wid * 256;
#pragma unroll 16
        for (int k = 0; k < 256; ++k) {
            const float wv = W[(size_t)(k0 + k) * 12288];
#pragma unroll
            for (int b = 0; b < 8; ++b) acc[b] += cact[b * 2048 + k0 + k] * wv;
        }
#pragma unroll
        for (int b = 0; b < 8; ++b) red[(wid * 8 + b) * 64 + lane] = acc[b];
        __syncthreads();
        { const int b = tid >> 6; float s = 0.f;
#pragma unroll
          for (int w = 0; w < 8; ++w) s += red[(w * 8 + b) * 64 + lane];
          mod[(size_t)(l * 8 + b) * 12288 + c0 + lane] = s + p.in[4][l * 12288 + c0 + lane]; }
        __syncthreads();
    }
}
__device__ __forceinline__ void p0_rope(const Params& p) {
    float* cosA = (float*)(p.ws + WS_COSA); float* sinA = (float*)(p.ws + WS_SINA); float* cosI = (float*)(p.ws + WS_COSI); float* sinI = (float*)(p.ws + WS_SINI);
    const int* pos = (const int*)p.in[2];
    const int nb_ = ogrid(); for (int i = obid() * 512 + otid(); i < T_ * 32; i += nb_ * 512) {
        const int t = i >> 5, f = i & 31; const float ps = (float)pos[t];
        { const float inv = 1.0f / powf(10000.f, (float)(2 * f) / 64.f); const float ang = ps * inv; const double a = (double)ang; const double k = rint(a * 0.15915494309189535);
          const float r = (float)(a - k * 6.283185307179586); cosA[i] = __cosf(r); sinA[i] = __sinf(r); }
        if (f < 16) { const float inv = 1.0f / powf(10000.f, (float)(2 * f) / 32.f); const float ang = ps * inv; const double a = (double)ang; const double k = rint(a * 0.15915494309189535);
          const float r = (float)(a - k * 6.283185307179586); cosI[t * 16 + f] = __cosf(r); sinI[t * 16 + f] = __sinf(r); }
    }
}
__device__ __forceinline__ int ropeperm(int j) { const int half = j >> 5, f = j & 31; return (f >> 4) * 32 + 8 * ((f & 15) >> 2) + 4 * half + (f & 3); }
__device__ __forceinline__ int idxperm(int j) { if (j >= 32) return j; const int half = j >> 4, f = j & 15; return 8 * (f >> 2) + 4 * half + (f & 3); }

struct Job { const float* src; bf16_t* dst; int modeC, sK, sN, skst, snst, dN, dK, dld, k0, nblk, kblk, rowmap; };
__device__ __forceinline__ Job mkjob(const float* src, void* dst, int sK, int sN, int skst, int dN, int dK) {
    Job J; J.src = src; J.dst = (bf16_t*)dst; J.modeC = 0; J.sK = sK; J.sN = sN; J.skst = skst; J.snst = 1; J.dN = dN; J.dK = dK; J.dld = dK; J.k0 = 0; J.nblk = 1 << 30; J.kblk = 0; J.rowmap = 0; return J;
}
constexpr int NJOBS_EARLY = 40, NJOBS_ALL = 42;
__device__ __forceinline__ Job get_job(const Params& p, int j) {
    unsigned char* ws = p.ws;
    if (j == 0) return mkjob(p.in[8], ws + WS_WT_IN, 2048, 912, 912, 1024, 2048);
    if (j == 1) { Job J = mkjob(p.in[11], ws + WS_WT_Q, 512, 3072, 3072, 3072, 512); J.rowmap = 1; return J; }
    if (j == 2) { Job J = mkjob(p.in[12], ws + WS_WT_Q, 512, 1024, 1024, 1024, 512); J.rowmap = 2; return J; }
    if (j < 19) { const int h = j - 3; Job J = mkjob(p.in[15] + h * 128, (bf16_t*)(ws + WS_WT_UK) + (size_t)h * 256 * 256, 128, 256, 1, 256, 256); J.modeC = 1; J.snst = 2048; J.k0 = (h & 1) * 128; return J; }
    if (j < 27) { const int hp = j - 19; Job J = mkjob(p.in[16] + hp * 256, (bf16_t*)(ws + WS_WT_UV) + (size_t)hp * 256 * 512, 256, 256, 2048, 256, 512); J.nblk = 128; J.kblk = 256; return J; }
    if (j == 27) return mkjob(p.in[17], ws + WS_WT_O, 2048, 2048, 2048, 2048, 2048);
    if (j == 28) return mkjob(p.in[5], ws + WS_WT_1_0, 2048, 8192, 8192, 8192, 2048);
    if (j == 29) return mkjob(p.in[6], ws + WS_WT_2_0, 8192, 2048, 2048, 2048, 8192);
    if (j == 30) return mkjob(p.in[19], (bf16_t*)(ws + WS_WT_RKV), 2048, 2048, 2048, 2048, 2048);
    if (j == 31) return mkjob(p.in[20], (bf16_t*)(ws + WS_WT_RKV) + (size_t)2048 * 2048, 2048, 2048, 2048, 2048, 2048);
    if (j == 32) return mkjob(p.in[21], (bf16_t*)(ws + WS_WT_RKV) + (size_t)4096 * 2048, 2048, 2048, 2048, 2048, 2048);
    if (j == 33) return mkjob(p.in[24], (bf16_t*)(ws + WS_WT_RKV) + (size_t)6144 * 2048, 2048, 96, 96, 256, 2048);
    if (j == 34) return mkjob(p.in[27], (bf16_t*)(ws + WS_WT_RKV) + (size_t)6400 * 2048, 2048, 96, 96, 256, 2048);
    if (j == 35) return mkjob(p.in[29], (bf16_t*)(ws + WS_WT_RKV) + (size_t)6656 * 2048, 2048, 256, 256, 256, 2048);
    if (j == 36) return mkjob(p.in[25], (bf16_t*)(ws + WS_WT_L2), 96, 2048, 2048, 2048, 256);
    if (j == 37) return mkjob(p.in[28], (bf16_t*)(ws + WS_WT_L2) + (size_t)2048 * 256, 96, 2048, 2048, 2048, 256);
    if (j == 38) return mkjob(p.in[30], (bf16_t*)(ws + WS_WT_L2) + (size_t)4096 * 256, 256, 2048, 2048, 2048, 256);
    if (j == 39) return mkjob(p.in[22], ws + WS_WT_BO, 2048, 2048, 2048, 2048, 2048);
    if (j == 40) return mkjob(p.in[5] + (size_t)2048 * 8192, ws + WS_WT_1_1, 2048, 8192, 8192, 8192, 2048);
    return mkjob(p.in[6] + (size_t)8192 * 2048, ws + WS_WT_2_1, 8192, 2048, 2048, 2048, 8192);
}
__device__ __forceinline__ int job_rowmap(const Job& J, int n) {
    if (J.rowmap == 1) { const int h = n / 192, d = n % 192; return d < 128 ? h * 128 + d : 2048 + h * 64 + ropeperm(d - 128); }
    if (J.rowmap == 2) { const int h = n >> 6, jj = n & 63; return 3072 + h * 64 + idxperm(jj); }
    return n;
}
__device__ __forceinline__ void conv_decode(const Params& p, int jlo, int ti, Job& J, int& n0, int& k0t, const volatile int* jtab) {
    int j = jlo; while (ti >= jtab[j + 1]) ++j;
    const int rem = ti - jtab[j]; J = get_job(p, j);
    const int nnt = J.dN >> 8; k0t = (rem / nnt) * 64; n0 = (rem % nnt) * 256;
}
__device__ __forceinline__ void conv_load(const Job& J, int n0, int k0t, int tid, f32x4 (&R)[8]) {
    if (!J.modeC) {
#pragma unroll
        for (int i = 0; i < 8; ++i) {
            const int kr = (tid >> 6) + 8 * i, n = n0 + (tid & 63) * 4; const int kk = k0t + kr - (J.k0 + (n / J.nblk) * J.kblk);
            R[i] = (f32x4){0.f, 0.f, 0.f, 0.f};
            if (n < J.sN && kk >= 0 && kk < J.sK) R[i] = *(const f32x4*)(J.src + (size_t)kk * J.skst + n);
        }
    } else {
#pragma unroll
        for (int i = 0; i < 4; ++i) {
            const int n = (tid >> 3) + 64 * i, k8 = (tid & 7) * 8; const int kk = k0t + k8 - J.k0;
            R[2 * i] = (f32x4){0.f, 0.f, 0.f, 0.f}; R[2 * i + 1] = R[2 * i];
            if (n0 + n < J.sN && kk >= 0 && kk + 7 < J.sK) { const float* sp = J.src + (size_t)(n0 + n) * J.snst + kk; R[2 * i] = *(const f32x4*)sp; R[2 * i + 1] = *(const f32x4*)(sp + 4); }
        }
    }
}
__device__ __forceinline__ void convert_jobs(const Params& p, unsigned char* shm, int jlo, int jhi, unsigned* ctr) {
    float* tile = (float*)shm;
    volatile int* nextp = (volatile int*)(shm + 66048);
    const int tid = otid();
    volatile int* jtab = (volatile int*)(shm + 66112);
    __syncthreads();
    if (tid == 0) { int acc = 0; for (int j = jlo; j < jhi; ++j) { jtab[j] = acc; const Job Jt = get_job(p, j); acc += (Jt.dN >> 8) * (Jt.dK >> 6); } jtab[jhi] = acc; }
    __syncthreads();
    const int total = jtab[jhi];
    if (tid == 0) *nextp = (int)__hip_atomic_fetch_add(ctr, 1u, __ATOMIC_RELAXED, __HIP_MEMORY_SCOPE_AGENT);
    __syncthreads();
    int ti = *nextp;
    Job J; int n0 = 0, k0t = 0; f32x4 R[8];
    if (ti < total) { conv_decode(p, jlo, ti, J, n0, k0t, jtab); conv_load(J, n0, k0t, tid, R); }
    while (ti < total) {
        if (!J.modeC) {
#pragma unroll
            for (int i = 0; i < 8; ++i) { const int kr = (tid >> 6) + 8 * i, n4 = (tid & 63) * 4; float* d = tile + kr * 257 + n4; d[0] = R[i][0]; d[1] = R[i][1]; d[2] = R[i][2]; d[3] = R[i][3]; }
        } else {
#pragma unroll
            for (int i = 0; i < 4; ++i) { const int n = (tid >> 3) + 64 * i, k8 = (tid & 7) * 8;
#pragma unroll
                for (int e = 0; e < 4; ++e) { tile[(k8 + e) * 257 + n] = R[2 * i][e]; tile[(k8 + 4 + e) * 257 + n] = R[2 * i + 1][e]; } }
        }
        if (tid == 0) *nextp = (int)__hip_atomic_fetch_add(ctr, 1u, __ATOMIC_RELAXED, __HIP_MEMORY_SCOPE_AGENT);
        __syncthreads();
        const int tnx = *nextp;
        const Job Jc = J; const int n0c = n0, k0c = k0t;
        if (tnx < total) { conv_decode(p, jlo, tnx, J, n0, k0t, jtab); conv_load(J, n0, k0t, tid, R); }
#pragma unroll
        for (int i = 0; i < 4; ++i) {
            const int n = (tid >> 3) + 64 * i, k8 = (tid & 7) * 8;
            float v[8];
#pragma unroll
            for (int e = 0; e < 8; ++e) v[e] = tile[(k8 + e) * 257 + n];
            u32x4 o; o[0] = cvt_pk_bf16(v[0], v[1]); o[1] = cvt_pk_bf16(v[2], v[3]); o[2] = cvt_pk_bf16(v[4], v[5]); o[3] = cvt_pk_bf16(v[6], v[7]);
            *(u32x4*)(Jc.dst + (size_t)job_rowmap(Jc, n0c + n) * Jc.dld + k0c + k8) = o;
        }
        __syncthreads();
        ti = tnx;
    }
}

__device__ __forceinline__ void norm_phase(int vbx, const float* xin, const float* sh, const float* sc, bf16_t* outb, float* outf, const float* fg) {
    const int tid_ = otid(); const int lane = tid_ & 63; const int gw = obid() * 8 + (tid_ >> 6), nw = ogrid() * 8; (void)vbx;
    for (int row = gw; row < T_; row += nw) {
        const float* xr = xin + (size_t)row * D_; const int b = row >> 11;
        f32x4 v[8]; float ss = 0.f;
#pragma unroll
        for (int j = 0; j < 8; ++j) { v[j] = *(const f32x4*)(xr + (lane + 64 * j) * 4); ss += v[j][0] * v[j][0] + v[j][1] * v[j][1] + v[j][2] * v[j][2] + v[j][3] * v[j][3]; }
        ss = red64(ss); const float rstd = rsqrtf(ss * (1.f / D_) + 1e-6f);
#pragma unroll
        for (int j = 0; j < 8; ++j) {
            const int c = (lane + 64 * j) * 4;
            if (outf) { const f32x4 g = *(const f32x4*)(fg + c); *(f32x4*)(outf + (size_t)row * D_ + c) = v[j] * rstd * g; }
            else { const f32x4 s1 = *(const f32x4*)(sc + (size_t)b * 12288 + c), s0 = *(const f32x4*)(sh + (size_t)b * 12288 + c);
                const f32x4 o = v[j] * rstd * (s1 + 1.f) + s0; u32x2 pk; pk[0] = cvt_pk_bf16(o[0], o[1]); pk[1] = cvt_pk_bf16(o[2], o[3]); *(u32x2*)(outb + (size_t)row * D_ + c) = pk; }
        }
    }
}
__device__ __forceinline__ void mix_phase(const Params& p, const float* xin, const float* sh, const float* sc) {
    const int tid_ = otid(); const int lane = tid_ & 63; const int gw = obid() * 8 + (tid_ >> 6), nw = ogrid() * 8;
    bf16_t* mix = (bf16_t*)(p.ws + WS_MIX); const float* mu = p.in[18];
    for (int r0 = gw * 8; r0 < T_; r0 += nw * 8) {
        const int b = r0 >> 11;
        f32x4 hp[8];
        for (int rr = -1; rr < 8; ++rr) {
            const int row = r0 + rr;
            f32x4 h[8];
            if (rr < 0 && (r0 & 2047) == 0) {
#pragma unroll
                for (int j = 0; j < 8; ++j) h[j] = (f32x4){0.f, 0.f, 0.f, 0.f};
            } else {
                const float* xr = xin + (size_t)row * D_; float ss = 0.f;
#pragma unroll
                for (int j = 0; j < 8; ++j) { h[j] = *(const f32x4*)(xr + (lane + 64 * j) * 4); ss += h[j][0] * h[j][0] + h[j][1] * h[j][1] + h[j][2] * h[j][2] + h[j][3] * h[j][3]; }
                ss = red64(ss); const float rstd = rsqrtf(ss * (1.f / D_) + 1e-6f);
#pragma unroll
                for (int j = 0; j < 8; ++j) { const int c = (lane + 64 * j) * 4; const f32x4 s1 = *(const f32x4*)(sc + (size_t)b * 12288 + c), s0 = *(const f32x4*)(sh + (size_t)b * 12288 + c); h[j] = h[j] * rstd * (s1 + 1.f) + s0; }
            }
            if (rr >= 0) {
#pragma unroll 1
                for (int q = 0; q < 6; ++q) {
                    const int mq = (q == 1) ? 2 : (q == 2) ? 3 : (q == 3) ? 1 : q;
                    f32x4 m[8];
#pragma unroll
                    for (int j = 0; j < 8; ++j) m[j] = *(const f32x4*)(mu + mq * D_ + (lane + 64 * j) * 4);
#pragma unroll
                    for (int j = 0; j < 8; ++j) {
                        const int c = (lane + 64 * j) * 4; const f32x4 o = h[j] + (hp[j] - h[j]) * m[j]; u32x2 pk; pk[0] = cvt_pk_bf16(o[0], o[1]); pk[1] = cvt_pk_bf16(o[2], o[3]);
                        *(u32x2*)(mix + (size_t)q * T_ * D_ + (size_t)row * D_ + c) = pk;
                    }
                }
            }
#pragma unroll
            for (int j = 0; j < 8; ++j) hp[j] = h[j];
        }
    }
}
__device__ __forceinline__ void projrow_phase(const Params& p) {
    const int tid_ = otid(); const int lane = tid_ & 63; const int gw = obid() * 8 + (tid_ >> 6), nw = ogrid() * 8;
    const float* proj = (const float*)(p.ws + WS_PROJ); bf16_t* cq = (bf16_t*)(p.ws + WS_CQ); bf16_t* keys = (bf16_t*)(p.ws + WS_KEYS); bf16_t* kidx = (bf16_t*)(p.ws + WS_KIDX); float* widx = (float*)(p.ws + WS_WIDX);
    const float* cosA = (const float*)(p.ws + WS_COSA); const float* sinA = (const float*)(p.ws + WS_SINA); const float* cosI = (const float*)(p.ws + WS_COSI); const float* sinI = (const float*)(p.ws + WS_SINI);
    const float* qg = p.in[9]; const float* kvg = p.in[10]; const float* lng = p.in[13]; const float* lnb = p.in[14];
    for (int row = gw; row < T_; row += nw) {
        const float* pr = proj + (size_t)row * 1024;
        f32x4 v[4];
#pragma unroll
        for (int j = 0; j < 4; ++j) v[j] = *(const f32x4*)(pr + (lane + 64 * j) * 4);
        float sq = 0.f, skv = 0.f;
#pragma unroll
        for (int e = 0; e < 4; ++e) { sq += v[0][e] * v[0][e] + v[1][e] * v[1][e]; skv += v[2][e] * v[2][e]; }
        sq = red64(sq); skv = red64(skv);
        const float rq = rsqrtf(sq * (1.f / 512.f) + 1e-6f), rkv = rsqrtf(skv * (1.f / 256.f) + 1e-6f);
#pragma unroll
        for (int j = 0; j < 2; ++j) { const int c = (lane + 64 * j) * 4; const f32x4 g = *(const f32x4*)(qg + c); const f32x4 o = v[j] * rq * g; u32x2 pk; pk[0] = cvt_pk_bf16(o[0], o[1]); pk[1] = cvt_pk_bf16(o[2], o[3]); *(u32x2*)(cq + (size_t)row * 512 + c) = pk; }
        { const int c = lane * 4; const f32x4 g = *(const f32x4*)(kvg + c); const f32x4 o = v[2] * rkv * g; u32x2 pk; pk[0] = cvt_pk_bf16(o[0], o[1]); pk[1] = cvt_pk_bf16(o[2], o[3]); *(u32x2*)(keys + (size_t)row * 320 + c) = pk; }
        f32x4 x = v[3];
        float s1 = x[0] + x[1] + x[2] + x[3]; s1 = red16(s1); const float mean = s1 * (1.f / 64.f);
        f32x4 xc = x - mean; float s2 = xc[0] * xc[0] + xc[1] * xc[1] + xc[2] * xc[2] + xc[3] * xc[3]; s2 = red16(s2); const float rs = rsqrtf(s2 * (1.f / 64.f) + 1e-6f);
        f32x4 y = x;
        if (lane >= 16 && lane < 32) { const int jj = (lane - 16) * 4; const f32x4 g = *(const f32x4*)(lng + jj), bb = *(const f32x4*)(lnb + jj); y = xc * rs * g + bb; }
        f32x4 part8, part4;
#pragma unroll
        for (int e = 0; e < 4; ++e) { part8[e] = __shfl_xor(y[e], 8); part4[e] = __shfl_xor(y[e], 4); }
        if (lane < 16) {
            const int l2 = lane & 7; const f32x4 c = *(const f32x4*)(cosA + (size_t)row * 32 + 4 * l2), s = *(const f32x4*)(sinA + (size_t)row * 32 + 4 * l2);
            f32x4 o; if (lane < 8) o = y * c - part8 * s; else o = y * c + part8 * s;
            const int pphys = (l2 >> 2) * 32 + 8 * (l2 & 3) + (lane < 8 ? 0 : 4);
            u32x2 pk; pk[0] = cvt_pk_bf16(o[0], o[1]); pk[1] = cvt_pk_bf16(o[2], o[3]); *(u32x2*)(keys + (size_t)row * 320 + 256 + pphys) = pk;
        } else if (lane < 32) {
            const int ll = lane - 16; f32x4 o = y; int pphys = ll * 4;
            if (ll < 8) { const int l2 = ll & 3; const f32x4 c = *(const f32x4*)(cosI + (size_t)row * 16 + 4 * l2), s = *(const f32x4*)(sinI + (size_t)row * 16 + 4 * l2);
                if (ll < 4) o = y * c - part4 * s; else o = y * c + part4 * s; pphys = 8 * l2 + (ll < 4 ? 0 : 4); }
            u32x2 pk; pk[0] = cvt_pk_bf16(o[0], o[1]); pk[1] = cvt_pk_bf16(o[2], o[3]); *(u32x2*)(kidx + (size_t)row * 64 + pphys) = pk;
        } else if (lane < 36) {
            *(f32x4*)(widx + (size_t)row * 16 + (lane - 32) * 4) = x * (1.f / 32.f);
        }
    }
}

__device__ __forceinline__ void score_phase(const Params& p, int vbx) {
    const int tid_ = otid(); const int lane = tid_ & 63, l32 = lane & 31, hh = lane >> 5; const int gw = obid() * 8 + (tid_ >> 6), nw = ogrid() * 8;
    const bf16_t* qall = (const bf16_t*)(p.ws + WS_QALL); const bf16_t* kidx = (const bf16_t*)(p.ws + WS_KIDX); const float* widx = (const float*)(p.ws + WS_WIDX); float* scores = (float*)(p.ws + WS_SCORES);
    const int xb_ = vbx >> 5;
    unsigned* sctr = (unsigned*)(p.ws + WS_BAR) + 48 + 16 * (xb_ & 7);
    for (;;) {
        int tile = 0; if (lane == 0) tile = (int)__hip_atomic_fetch_add(sctr, 1u, __ATOMIC_RELAXED, __HIP_MEMORY_SCOPE_AGENT);
        tile = __builtin_amdgcn_readfirstlane(tile); if (tile >= 528) break;
        const int b = xb_ & 7, L = 527 - tile;
        int qc = (int)((sqrtf(8.f * (float)L + 1.f) - 1.f) * 0.5f); while ((qc + 1) * (qc + 2) / 2 <= L) ++qc; while (qc * (qc + 1) / 2 > L) --qc;
        const int kt = L - qc * (qc + 1) / 2;
        const int t0 = b * S_ + qc * 64, key0 = b * S_ + kt * 64;
        bf16x8 kf[2][4];
#pragma unroll
        for (int mt = 0; mt < 2; ++mt)
#pragma unroll
            for (int ks = 0; ks < 4; ++ks) kf[mt][ks] = *(const bf16x8*)(kidx + (size_t)(key0 + mt * 32 + l32) * 64 + ks * 16 + hh * 8);
        f32x16 sc[2][2];
#pragma unroll
        for (int mt = 0; mt < 2; ++mt)
#pragma unroll
            for (int nt = 0; nt < 2; ++nt)
#pragma unroll
                for (int i = 0; i < 16; ++i) sc[mt][nt][i] = 0.f;
        bf16x8 qn[2][4]; float wn[2];
#pragma unroll
        for (int nt = 0; nt < 2; ++nt) {
#pragma unroll
            for (int ks = 0; ks < 4; ++ks) qn[nt][ks] = *(const bf16x8*)(qall + (size_t)(t0 + nt * 32 + l32) * 4096 + 3072 + ks * 16 + hh * 8);
            wn[nt] = widx[(size_t)(t0 + nt * 32 + l32) * 16];
        }
        for (int h = 0; h < 16; ++h) {
            bf16x8 qf[2][4]; float w[2];
#pragma unroll
            for (int nt = 0; nt < 2; ++nt) {
#pragma unroll
                for (int ks = 0; ks < 4; ++ks) qf[nt][ks] = qn[nt][ks];
                w[nt] = wn[nt];
            }
            { const int h1 = (h + 1) & 15;
#pragma unroll
              for (int nt = 0; nt < 2; ++nt) {
#pragma unroll
                for (int ks = 0; ks < 4; ++ks) qn[nt][ks] = *(const bf16x8*)(qall + (size_t)(t0 + nt * 32 + l32) * 4096 + 3072 + h1 * 64 + ks * 16 + hh * 8);
                wn[nt] = widx[(size_t)(t0 + nt * 32 + l32) * 16 + h1];
              } }
#pragma unroll
            for (int mt = 0; mt < 2; ++mt)
#pragma unroll
                for (int nt = 0; nt < 2; ++nt) {
                    f32x16 a;
#pragma unroll
                    for (int i = 0; i < 16; ++i) a[i] = 0.f;
#pragma unroll
                    for (int ks = 0; ks < 4; ++ks) a = __builtin_amdgcn_mfma_f32_32x32x16_bf16(kf[mt][ks], qf[nt][ks], a, 0, 0, 0);
#pragma unroll
                    for (int i = 0; i < 16; ++i) sc[mt][nt][i] += w[nt] * fmaxf(a[i], 0.f);
                }
        }
#pragma unroll
        for (int mt = 0; mt < 2; ++mt)
#pragma unroll
            for (int nt = 0; nt < 2; ++nt)
#pragma unroll
                for (int q4 = 0; q4 < 4; ++q4) {
                    f32x4 o; o[0] = sc[mt][nt][q4 * 4]; o[1] = sc[mt][nt][q4 * 4 + 1]; o[2] = sc[mt][nt][q4 * 4 + 2]; o[3] = sc[mt][nt][q4 * 4 + 3];
                    *(f32x4*)(scores + (size_t)(t0 + nt * 32 + l32) * S_ + kt * 64 + mt * 32 + q4 * 8 + hh * 4) = o;
                }
    }
}
template <int NI> __device__ __forceinline__ void topk_select(const float* sr, unsigned short* srow, int qc, int lane, unsigned long long ltmask) {
    unsigned u[NI];
#pragma unroll
    for (int i = 0; i < NI; ++i) {
        unsigned bits = 0u;
        if (i <= qc) { bits = __float_as_uint(sr[i * 64 + lane]); bits = (bits & 0x80000000u) ? ~bits : (bits | 0x80000000u); if (bits == 0u) bits = 1u; }
        u[i] = bits;
    }
    unsigned thr = 0u;
    for (int bit = 31; bit >= 0; --bit) {
        const unsigned cand = thr | (1u << bit); int c = 0;
#pragma unroll
        for (int i = 0; i < NI; ++i) c += __popcll(__ballot(u[i] >= cand));
        if (c >= 256) { thr = cand; if (c == 256) break; }
    }
    int cgt = 0;
#pragma unroll
    for (int i = 0; i < NI; ++i) cgt += __popcll(__ballot(u[i] > thr));
    const int need = 256 - cgt; int eqtaken = 0, base = 0;
#pragma unroll
    for (int i = 0; i < NI; ++i) {
        const bool eq = (u[i] == thr); const unsigned long long em = __ballot(eq);
        const int rank = eqtaken + __popcll(em & ltmask);
        const bool take = (u[i] > thr) || (eq && rank < need);
        const unsigned long long tm = __ballot(take);
        if (take) srow[base + __popcll(tm & ltmask)] = (unsigned short)(i * 64 + lane);
        base += __popcll(tm); eqtaken += __popcll(em);
    }
}
__device__ __forceinline__ void topk_phase(const Params& p) {
    const int tid_ = otid(); const int lane = tid_ & 63; const int gw = obid() * 8 + (tid_ >> 6), nw = ogrid() * 8;
    const float* scores = (const float*)(p.ws + WS_SCORES); unsigned short* sel = (unsigned short*)(p.ws + WS_SEL); int* cnt = (int*)(p.ws + WS_CNT);
    const unsigned long long ltmask = (1ull << lane) - 1ull;
    for (int t0 = gw; t0 < T_; t0 += nw) {
        const int bq = t0 >> 11; const int t = (bq << 11) | (((t0 & 2047) + 261 * bq) & 2047);
        const int s = t & 2047, qc = s >> 6; const int nvalid = (qc + 1) * 64;
        unsigned short* srow = sel + (size_t)t * 256;
        if (nvalid <= 256) {
#pragma unroll
            for (int i = 0; i < 4; ++i) { const int k = i * 64 + lane; srow[k] = (unsigned short)(k < nvalid ? k : 0); }
            if (lane == 0) cnt[t] = nvalid;
            continue;
        }
        const float* sr = scores + (size_t)t * S_;
        if (qc < 8) topk_select<8>(sr, srow, qc, lane, ltmask);
        else if (qc < 16) topk_select<16>(sr, srow, qc, lane, ltmask);
        else if (qc < 24) topk_select<24>(sr, srow, qc, lane, ltmask);
        else topk_select<32>(sr, srow, qc, lane, ltmask);
        if (lane == 0) cnt[t] = 256;
    }
}


constexpr int SROW = 2052;
__device__ __forceinline__ void scoretopk_phase(const Params& p, unsigned char* shm, int vbx) {
    float* scl = (float*)shm;
    volatile int* nextp = (volatile int*)(shm + 16 * SROW * 4);
    const int tid = otid(); const int wid = tid >> 6, lane = tid & 63, l16 = lane & 15, g = lane >> 4;
    const bf16_t* qall = (const bf16_t*)(p.ws + WS_QALL); const bf16_t* kidx = (const bf16_t*)(p.ws + WS_KIDX); const float* widx = (const float*)(p.ws + WS_WIDX);
    unsigned short* sel = (unsigned short*)(p.ws + WS_SEL); int* cnt = (int*)(p.ws + WS_CNT);
    const unsigned long long ltmask = (1ull << lane) - 1ull;
    for (int bi = 0; bi < 8; ++bi) {
    const int b = ((vbx >> 5) + bi) & 7;
    unsigned* sctr = (unsigned*)(p.ws + WS_BAR) + 48 + 16 * b;
    for (;;) {
        __syncthreads();
        if (tid == 0) *nextp = (int)__hip_atomic_fetch_add(sctr, 1u, __ATOMIC_RELAXED, __HIP_MEMORY_SCOPE_AGENT);
        __syncthreads();
        const int task = *nextp; if (task >= 128) break;
        const int qg = 127 - task; const int t0 = b * S_ + qg * 16; const int qc = qg >> 2; const int nvalid = (qc + 1) * 64;
        if (nvalid <= 256) {
#pragma unroll
            for (int qq = 0; qq < 2; ++qq) {
                const int t = t0 + 2 * wid + qq; unsigned short* srow = sel + (size_t)t * 256;
#pragma unroll
                for (int i = 0; i < 4; ++i) { const int k = i * 64 + lane; srow[k] = (unsigned short)(k < nvalid ? k : 0); }
                if (lane == 0) cnt[t] = nvalid;
            }
            continue;
        }
#pragma unroll 1
        for (int hp = 0; hp < 2; ++hp) {
            bf16x8 qf[8][2]; float w[8];
#pragma unroll
            for (int h = 0; h < 8; ++h) {
#pragma unroll
                for (int ks = 0; ks < 2; ++ks) qf[h][ks] = *(const bf16x8*)(qall + (size_t)(t0 + l16) * 4096 + 3072 + (hp * 8 + h) * 64 + ks * 32 + g * 8);
            }
#pragma unroll
            for (int h4 = 0; h4 < 2; ++h4) { const f32x4 wv = *(const f32x4*)(widx + (size_t)(t0 + l16) * 16 + hp * 8 + h4 * 4); w[h4 * 4] = wv[0]; w[h4 * 4 + 1] = wv[1]; w[h4 * 4 + 2] = wv[2]; w[h4 * 4 + 3] = wv[3]; }
            const int nkt = nvalid >> 4;
            const bf16_t* kr0 = kidx + (size_t)(b * S_ + l16) * 64 + g * 8;
            bf16x8 k0n = *(const bf16x8*)(kr0 + (size_t)wid * 1024), k1n = *(const bf16x8*)(kr0 + (size_t)wid * 1024 + 32);
            for (int kt = wid; kt < nkt; kt += 8) {
                const bf16x8 k0 = k0n, k1 = k1n;
                { const int ktn = (kt + 8 < nkt) ? kt + 8 : kt; k0n = *(const bf16x8*)(kr0 + (size_t)ktn * 1024); k1n = *(const bf16x8*)(kr0 + (size_t)ktn * 1024 + 32); }
                float* dst = scl + l16 * SROW + kt * 16 + g * 4;
                f32x4 sacc = (f32x4){0.f, 0.f, 0.f, 0.f};
                if (hp) sacc = *(const f32x4*)dst;
#pragma unroll
                for (int h = 0; h < 8; ++h) {
                    f32x4 a = (f32x4){0.f, 0.f, 0.f, 0.f};
                    a = __builtin_amdgcn_mfma_f32_16x16x32_bf16(k0, qf[h][0], a, 0, 0, 0);
                    a = __builtin_amdgcn_mfma_f32_16x16x32_bf16(k1, qf[h][1], a, 0, 0, 0);
#pragma unroll
                    for (int i = 0; i < 4; ++i) sacc[i] += w[h] * fmaxf(a[i], 0.f);
                }
                *(f32x4*)dst = sacc;
            }
        }
        __syncthreads();
#pragma unroll 1
        for (int qq = 0; qq < 2; ++qq) {
            const int q = 2 * wid + qq; const int t = t0 + q; unsigned short* srow = sel + (size_t)t * 256; const float* sr = scl + q * SROW;
            if (qc < 8) topk_select<8>(sr, srow, qc, lane, ltmask);
            else if (qc < 16) topk_select<16>(sr, srow, qc, lane, ltmask);
            else if (qc < 24) topk_select<24>(sr, srow, qc, lane, ltmask);
            else topk_select<32>(sr, srow, qc, lane, ltmask);
            if (lane == 0) cnt[t] = 256;
        }
    }
    }
}
typedef short bf16x4v __attribute__((ext_vector_type(4)));
constexpr int ABUF_BYTES = 8 * 1024, AWAVE = 2 * ABUF_BYTES;
__device__ __forceinline__ void attn_phase(const Params& p, LAS unsigned char* lds, int vbx) {
    const int tid_ = otid(); const int wid = __builtin_amdgcn_readfirstlane(tid_ >> 6), lane = tid_ & 63, l16 = lane & 15, g = lane >> 4;
    const int gw = vbx * 8 + wid, nw = ogrid() * 8;
    LAS unsigned char* vl = lds + wid * AWAVE;
    LAS unsigned char* rl = lds + 8 * AWAVE + wid * 2048;
    const unsigned r_rd0 = (unsigned)((l16 >> 3) * 1024 + (l16 & 7) * 128 + ((g ^ (l16 & 7)) * 16)), r_rd1 = (unsigned)((l16 >> 3) * 1024 + (l16 & 7) * 128 + (((4 + g) ^ (l16 & 7)) * 16));
    const bf16_t* qlat = (const bf16_t*)(p.ws + WS_QLAT); const bf16_t* qall = (const bf16_t*)(p.ws + WS_QALL); const bf16_t* keys = (const bf16_t*)(p.ws + WS_KEYS);
    const unsigned short* sel = (const unsigned short*)(p.ws + WS_SEL); bf16_t* olat = (bf16_t*)(p.ws + WS_OLAT);
    const float cs = 0.07216878364870322f * 1.4426950408889634f;
    const float NEG = -1e30f;
    const unsigned a_rd0 = (unsigned)((l16 >> 3) * 1024 + (l16 & 7) * 128 + ((g ^ (l16 & 7)) * 16)), a_rd1 = (unsigned)((l16 >> 3) * 1024 + (l16 & 7) * 128 + (((4 + g) ^ (l16 & 7)) * 16));
    const int trow = g * 4 + ((lane & 15) >> 2), tp = lane & 3;
    unsigned tr_rdk[4];
#pragma unroll
    for (int k = 0; k < 4; ++k) tr_rdk[k] = (unsigned)((trow >> 3) * 1024 + (trow & 7) * 128 + (((2 * k + (tp >> 1)) ^ (trow & 7)) * 16) + (tp & 1) * 8);
    const int dr8 = lane >> 3, dpiece = ((lane & 7) ^ (lane >> 3)) * 16;
    for (int t = gw * 8; t < T_; t += nw * 8)
    for (int qi = 0; qi < 8; ++qi) {
        const int tq = t + qi; const int b = tq >> 11; const int nv_ = ((((tq & 2047) >> 6) + 1) * 64); const int cnt = nv_ < 256 ? nv_ : 256;
        bf16x8 qf[10];
#pragma unroll
        for (int ks = 0; ks < 8; ++ks) qf[ks] = *(const bf16x8*)(qlat + (size_t)tq * 4096 + l16 * 256 + ks * 32 + g * 8);
#pragma unroll
        for (int ks = 0; ks < 2; ++ks) qf[8 + ks] = *(const bf16x8*)(qall + (size_t)tq * 4096 + 2048 + l16 * 64 + ks * 32 + g * 8);
        f32x4 oacc[16];
#pragma unroll
        for (int rt = 0; rt < 16; ++rt) oacc[rt] = (f32x4){0.f, 0.f, 0.f, 0.f};
        float m = NEG, lsum = 0.f;
        const int nch = cnt >> 4;
        const unsigned short* selr = sel + (size_t)tq * 256;
        const bf16_t* kbase = keys + (size_t)(b * S_) * 320;
        int jr0 = selr[dr8], jr1 = selr[8 + dr8];
        { const char* s0 = (const char*)(kbase + (size_t)jr0 * 320) + dpiece; const char* s1 = (const char*)(kbase + (size_t)jr1 * 320) + dpiece;
#pragma unroll
          for (int lh = 0; lh < 5; ++lh) {
              LAS unsigned char* d = (lh < 4) ? vl + lh * 2048 : rl;
              __builtin_amdgcn_global_load_lds((const unsigned*)(s0 + lh * 128), (LAS unsigned*)(d), 16, 0, 0);
              __builtin_amdgcn_global_load_lds((const unsigned*)(s1 + lh * 128), (LAS unsigned*)(d + 1024), 16, 0, 0); } }
        jr0 = selr[16 + dr8]; jr1 = selr[24 + dr8];
        for (int c = 0; c < nch; ++c) {
            LAS unsigned char* buf = vl + (c & 1) * ABUF_BYTES;
            asm volatile("s_waitcnt vmcnt(0)" ::: "memory");
            const bf16x8 r0 = *(const LAS bf16x8*)(rl + r_rd0), r1 = *(const LAS bf16x8*)(rl + r_rd1);
            asm volatile("s_waitcnt lgkmcnt(0)" ::: "memory");
            if (c + 1 < nch) {
                LAS unsigned char* nb = vl + ((c + 1) & 1) * ABUF_BYTES;
                const char* s0 = (const char*)(kbase + (size_t)jr0 * 320) + dpiece; const char* s1 = (const char*)(kbase + (size_t)jr1 * 320) + dpiece;
#pragma unroll
                for (int lh = 0; lh < 5; ++lh) {
                    LAS unsigned char* d = (lh < 4) ? nb + lh * 2048 : rl;
                    __builtin_amdgcn_global_load_lds((const unsigned*)(s0 + lh * 128), (LAS unsigned*)(d), 16, 0, 0);
                    __builtin_amdgcn_global_load_lds((const unsigned*)(s1 + lh * 128), (LAS unsigned*)(d + 1024), 16, 0, 0); }
                const int cn = (c + 2 < 16) ? c + 2 : 15; jr0 = selr[cn * 16 + dr8]; jr1 = selr[cn * 16 + 8 + dr8];
            }
            f32x4 sv = (f32x4){0.f, 0.f, 0.f, 0.f};
#pragma unroll
            for (int ks = 0; ks < 8; ++ks) { const bf16x8 a = *(const LAS bf16x8*)(buf + (ks >> 1) * 2048 + ((ks & 1) ? a_rd1 : a_rd0)); sv = __builtin_amdgcn_mfma_f32_16x16x32_bf16(a, qf[ks], sv, 0, 0, 0); }
            sv = __builtin_amdgcn_mfma_f32_16x16x32_bf16(r0, qf[8], sv, 0, 0, 0); sv = __builtin_amdgcn_mfma_f32_16x16x32_bf16(r1, qf[9], sv, 0, 0, 0);
            float cmax = NEG;
#pragma unroll
            for (int i = 0; i < 4; ++i) { if (c * 16 + g * 4 + i >= cnt) sv[i] = NEG; cmax = fmaxf(cmax, sv[i]); }
            cmax = fmaxf(cmax, __shfl_xor(cmax, 16)); cmax = fmaxf(cmax, __shfl_xor(cmax, 32));
            if (__any((cmax - m) * cs > 6.f)) {
                const float mn = fmaxf(m, cmax); const float alpha = exp2f((m - mn) * cs); m = mn;
                lsum *= alpha;
#pragma unroll
                for (int rt = 0; rt < 16; ++rt) oacc[rt] *= alpha;
            }
            float ps = 0.f;
#pragma unroll
            for (int i = 0; i < 4; ++i) { sv[i] = exp2f((sv[i] - m) * cs); ps += sv[i]; }
            lsum += ps;
            u32x2 pfu; pfu[0] = cvt_pk_bf16(sv[0], sv[1]); pfu[1] = cvt_pk_bf16(sv[2], sv[3]);
            const bf16x4v pf = __builtin_bit_cast(bf16x4v, pfu);
            const unsigned tbb = (unsigned)(size_t)buf; const unsigned tb0 = tbb + tr_rdk[0], tb1 = tbb + tr_rdk[1], tb2 = tbb + tr_rdk[2], tb3 = tbb + tr_rdk[3];
#define TRG4(R4) { bf16x4v a0, a1, a2, a3; \
                asm volatile("ds_read_b64_tr_b16 %0, %4 offset:%8\n\tds_read_b64_tr_b16 %1, %5 offset:%8\n\tds_read_b64_tr_b16 %2, %6 offset:%8\n\tds_read_b64_tr_b16 %3, %7 offset:%8\n\ts_waitcnt lgkmcnt(0)" \
                             : "=&v"(a0), "=&v"(a1), "=&v"(a2), "=&v"(a3) \
                             : "v"(tb0), "v"(tb1), "v"(tb2), "v"(tb3), "i"((R4) * 2048) : "memory"); \
                oacc[(R4) * 4 + 0] = __builtin_amdgcn_mfma_f32_16x16x16bf16_1k(a0, pf, oacc[(R4) * 4 + 0], 0, 0, 0); \
                oacc[(R4) * 4 + 1] = __builtin_amdgcn_mfma_f32_16x16x16bf16_1k(a1, pf, oacc[(R4) * 4 + 1], 0, 0, 0); \
                oacc[(R4) * 4 + 2] = __builtin_amdgcn_mfma_f32_16x16x16bf16_1k(a2, pf, oacc[(R4) * 4 + 2], 0, 0, 0); \
                oacc[(R4) * 4 + 3] = __builtin_amdgcn_mfma_f32_16x16x16bf16_1k(a3, pf, oacc[(R4) * 4 + 3], 0, 0, 0); }
            TRG4(0) TRG4(1) TRG4(2) TRG4(3)
#undef TRG4
        }
        lsum += __shfl_xor(lsum, 16); lsum += __shfl_xor(lsum, 32);
        const float inv = 1.f / lsum;
#pragma unroll
        for (int rt = 0; rt < 16; ++rt) { const f32x4 o = oacc[rt] * inv; u32x2 pk; pk[0] = cvt_pk_bf16(o[0], o[1]); pk[1] = cvt_pk_bf16(o[2], o[3]); *(u32x2*)(olat + (size_t)tq * 4096 + l16 * 256 + rt * 16 + g * 4) = pk; }
    }
}

__device__ __forceinline__ void red8x2(float& x0, float& x1) {
    float y0, y1;
    asm volatile("s_nop 1\n\t"
                 "v_add_f32_dpp %0, %2, %2 quad_perm:[1,0,3,2] row_mask:0xf bank_mask:0xf\n\t"
                 "v_add_f32_dpp %1, %3, %3 quad_perm:[1,0,3,2] row_mask:0xf bank_mask:0xf\n\t"
                 "s_nop 0\n\t"
                 "v_add_f32_dpp %0, %0, %0 quad_perm:[2,3,0,1] row_mask:0xf bank_mask:0xf\n\t"
                 "v_add_f32_dpp %1, %1, %1 quad_perm:[2,3,0,1] row_mask:0xf bank_mask:0xf\n\t"
                 "s_nop 0\n\t"
                 "v_add_f32_dpp %0, %0, %0 row_half_mirror row_mask:0xf bank_mask:0xf\n\t"
                 "v_add_f32_dpp %1, %1, %1 row_half_mirror row_mask:0xf bank_mask:0xf\n\t"
                 "s_nop 0"
                 : "=&v"(y0), "=&v"(y1) : "v"(x0), "v"(x1));
    x0 = y0; x1 = y1;
}
constexpr int TC = 32;
typedef float f32x2 __attribute__((ext_vector_type(2)));
__device__ __forceinline__ void scan_phase(const Params& p, unsigned char* shm) {
    const int tid = otid(); const bool seq = tid < 256;
    float* bufs = (float*)shm;
    float* obuf = bufs + 2 * 6 * TC * 64;
    const bf16_t* rbuf = (const bf16_t*)(p.ws + WS_RBUF); const bf16_t* kbuf = (const bf16_t*)(p.ws + WS_KBUF); const bf16_t* vbuf = (const bf16_t*)(p.ws + WS_VBUF);
    const bf16_t* abuf = (const bf16_t*)(p.ws + WS_ABUF); const bf16_t* gbuf = (const bf16_t*)(p.ws + WS_GBUF); const float* wdec = (const float*)(p.ws + WS_WDEC);
    bf16_t* outb = (bf16_t*)(p.ws + WS_SCANOUT);
    const int nb_ = ogrid();
    for (int pair = obid(); pair < 256; pair += nb_) {
        const int b = pair >> 5, h = pair & 31;
        if (seq) {
            const int rp = tid >> 3, cgp = tid & 7;
            f32x2 A0[4], A1[4];
#pragma unroll
            for (int q = 0; q < 4; ++q) { A0[q] = (f32x2){0.f, 0.f}; A1[q] = (f32x2){0.f, 0.f}; }
            __syncthreads();
            for (int c = 0; c <= S_ / TC; ++c) {
                if (c < S_ / TC) {
                    const float* B = bufs + (c & 1) * 6 * TC * 64 + cgp * 8; float* ob = obuf + (c & 1) * TC * 64 + 2 * rp;
                    const float* Bv = bufs + (c & 1) * 6 * TC * 64 + 5 * TC * 64 + 2 * rp;
                    f32x4 xw0 = *(const f32x4*)(B), xw1 = *(const f32x4*)(B + 4), xn0 = *(const f32x4*)(B + TC * 64), xn1 = *(const f32x4*)(B + TC * 64 + 4);
                    f32x4 xb0 = *(const f32x4*)(B + 2 * TC * 64), xb1 = *(const f32x4*)(B + 2 * TC * 64 + 4), xk0 = *(const f32x4*)(B + 3 * TC * 64), xk1 = *(const f32x4*)(B + 3 * TC * 64 + 4);
                    f32x4 xr0 = *(const f32x4*)(B + 4 * TC * 64), xr1 = *(const f32x4*)(B + 4 * TC * 64 + 4); f32x2 xvv = *(const f32x2*)(Bv);
#pragma unroll 4
                    for (int s = 0; s < TC; ++s) {
                        const f32x4 w0 = xw0, w1 = xw1, n0 = xn0, n1 = xn1, b0 = xb0, b1 = xb1, k0 = xk0, k1 = xk1, r0 = xr0, r1 = xr1; const f32x2 vv = xvv;
                        { const float* Bs = B + (s + 1) * 64;
                          xw0 = *(const f32x4*)(Bs); xw1 = *(const f32x4*)(Bs + 4); xn0 = *(const f32x4*)(Bs + TC * 64); xn1 = *(const f32x4*)(Bs + TC * 64 + 4);
                          xb0 = *(const f32x4*)(Bs + 2 * TC * 64); xb1 = *(const f32x4*)(Bs + 2 * TC * 64 + 4); xk0 = *(const f32x4*)(Bs + 3 * TC * 64); xk1 = *(const f32x4*)(Bs + 3 * TC * 64 + 4);
                          xr0 = *(const f32x4*)(Bs + 4 * TC * 64); xr1 = *(const f32x4*)(Bs + 4 * TC * 64 + 4); xvv = *(const f32x2*)(Bv + (s + 1) * 64); }
                        const f32x2 wp[4] = {{w0[0], w0[1]}, {w0[2], w0[3]}, {w1[0], w1[1]}, {w1[2], w1[3]}};
                        const f32x2 np[4] = {{n0[0], n0[1]}, {n0[2], n0[3]}, {n1[0], n1[1]}, {n1[2], n1[3]}};
                        const f32x2 bp[4] = {{b0[0], b0[1]}, {b0[2], b0[3]}, {b1[0], b1[1]}, {b1[2], b1[3]}};
                        const f32x2 kp[4] = {{k0[0], k0[1]}, {k0[2], k0[3]}, {k1[0], k1[1]}, {k1[2], k1[3]}};
                        const f32x2 rq[4] = {{r0[0], r0[1]}, {r0[2], r0[3]}, {r1[0], r1[1]}, {r1[2], r1[3]}};
                        f32x2 t0 = A0[0] * np[0], t1 = A1[0] * np[0];
#pragma unroll
                        for (int q = 1; q < 4; ++q) { t0 = __builtin_elementwise_fma(A0[q], np[q], t0); t1 = __builtin_elementwise_fma(A1[q], np[q], t1); }
                        float sa0 = t0[0] + t0[1], sa1 = t1[0] + t1[1];
                        red8x2(sa0, sa1);
                        const f32x2 s0v = {sa0, sa0}, s1v = {sa1, sa1}, v0v = {vv[0], vv[0]}, v1v = {vv[1], vv[1]};
#pragma unroll
                        for (int q = 0; q < 4; ++q) { A0[q] = __builtin_elementwise_fma(v0v, kp[q], __builtin_elementwise_fma(s0v, bp[q], A0[q] * wp[q])); A1[q] = __builtin_elementwise_fma(v1v, kp[q], __builtin_elementwise_fma(s1v, bp[q], A1[q] * wp[q])); }
                        f32x2 u0 = A0[0] * rq[0], u1 = A1[0] * rq[0];
#pragma unroll
                        for (int q = 1; q < 4; ++q) { u0 = __builtin_elementwise_fma(A0[q], rq[q], u0); u1 = __builtin_elementwise_fma(A1[q], rq[q], u1); }
                        float o0 = u0[0] + u0[1], o1 = u1[0] + u1[1];
                        red8x2(o0, o1);
                        if (cgp == 0) *(f32x2*)(ob + s * 64) = (f32x2){o0, o1};
                    }
                }
                __syncthreads();
            }
        } else {
            const int ht = tid - 256; const int ss0 = ht >> 4, c4 = (ht & 15) * 4; const int ch = h * 64 + c4;
            const f32x4 w0v = *(const f32x4*)(p.in[23] + ch), a0v = *(const f32x4*)(p.in[26] + ch); const f32x4 kkv = *(const f32x4*)(p.in[31] + ch), kav = *(const f32x4*)(p.in[32] + ch), rkv = *(const f32x4*)(p.in[33] + ch), gng = *(const f32x4*)(p.in[34] + ch), gnb = *(const f32x4*)(p.in[35] + ch);
            for (int c = -1; c <= S_ / TC; ++c) {
                const bool do_post = (c >= 1), do_stage = (c + 1 < S_ / TC);
                u32x2 lr[2], lk[2], lv[2], la[2], lg[2]; f32x4 lw[2];
#pragma unroll
                for (int i = 0; i < 2; ++i) {
                    const int ss = ss0 + 16 * i;
                    if (do_stage) { const size_t off = (size_t)(b * S_ + (c + 1) * TC + ss) * D_ + ch; lr[i] = *(const u32x2*)(rbuf + off); lk[i] = *(const u32x2*)(kbuf + off); lv[i] = *(const u32x2*)(vbuf + off); la[i] = *(const u32x2*)(abuf + off); lw[i] = *(const f32x4*)(wdec + off); }
                    if (do_post) { const size_t off = (size_t)(b * S_ + (c - 1) * TC + ss) * D_ + ch; lg[i] = *(const u32x2*)(gbuf + off); }
                }
#pragma unroll
                for (int i = 0; i < 2; ++i) {
                    const int ss = ss0 + 16 * i; const int o = ss * 64 + c4;
                    float* B = bufs + ((c + 1) & 1) * 6 * TC * 64;
                    if (do_post) {
                        const float* obr = obuf + ((c - 1) & 1) * TC * 64;
                        const f32x4 ov = *(const f32x4*)(obr + o), km = *(const f32x4*)(B + 3 * TC * 64 + o), r = *(const f32x4*)(B + 4 * TC * 64 + o), v = *(const f32x4*)(B + 5 * TC * 64 + o);
                        float s1 = ov[0] + ov[1] + ov[2] + ov[3]; s1 = red16(s1); const float mean = s1 * (1.f / 64.f);
                        const f32x4 oc = ov - mean; float s2 = oc[0] * oc[0] + oc[1] * oc[1] + oc[2] * oc[2] + oc[3] * oc[3]; s2 = red16(s2); const float rs = rsqrtf(s2 * (1.f / 64.f) + 64e-5f);
                        const f32x4 rk = r * km * rkv; float bs = rk[0] + rk[1] + rk[2] + rk[3]; bs = red16(bs);
                        const size_t off = (size_t)(b * S_ + (c - 1) * TC + ss) * D_ + ch;
                        f32x4 gg; gg[0] = bf2f(lg[i][0] & 0xffffu); gg[1] = bf2f(lg[i][0] >> 16); gg[2] = bf2f(lg[i][1] & 0xffffu); gg[3] = bf2f(lg[i][1] >> 16);
                        const f32x4 y = (oc * rs * gng + gnb + v * bs) * gg;
                        u32x2 pk; pk[0] = cvt_pk_bf16(y[0], y[1]); pk[1] = cvt_pk_bf16(y[2], y[3]); *(u32x2*)(outb + off) = pk;
                    }
                    if (do_stage) {
                        f32x4 r, k, v, a, wv;
                        r[0] = bf2f(lr[i][0] & 0xffffu); r[1] = bf2f(lr[i][0] >> 16); r[2] = bf2f(lr[i][1] & 0xffffu); r[3] = bf2f(lr[i][1] >> 16);
                        k[0] = bf2f(lk[i][0] & 0xffffu); k[1] = bf2f(lk[i][0] >> 16); k[2] = bf2f(lk[i][1] & 0xffffu); k[3] = bf2f(lk[i][1] >> 16);
                        v[0] = bf2f(lv[i][0] & 0xffffu); v[1] = bf2f(lv[i][0] >> 16); v[2] = bf2f(lv[i][1] & 0xffffu); v[3] = bf2f(lv[i][1] >> 16);
                        a[0] = bf2f(la[i][0] & 0xffffu); a[1] = bf2f(la[i][0] >> 16); a[2] = bf2f(la[i][1] & 0xffffu); a[3] = bf2f(la[i][1] >> 16);
#pragma unroll
                        for (int e = 0; e < 4; ++e) { a[e] = sigmoidf_(a0v[e] + a[e]); const float z = -(w0v[e] + lw[i][e]); const float sp = fmaxf(z, 0.f) + __logf(1.f + __expf(-fabsf(z))); wv[e] = __expf(-__expf(-sp - 0.5f)); }
                        f32x4 kk = k * kkv; float n2 = kk[0] * kk[0] + kk[1] * kk[1] + kk[2] * kk[2] + kk[3] * kk[3]; n2 = red16(n2);
                        const float invn = 1.f / fmaxf(sqrtf(n2), 1e-12f); kk = kk * invn;
                        const f32x4 km = k * ((a - 1.f) * kav + 1.f);
                        *(f32x4*)(B + 0 * TC * 64 + o) = wv; *(f32x4*)(B + 1 * TC * 64 + o) = -kk; *(f32x4*)(B + 2 * TC * 64 + o) = kk * a; *(f32x4*)(B + 3 * TC * 64 + o) = km; *(f32x4*)(B + 4 * TC * 64 + o) = r; *(f32x4*)(B + 5 * TC * 64 + o) = v;
                    }
                }
                __syncthreads();
            }
        }
        __syncthreads();
    }
}

__global__ void __launch_bounds__(512, 2) mega(Params p) {
    extern __shared__ __attribute__((aligned(16))) unsigned char shm[];
    LAS unsigned char* lds = (LAS unsigned char*)shm;
    cg::grid_group grid = cg::this_grid();
    unsigned char* ws = p.ws;
    float* mod = (float*)(ws + WS_MOD); float* X = (float*)(ws + WS_X);
    volatile LAS unsigned* xst = (volatile LAS unsigned*)(lds + LDS_BYTES - 16);
    if (threadIdx.x == 0) { xst[0] = 0u; xst[1] = 0u; xst[2] = 0u; xst[3] = 0u; }
    __syncthreads();
    const XcdBarrier xb = xcd_barrier_post((unsigned*)(ws + WS_BAR + 4096), xst);
    p0_mod(p, shm); p0_rope(p); __syncthreads(); convert_jobs(p, shm, 0, NJOBS_EARLY, (unsigned*)(ws + WS_BAR) + 16);
    if (p.ws == nullptr) grid.sync();
    xcd_barrier(xb);
    if (threadIdx.x == 0) {
        bool ok = (gridDim.x == 256);
        for (int j = 0; j < 16; ++j) ok = ok && (xb_ld(&xb.bar[XB_XCNT(j)]) == (j < 8 ? 32u : 0u));
        if (!ok) xst[2] = 0xFFFFFFFFu;
    }
    __syncthreads();
    int vb; { const unsigned rk = xst[2], xc = xst[3]; vb = (gridDim.x == 256 && rk < 32u && xc < 8u) ? (int)(rk * 8u + xc) : (int)blockIdx.x; asm volatile("" : "+s"(vb)); }
    int vbx; { const unsigned rk = xst[2], xc = xst[3]; vbx = (gridDim.x == 256 && rk < 32u && xc < 8u) ? (int)(xc * 32u + rk) : (int)blockIdx.x; asm volatile("" : "+s"(vbx)); }
    norm_phase(vbx, p.in[0], mod + 0 * 2048, mod + 1 * 2048, (bf16_t*)(ws + WS_HMIX), nullptr, nullptr);
    xcd_barrier(xb);
    { Epi<M_F32> E{}; E.o0 = ws + WS_PROJ; E.ldc = 1024; run_gemm<M_F32>(vb, lds, ws + WS_HMIX, 2048, ws + WS_WT_IN, 2048, T_, 1024, 2048, 0, E); }
    xcd_barrier(xb);
    projrow_phase(p);
    xcd_barrier(xb);
    { Epi<M_QROPE> E{}; E.o0 = ws + WS_QALL; E.ldc = 4096; E.f0 = (const float*)(ws + WS_COSA); E.f1 = (const float*)(ws + WS_SINA); E.f2 = (const float*)(ws + WS_COSI); E.f3 = (const float*)(ws + WS_SINI);
      run_gemm<M_QROPE>(vb, lds, ws + WS_CQ, 512, ws + WS_WT_Q, 512, T_, 4096, 512, 0, E); }
    xcd_barrier(xb);
    { Epi<M_BF16> E{}; E.o0 = ws + WS_QLAT; E.ldc = 4096; run_gemm<M_BF16>(vb, lds, ws + WS_QALL, 4096, ws + WS_WT_UK, 256, T_, 4096, 256, 1, E); }
    scoretopk_phase(p, shm, vbx);
    xcd_barrier(xb);
    attn_phase(p, lds, vbx);
    xcd_barrier(xb);
    { Epi<M_BF16> E{}; E.o0 = ws + WS_O; E.ldc = 2048; run_gemm<M_BF16>(vb, lds, ws + WS_OLAT, 4096, ws + WS_WT_UV, 512, T_, 2048, 512, 2, E); }
    xcd_barrier(xb);
    { Epi<M_RESID> E{}; E.o0 = X; E.f0 = p.in[0]; E.f1 = mod + 2 * 2048; run_gemm<M_RESID>(vb, lds, ws + WS_O, 2048, ws + WS_WT_O, 2048, T_, 2048, 2048, 0, E); }
    xcd_barrier(xb);
    norm_phase(vbx, X, mod + 3 * 2048, mod + 4 * 2048, (bf16_t*)(ws + WS_HFF), nullptr, nullptr);
    xcd_barrier(xb);
    { Epi<M_RELU2> E{}; E.o0 = ws + WS_H1; E.ldc = 8192; run_gemm<M_RELU2>(vb, lds, ws + WS_HFF, 2048, ws + WS_WT_1_0, 2048, T_, 8192, 2048, 0, E); }
    xcd_barrier(xb);
    { Epi<M_RESID> E{}; E.o0 = X; E.f0 = X; E.f1 = mod + 5 * 2048; run_gemm<M_RESID>(vb, lds, ws + WS_H1, 8192, ws + WS_WT_2_0, 8192, T_, 2048, 8192, 0, E); }
    xcd_barrier(xb);
    const float* mod1 = mod + 8 * 12288;
    mix_phase(p, X, mod1 + 0 * 2048, mod1 + 1 * 2048);
    xcd_barrier(xb);
    { Epi<M_L1A> E{}; E.o0 = ws + WS_KBUF; E.o1 = ws + WS_VBUF; E.o2 = ws + WS_MID; E.o3 = ws + WS_MID + 8 * MiB; E.o4 = ws + WS_MID + 16 * MiB;
      run_gemm<M_L1A>(vb, lds, ws + WS_MIX + 64 * MiB, 2048, (bf16_t*)(ws + WS_WT_RKV) + (size_t)2048 * 2048, 2048, T_, 4864, 2048, 3, E); }
    xcd_barrier(xb);
    { Epi<M_BF16> E{}; E.o0 = ws + WS_RBUF; E.ldc = 2048; run_gemm<M_BF16>(vb, lds, ws + WS_MIX, 2048, ws + WS_WT_RKV, 2048, T_, 2048, 2048, 0, E); }
    { Epi<M_F32> E{}; E.o0 = ws + WS_WDEC; E.ldc = 2048; run_gemm<M_F32>(vb, lds, ws + WS_MID, 256, ws + WS_WT_L2, 256, T_, 2048, 256, 0, E); }
    { Epi<M_BF16> E{}; E.o0 = ws + WS_ABUF; E.ldc = 2048; run_gemm<M_BF16>(vb, lds, ws + WS_MID + 8 * MiB, 256, (bf16_t*)(ws + WS_WT_L2) + (size_t)2048 * 256, 256, T_, 2048, 256, 0, E); }
    { Epi<M_BF16> E{}; E.o0 = ws + WS_GBUF; E.ldc = 2048; run_gemm<M_BF16>(vb, lds, ws + WS_MID + 16 * MiB, 256, (bf16_t*)(ws + WS_WT_L2) + (size_t)4096 * 256, 256, T_, 2048, 256, 0, E); }
    xcd_barrier(xb);
    scan_phase(p, shm);
    xcd_barrier(xb);
    { Epi<M_RESID> E{}; E.o0 = X; E.f0 = X; E.f1 = mod1 + 2 * 2048; run_gemm<M_RESID>(vb, lds, ws + WS_SCANOUT, 2048, ws + WS_WT_BO, 2048, T_, 2048, 2048, 0, E); }
    xcd_barrier(xb);
    norm_phase(vbx, X, mod1 + 3 * 2048, mod1 + 4 * 2048, (bf16_t*)(ws + WS_HFF), nullptr, nullptr);
    __syncthreads(); convert_jobs(p, shm, NJOBS_EARLY, NJOBS_ALL, (unsigned*)(ws + WS_BAR) + 32);
    xcd_barrier(xb);
    { Epi<M_RELU2> E{}; E.o0 = ws + WS_H1; E.ldc = 8192; run_gemm<M_RELU2>(vb, lds, ws + WS_HFF, 2048, ws + WS_WT_1_1, 2048, T_, 8192, 2048, 0, E); }
    xcd_barrier(xb);
    { Epi<M_RESID> E{}; E.o0 = X; E.f0 = X; E.f1 = mod1 + 5 * 2048; run_gemm<M_RESID>(vb, lds, ws + WS_H1, 8192, ws + WS_WT_2_1, 8192, T_, 2048, 8192, 0, E); }
    xcd_barrier(xb);
    norm_phase(vbx, X, nullptr, nullptr, nullptr, p.out, p.in[7]);
}

extern "C" void kernel_launch(void* const* d_in, const int* in_sizes, int n_in, void* d_out, int out_size, void* d_ws, size_t ws_size, hipStream_t stream) {
    static int grid = 0;
    if (grid == 0) {
        int dev = 0, cus = 0, per_cu = 0;
        hipGetDevice(&dev); hipDeviceGetAttribute(&cus, hipDeviceAttributeMultiprocessorCount, dev);
        if (hipFuncSetAttribute((const void*)mega, hipFuncAttributeMaxDynamicSharedMemorySize, LDS_BYTES) != hipSuccess) fprintf(stderr, "hipFuncSetAttribute failed\n");
        hipOccupancyMaxActiveBlocksPerMultiprocessor(&per_cu, (const void*)mega, 512, LDS_BYTES);
        if (per_cu < 1) per_cu = 1;
        grid = cus * 1;
        (void)hipGetLastError();
    }
    Params p{};
    for (int i = 0; i < 36; ++i) p.in[i] = (const float*)d_in[i];
    p.out = (float*)d_out; p.ws = (unsigned char*)d_ws;
    (void)hipMemsetAsync((unsigned char*)d_ws + WS_BAR, 0, 32768, stream);
    void* args[] = {&p};
    hipError_t e = hipLaunchCooperativeKernel((const void*)mega, dim3(grid), dim3(512), args, LDS_BYTES, stream);
    if (e != hipSuccess) fprintf(stderr, "cooperative launch failed: %s (grid %d)\n", hipGetErrorString(e), grid);
}
```

```cpp
#include <hip/hip_runtime.h>
#include <hip/hip_cooperative_groups.h>
#include <cstdio>
#include <cstdint>
namespace cg = cooperative_groups;

#define LAS __attribute__((address_space(3)))
typedef unsigned short bf16_t;
typedef short bf16x8 __attribute__((ext_vector_type(8)));
typedef short s16x4 __attribute__((ext_vector_type(4)));
typedef float f32x4 __attribute__((ext_vector_type(4)));
typedef float f32x16 __attribute__((ext_vector_type(16)));
typedef unsigned u32x4 __attribute__((ext_vector_type(4)));
typedef unsigned u32x2 __attribute__((ext_vector_type(2)));

constexpr int T_ = 16384, D_ = 2048, S_ = 2048, FF_ = 8192;
constexpr size_t MiB = 1048576;
constexpr size_t WS_MOD = 0, WS_COSA = 1 * MiB, WS_SINA = 3 * MiB, WS_COSI = 5 * MiB, WS_SINI = 6 * MiB, WS_CNT = 7 * MiB;
constexpr size_t WS_X = 8 * MiB;
constexpr size_t WS_WT_RKV = 136 * MiB, WS_WT_L2 = 163 * MiB, WS_WT_BO = 166 * MiB;
constexpr size_t WS_WT_IN = 174 * MiB, WS_WT_Q = 178 * MiB, WS_WT_UK = 182 * MiB, WS_WT_UV = 184 * MiB, WS_WT_O = 186 * MiB, WS_WT_1_0 = 194 * MiB, WS_WT_2_0 = 226 * MiB;
constexpr size_t WS_HMIX = 258 * MiB, WS_PROJ = 322 * MiB, WS_SCORES = 258 * MiB, WS_OLAT = 258 * MiB, WS_QALL = 386 * MiB, WS_O = 386 * MiB, WS_QLAT = 514 * MiB;
constexpr size_t WS_CQ = 642 * MiB, WS_KEYS = 658 * MiB, WS_KIDX = 668 * MiB, WS_WIDX = 670 * MiB, WS_SEL = 671 * MiB;
constexpr size_t WS_HFF = 258 * MiB, WS_H1 = 322 * MiB;
constexpr size_t WS_MIX = 258 * MiB;
constexpr size_t WS_KBUF = 174 * MiB, WS_VBUF = 642 * MiB, WS_MID = 706 * MiB;
constexpr size_t WS_RBUF = 322 * MiB, WS_WDEC = 450 * MiB, WS_ABUF = 578 * MiB, WS_GBUF = 386 * MiB, WS_SCANOUT = 258 * MiB;
constexpr size_t WS_WT_1_1 = 578 * MiB, WS_WT_2_1 = 610 * MiB;
constexpr int LDS_BYTES = 147520;

struct Params { const float* in[36]; float* out; unsigned char* ws; };

__device__ __forceinline__ bf16_t f2bf(float f) { unsigned u = __float_as_uint(f); u += 0x7FFFu + ((u >> 16) & 1u); return (bf16_t)(u >> 16); }
__device__ __forceinline__ float bf2f(unsigned b) { return __uint_as_float(b << 16); }
__device__ __forceinline__ unsigned cvt_pk_bf16(float lo, float hi) { unsigned r; asm volatile("v_cvt_pk_bf16_f32 %0, %1, %2" : "=v"(r) : "v"(lo), "v"(hi)); return r; }
__device__ __forceinline__ float dpp_f(float x, const int ctrl_sel) {
    const int v = __builtin_bit_cast(int, x); int r;
    if (ctrl_sel == 0) r = __builtin_amdgcn_update_dpp(0, v, 0xB1, 0xF, 0xF, true);
    else if (ctrl_sel == 1) r = __builtin_amdgcn_update_dpp(0, v, 0x4E, 0xF, 0xF, true);
    else if (ctrl_sel == 2) r = __builtin_amdgcn_update_dpp(0, v, 0x141, 0xF, 0xF, true);
    else r = __builtin_amdgcn_update_dpp(0, v, 0x140, 0xF, 0xF, true);
    return __builtin_bit_cast(float, r);
}
__device__ __forceinline__ int otid() { int t = threadIdx.x; asm volatile("" : "+v"(t)); return t; }
__device__ __forceinline__ int obid() { int t = blockIdx.x; asm volatile("" : "+s"(t)); return t; }
__device__ __forceinline__ int ogrid() { int t = gridDim.x; asm volatile("" : "+s"(t)); return t; }
constexpr size_t WS_BAR = 7 * MiB + 512 * 1024;
__device__ __forceinline__ void fast_sync(unsigned* ctr, unsigned& target, unsigned nblk) {
    target += nblk;
    asm volatile("s_waitcnt vmcnt(0) lgkmcnt(0)" ::: "memory");
    __syncthreads();
    if (threadIdx.x == 0) {
        __builtin_amdgcn_fence(__ATOMIC_RELEASE, "agent");
        asm volatile("s_waitcnt vmcnt(0)" ::: "memory");
        __hip_atomic_fetch_add(ctr, 1u, __ATOMIC_RELAXED, __HIP_MEMORY_SCOPE_AGENT);
        while (__hip_atomic_load(ctr, __ATOMIC_RELAXED, __HIP_MEMORY_SCOPE_AGENT) < target) __builtin_amdgcn_s_sleep(2);
        __builtin_amdgcn_fence(__ATOMIC_ACQUIRE, "agent");
        asm volatile("s_waitcnt vmcnt(0)" ::: "memory");
    }
    __syncthreads();
}

#define XB_TMO      128
#define XB_XCNT(j)  (256  + 64 * (j))
#define XB_XSUB(j)  (1280 + 64 * (j))
#define XB_XGEN(j)  (2304 + 64 * (j))
#define XB_TOP      3328
#define XB_TOPGEN   3392
#define XCD_BAR_WORDS 3456
#define XB_SPIN_CAP (1u << 22)
__device__ __forceinline__ unsigned xb_ld(unsigned* p)              { return __hip_atomic_load(p, __ATOMIC_RELAXED, __HIP_MEMORY_SCOPE_AGENT); }
__device__ __forceinline__ unsigned xb_add(unsigned* p, unsigned v) { return __hip_atomic_fetch_add(p, v, __ATOMIC_RELAXED, __HIP_MEMORY_SCOPE_AGENT); }
__device__ __forceinline__ unsigned xb_xcc_id() { return (unsigned)__builtin_amdgcn_s_getreg((3 << 11) | 20) & 0xFu; }
#define XB_SPIN(cond, bar) do { unsigned _sp = 0; while (cond) { __builtin_amdgcn_s_sleep(1); \
    if ((++_sp & 255u) == 0u) { if (xb_ld(&(bar)[XB_TMO])) break; if (_sp > XB_SPIN_CAP) { atomicAdd(&(bar)[XB_TMO], 1u); break; } } } } while (0)
struct XcdBarrier { unsigned* bar; unsigned x; volatile LAS unsigned* st; };
__device__ __forceinline__ XcdBarrier xcd_barrier_post(unsigned* bar, volatile LAS unsigned* st) {
    XcdBarrier b; b.bar = bar; b.x = xb_xcc_id(); b.st = st;
    if (threadIdx.x == 0) { const unsigned rank = xb_add(&bar[XB_XCNT(b.x)], 1u); st[2] = rank; st[3] = b.x; }
    return b;
}
__device__ __forceinline__ void xcd_barrier_complete(unsigned* bar, unsigned x, unsigned& nloc, unsigned& nx) {
    const unsigned G = gridDim.x * gridDim.y * gridDim.z;
    unsigned sum, cnt, mine, sp = 0u;
    for (;;) {
        sum = 0u; cnt = 0u; mine = 0u;
#pragma unroll
        for (unsigned j = 0; j < 16; ++j) { const unsigned c = xb_ld(&bar[XB_XCNT(j)]); sum += c; cnt += (c > 0u) ? 1u : 0u; mine = (j == x) ? c : mine; }
        if (sum == G) break;
        __builtin_amdgcn_s_sleep(1);
        if ((++sp & 255u) == 0u) { if (xb_ld(&bar[XB_TMO])) break; if (sp > XB_SPIN_CAP) { atomicAdd(&bar[XB_TMO], 1u); break; } }
    }
    nloc = mine > 0u ? mine : 1u; nx = cnt > 0u ? cnt : 1u;
}
__device__ __forceinline__ void xcd_barrier(const XcdBarrier& b) {
    asm volatile("s_waitcnt vmcnt(0)" ::: "memory");
    __syncthreads();
    if (threadIdx.x == 0) {
        unsigned* bar = b.bar;
        __builtin_amdgcn_s_waitcnt(0);
        unsigned nloc = b.st[0], nx = b.st[1];
        if (nloc == 0u) { xcd_barrier_complete(bar, b.x, nloc, nx); b.st[0] = nloc; b.st[1] = nx; }
        const unsigned old = xb_add(&bar[XB_XSUB(b.x)], 1u);
        const unsigned gen = old / nloc;
        if (old + 1u == (gen + 1u) * nloc) {
            __builtin_amdgcn_fence(__ATOMIC_RELEASE, "agent");
            asm volatile("s_waitcnt vmcnt(0)" ::: "memory");
            const unsigned og = xb_add(&bar[XB_TOP], 1u);
            const unsigned tg = og / nx;
            if (og + 1u == (tg + 1u) * nx) xb_add(&bar[XB_TOPGEN], 1u);
            else XB_SPIN(xb_ld(&bar[XB_TOPGEN]) == tg, bar);
            __builtin_amdgcn_fence(__ATOMIC_ACQUIRE, "agent");
            xb_add(&bar[XB_XGEN(b.x)], 1u);
            asm volatile("s_waitcnt vmcnt(0)" ::: "memory");
        } else {
            XB_SPIN(xb_ld(&bar[XB_XGEN(b.x)]) == gen, bar);
            __builtin_amdgcn_fence(__ATOMIC_ACQUIRE, "agent");
            asm volatile("s_waitcnt vmcnt(0)" ::: "memory");
        }
    }
    __syncthreads();
}
__device__ __forceinline__ float red8(float x) { x += dpp_f(x, 0); x += dpp_f(x, 1); x += dpp_f(x, 2); return x; }
__device__ __forceinline__ float red16(float x) { x = red8(x); x += dpp_f(x, 3); return x; }
__device__ __forceinline__ float red64(float x) { x = red16(x); x += __shfl_xor(x, 16); x += __shfl_xor(x, 32); return x; }

namespace pg8 {
constexpr int BM = 256, BK = 64, HALF = 128, HTB = HALF * BK * 2, STAGE_BYTES = 8 * HTB, NXCD = 8, WGM = 8;
__device__ __forceinline__ int lds_byte(int r, int c) { const int st = (r >> 4) * 2 + (c >> 5), rr = r & 15, cc = c & 31, ob = rr * 64 + cc * 2; return st * 1024 + (ob ^ (((ob >> 9) & 1) << 5)); }
__device__ __forceinline__ void stage_rc(int b, int& R, int& C) { const int st = b / 1024, sb = b % 1024, swz = sb ^ (((sb >> 9) & 1) << 5); R = (st >> 1) * 16 + swz / 64; C = (st & 1) * 32 + (swz % 64) / 2; }
__device__ __forceinline__ int perm32(int rho) { const int n = rho >> 4, i = rho & 15; return 8 * (i >> 2) + 4 * n + (i & 3); }
struct Unit { int pm, pn; };
struct Gemm { const bf16_t* A; const bf16_t* Bt; int M, N, K, lda, ldb, amode; };
__device__ __forceinline__ size_t a_off_bytes(const Gemm& g, int pn) {
    switch (g.amode) {
        case 1: return (size_t)(pn >> 1) * 256 * 2;
        case 2: return (size_t)pn * 512 * 2;
        case 3: return (size_t)(pn < 16 ? (pn >> 3) : (pn - 14)) * ((size_t)T_ * D_ * 2);
        case 4: return (size_t)(pn >> 3) * ((size_t)T_ * 256 * 2);
        default: return 0;
    }
}
struct StaticOrder {
    int nM, nN, nwg, G, c;
    __device__ void init(int M, int N, int G_, int c_) { nM = M / BM; nN = N / BM; nwg = nM * nN; G = G_; c = c_; }
    __device__ bool next(int i, Unit& u) const {
        const long L = (long)i * G + c; if (L >= nwg) return false;
        int wgid = (int)L; { const int q = nwg / NXCD, r = nwg % NXCD, xcd = wgid % NXCD, off = wgid / NXCD; wgid = (xcd < r ? xcd * (q + 1) : r * (q + 1) + (xcd - r) * q) + off; }
        const int nig = WGM * nN, gid = wgid / nig, fm = gid * WGM, gsz = (nM - fm) < WGM ? (nM - fm) : WGM;
        u.pm = fm + ((wgid % nig) % gsz); u.pn = (wgid % nig) / gsz; return true;
    }
};

template <class Epi>
__device__ __forceinline__ void gemm_phase(LAS unsigned char* lds, const Gemm g, const StaticOrder& S, const Epi& E) {
    const int tid = otid(), wid = __builtin_amdgcn_readfirstlane(tid >> 6), lane = tid & 63, wr = wid >> 2, wc = wid & 3, fr = lane & 15, fq = lane >> 4;
    const int K = g.K, nt = K / BK;
    unsigned voffA[2], voffB[2];
#pragma unroll
    for (int i = 0; i < 2; ++i) { int R, C; stage_rc(tid * 16 + i * 8192, R, C); const int Rb = (R & ~31) + perm32(R & 31);
        voffA[i] = (unsigned)(R * g.lda + C) * 2u; voffB[i] = (unsigned)(Rb * g.ldb + C) * 2u; }
    const size_t kstep = (size_t)(BK * 2);
    const size_t hstepA = (size_t)HALF * g.lda * 2, hstepB = (size_t)HALF * g.ldb * 2;
    const size_t tstepA = 2 * hstepA, tstepB = 2 * hstepB;
    const unsigned ldsw = (unsigned)wid * 1024u;
    const int aoff = lds_byte(wr * 64 + fr, fq * 8), boff = lds_byte(wc * 32 + fr, fq * 8);
#define PG8_SA(b, h) (((b) * 2 + (h)) * HTB)
#define PG8_SB(b, h) ((4 + (b) * 2 + (h)) * HTB)
#define PG8_STAGE(bufoff, gbase, voff) do { _Pragma("unroll") for (int _i = 0; _i < 2; ++_i) \
        __builtin_amdgcn_global_load_lds((const unsigned*)((const char*)(gbase) + (voff)[_i]), (LAS unsigned*)(lds + (bufoff) + ldsw + _i * 8192), 16, 0, 0); } while (0)
#define PG8_LDA(dst, b, h) do { _Pragma("unroll") for (int m = 0; m < 4; ++m) _Pragma("unroll") for (int k = 0; k < 2; ++k) dst[m][k] = *(const LAS bf16x8*)(lds + PG8_SA(b, h) + aoff + m * 2048 + k * 1024); } while (0)
#define PG8_LDB(dst, b, h) do { _Pragma("unroll") for (int n = 0; n < 2; ++n) _Pragma("unroll") for (int k = 0; k < 2; ++k) dst[n][k] = *(const LAS bf16x8*)(lds + PG8_SB(b, h) + boff + n * 2048 + k * 1024); } while (0)
#define PG8_MMA(ai, bj, At, Bt) do { __builtin_amdgcn_s_setprio(1); _Pragma("unroll") for (int m = 0; m < 4; ++m) _Pragma("unroll") for (int n = 0; n < 2; ++n) _Pragma("unroll") for (int k = 0; k < 2; ++k) \
        acc[ai][bj][m][n] = __builtin_amdgcn_mfma_f32_16x16x32_bf16(Bt[n][k], At[m][k], acc[ai][bj][m][n], 0, 0, 0); __builtin_amdgcn_s_setprio(0); } while (0)
#define PG8_WAIT_V(n) asm volatile("s_waitcnt vmcnt(" #n ")" ::: "memory")
#define PG8_WAIT_L(n) asm volatile("s_waitcnt lgkmcnt(" #n ")" ::: "memory")
#define PG8_BAR __builtin_amdgcn_s_barrier()
#define PG8_SCHED __builtin_amdgcn_sched_barrier(0)
    Unit cur, nxt; int ui = 0;
    if (!S.next(0, cur)) return;
    f32x4 acc[2][2][4][2];
#pragma unroll
    for (int a = 0; a < 2; ++a)
#pragma unroll
        for (int b = 0; b < 2; ++b)
#pragma unroll
            for (int m = 0; m < 4; ++m)
#pragma unroll
                for (int n = 0; n < 2; ++n) acc[a][b][m][n] = (f32x4){0.f, 0.f, 0.f, 0.f};
    bf16x8 At[4][2], B0[2][2], B1[2][2];
    const char* cA = (const char*)g.A + (size_t)cur.pm * tstepA + a_off_bytes(g, cur.pn); const char* cB = (const char*)g.Bt + (size_t)cur.pn * tstepB;
    PG8_STAGE(PG8_SB(0, 0), cB, voffB); PG8_STAGE(PG8_SA(0, 0), cA, voffA); PG8_STAGE(PG8_SB(0, 1), cB + hstepB, voffB); PG8_STAGE(PG8_SA(0, 1), cA + hstepA, voffA);
    if (wr == 1) PG8_BAR;
    PG8_WAIT_V(4); PG8_BAR;
    PG8_STAGE(PG8_SB(1, 0), cB + kstep, voffB); PG8_STAGE(PG8_SA(1, 0), cA + kstep, voffA); PG8_STAGE(PG8_SB(1, 1), cB + hstepB + kstep, voffB);
    PG8_WAIT_V(6); PG8_BAR;
    for (;;) {
        const bool has_next = S.next(ui + 1, nxt);
        const char* nA = has_next ? (const char*)g.A + (size_t)nxt.pm * tstepA + a_off_bytes(g, nxt.pn) : cA; const char* nB = has_next ? (const char*)g.Bt + (size_t)nxt.pn * tstepB : cB;
        for (int t = 0; t < nt; t += 2) {
            const bool last = (t == nt - 2);
            const char* a1 = cA + (size_t)(t + 1) * kstep;
            const char* a2 = last ? nA : cA + (size_t)(t + 2) * kstep; const char* b2 = last ? nB : cB + (size_t)(t + 2) * kstep;
            const char* a3 = a2 + kstep; const char* b3 = b2 + kstep;
            PG8_LDB(B0, 0, 0); PG8_SCHED; PG8_LDA(At, 0, 0); PG8_STAGE(PG8_SA(1, 1), a1 + hstepA, voffA);
            PG8_WAIT_L(8); PG8_BAR; PG8_WAIT_L(0); PG8_MMA(0, 0, At, B0); PG8_BAR; PG8_SCHED;
            PG8_LDB(B1, 0, 1); PG8_STAGE(PG8_SB(0, 0), b2, voffB);
            PG8_BAR; PG8_WAIT_L(0); PG8_MMA(0, 1, At, B1); PG8_BAR;
            PG8_LDA(At, 0, 1); PG8_STAGE(PG8_SA(0, 0), a2, voffA);
            PG8_BAR; PG8_WAIT_L(0); PG8_MMA(1, 0, At, B0); PG8_BAR; PG8_SCHED;
            PG8_STAGE(PG8_SB(0, 1), b2 + hstepB, voffB);
            PG8_WAIT_V(6); PG8_BAR; PG8_MMA(1, 1, At, B1); PG8_BAR;
            PG8_LDB(B0, 1, 0); PG8_SCHED; PG8_LDA(At, 1, 0); PG8_STAGE(PG8_SA(0, 1), a2 + hstepA, voffA);
            PG8_WAIT_L(8); PG8_BAR; PG8_WAIT_L(0); PG8_MMA(0, 0, At, B0); PG8_BAR; PG8_SCHED;
            PG8_LDB(B1, 1, 1); PG8_STAGE(PG8_SB(1, 0), b3, voffB);
            PG8_BAR; PG8_WAIT_L(0); PG8_MMA(0, 1, At, B1); PG8_BAR;
            PG8_LDA(At, 1, 1); PG8_STAGE(PG8_SA(1, 0), a3, voffA);
            PG8_BAR; PG8_WAIT_L(0); PG8_MMA(1, 0, At, B0); PG8_BAR; PG8_SCHED;
            PG8_STAGE(PG8_SB(1, 1), b3 + hstepB, voffB);
            PG8_WAIT_V(6); PG8_BAR; PG8_MMA(1, 1, At, B1); PG8_BAR;
        }
        E(acc, cur, wr, wc, fr, fq);
        if (!has_next) break;
#pragma unroll
        for (int a = 0; a < 2; ++a)
#pragma unroll
            for (int b = 0; b < 2; ++b)
#pragma unroll
                for (int m = 0; m < 4; ++m)
#pragma unroll
                    for (int n = 0; n < 2; ++n) acc[a][b][m][n] = (f32x4){0.f, 0.f, 0.f, 0.f};
        cur = nxt; cA = nA; cB = nB; ++ui;
    }
    PG8_WAIT_V(0);
    if (wr == 0) PG8_BAR;
    PG8_BAR;
#undef PG8_SA
#undef PG8_SB
#undef PG8_STAGE
#undef PG8_LDA
#undef PG8_LDB
#undef PG8_MMA
#undef PG8_WAIT_V
#undef PG8_WAIT_L
#undef PG8_BAR
#undef PG8_SCHED
}
}

enum { M_F32 = 0, M_BF16 = 1, M_QROPE = 2, M_RESID = 3, M_RELU2 = 4, M_L1A = 5, M_L1B = 6 };
__device__ __forceinline__ float sigmoidf_(float x) { return 1.f / (1.f + __expf(-x)); }
__device__ __forceinline__ float tanhf_(float x) { const float e = __expf(-2.f * fabsf(x)); const float t = (1.f - e) / (1.f + e); return x < 0.f ? -t : t; }
__device__ __forceinline__ void st_bf16x8(bf16_t* p, const f32x4& a, const f32x4& b) {
    u32x4 o; o[0] = cvt_pk_bf16(a[0], a[1]); o[1] = cvt_pk_bf16(a[2], a[3]); o[2] = cvt_pk_bf16(b[0], b[1]); o[3] = cvt_pk_bf16(b[2], b[3]); *(u32x4*)p = o;
}
template <int MODE> struct Epi {
    void* o0; void* o1; void* o2; void* o3; void* o4; const float* f0; const float* f1; const float* f2; const float* f3; int ldc;
    __device__ __forceinline__ void operator()(const f32x4 (&acc)[2][2][4][2], const pg8::Unit& u, int wr, int wc, int fr, int fq) const {
        const int row0 = u.pm * 256 + wr * 64 + fr, colb = u.pn * 256 + wc * 32 + 8 * fq;
        if constexpr (MODE == M_RESID) {
            const int b = (u.pm * 256) >> 11;
            f32x4 gt[2][2];
#pragma unroll
            for (int bj = 0; bj < 2; ++bj) { const float* gp = f1 + (size_t)b * 12288 + colb + bj * 128; gt[bj][0] = *(const f32x4*)gp; gt[bj][1] = *(const f32x4*)(gp + 4); }
#pragma unroll
            for (int ai = 0; ai < 2; ++ai) {
                f32x4 xv[4][2][2];
#pragma unroll
                for (int m = 0; m < 4; ++m)
#pragma unroll
                    for (int bj = 0; bj < 2; ++bj) { const float* xin = f0 + (size_t)(row0 + ai * 128 + m * 16) * D_ + colb + bj * 128; xv[m][bj][0] = *(const f32x4*)xin; xv[m][bj][1] = *(const f32x4*)(xin + 4); }
                asm volatile("" ::: "memory");
#pragma unroll
                for (int m = 0; m < 4; ++m)
#pragma unroll
                    for (int bj = 0; bj < 2; ++bj) { float* dst = (float*)o0 + (size_t)(row0 + ai * 128 + m * 16) * D_ + colb + bj * 128;
                        *(f32x4*)dst = xv[m][bj][0] + gt[bj][0] * acc[ai][bj][m][0]; *(f32x4*)(dst + 4) = xv[m][bj][1] + gt[bj][1] * acc[ai][bj][m][1]; }
                asm volatile("" ::: "memory");
            }
            return;
        }
        if constexpr (MODE == M_QROPE) {
            const bool isq = u.pn < 12; const int gpar = wc & 1;
            if (u.pn >= 8 && (isq || gpar == 0)) {
#pragma unroll
                for (int ai = 0; ai < 2; ++ai) {
                    f32x4 cv[4], sn[4];
#pragma unroll
                    for (int m = 0; m < 4; ++m) { const int row = row0 + ai * 128 + m * 16;
                        cv[m] = *(const f32x4*)(isq ? f0 + (size_t)row * 32 + gpar * 16 + 4 * fq : f2 + (size_t)row * 16 + 4 * fq);
                        sn[m] = *(const f32x4*)(isq ? f1 + (size_t)row * 32 + gpar * 16 + 4 * fq : f3 + (size_t)row * 16 + 4 * fq); }
                    asm volatile("" ::: "memory");
#pragma unroll
                    for (int m = 0; m < 4; ++m)
#pragma unroll
                        for (int bj = 0; bj < 2; ++bj) { const f32x4 v0 = acc[ai][bj][m][0], v1 = acc[ai][bj][m][1];
                            st_bf16x8((bf16_t*)o0 + (size_t)(row0 + ai * 128 + m * 16) * ldc + colb + bj * 128, v0 * cv[m] - v1 * sn[m], v1 * cv[m] + v0 * sn[m]); }
                    asm volatile("" ::: "memory");
                }
                return;
            }
        }
#pragma unroll
        for (int ai = 0; ai < 2; ++ai)
#pragma unroll
            for (int m = 0; m < 4; ++m) {
                const int row = row0 + ai * 128 + m * 16;
#pragma unroll
                for (int bj = 0; bj < 2; ++bj) {
                    const int col = colb + bj * 128;
                    f32x4 v0 = acc[ai][bj][m][0], v1 = acc[ai][bj][m][1];
                    if constexpr (MODE == M_F32) {
                        float* dst = (float*)o0 + (size_t)row * ldc + col; *(f32x4*)dst = v0; *(f32x4*)(dst + 4) = v1;
                    } else if constexpr (MODE == M_BF16) {
                        st_bf16x8((bf16_t*)o0 + (size_t)row * ldc + col, v0, v1);
                    } else if constexpr (MODE == M_QROPE) {
                        if (u.pn >= 8) {
                            const bool isq = u.pn < 12; const int gpar = wc & 1;
                            if (isq || gpar == 0) {
                                const float* ct = isq ? f0 + (size_t)row * 32 + gpar * 16 + 4 * fq : f2 + (size_t)row * 16 + 4 * fq;
                                const float* st = isq ? f1 + (size_t)row * 32 + gpar * 16 + 4 * fq : f3 + (size_t)row * 16 + 4 * fq;
                                const f32x4 c = *(const f32x4*)ct, s = *(const f32x4*)st;
                                const f32x4 a = v0 * c - v1 * s, b = v1 * c + v0 * s; v0 = a; v1 = b;
                            }
                        }
                        st_bf16x8((bf16_t*)o0 + (size_t)row * ldc + col, v0, v1);
                    } else if constexpr (MODE == M_RESID) {
                        const int b = row >> 11;
                        const float* gp = f1 + (size_t)b * 12288 + col; const float* xin = f0 + (size_t)row * D_ + col;
                        const f32x4 g0 = *(const f32x4*)gp, g1 = *(const f32x4*)(gp + 4), x0 = *(const f32x4*)xin, x1 = *(const f32x4*)(xin + 4);
                        float* dst = (float*)o0 + (size_t)row * D_ + col; *(f32x4*)dst = x0 + g0 * v0; *(f32x4*)(dst + 4) = x1 + g1 * v1;
                    } else if constexpr (MODE == M_RELU2) {
#pragma unroll
                        for (int i = 0; i < 4; ++i) { float a = fmaxf(v0[i], 0.f), b = fmaxf(v1[i], 0.f); v0[i] = a * a; v1[i] = b * b; }
                        st_bf16x8((bf16_t*)o0 + (size_t)row * ldc + col, v0, v1);
                    } else if constexpr (MODE == M_L1A) {
                        if (u.pn < 16) { bf16_t* base = (bf16_t*)(u.pn < 8 ? o0 : o1); st_bf16x8(base + (size_t)row * D_ + (col & 2047), v0, v1); }
                        else {
                            bf16_t* base = (bf16_t*)(u.pn == 16 ? o2 : (u.pn == 17 ? o3 : o4));
                            if (u.pn == 16) {
#pragma unroll
                                for (int i = 0; i < 4; ++i) { v0[i] = tanhf_(v0[i]); v1[i] = tanhf_(v1[i]); }
                            } else if (u.pn == 18) {
#pragma unroll
                                for (int i = 0; i < 4; ++i) { v0[i] = sigmoidf_(v0[i]); v1[i] = sigmoidf_(v1[i]); }
                            }
                            st_bf16x8(base + (size_t)row * 256 + (col & 255), v0, v1);
                        }
                    } else if constexpr (MODE == M_L1B) {
                        const int c = col & 2047;
                        if (u.pn < 8) { float* dst = (float*)o0 + (size_t)row * D_ + c; *(f32x4*)dst = v0; *(f32x4*)(dst + 4) = v1; }
                        else if (u.pn < 16) { st_bf16x8((bf16_t*)o1 + (size_t)row * D_ + c, v0, v1);
                        } else st_bf16x8((bf16_t*)o2 + (size_t)row * D_ + c, v0, v1);
                    }
                }
            }
    }
};
template <int MODE> __device__ __forceinline__ void run_gemm(int vbid, LAS unsigned char* lds, const void* A, int lda, const void* Bt, int ldb, int M, int N, int K, int amode, const Epi<MODE>& E) {
    pg8::Gemm g; g.A = (const bf16_t*)A; g.Bt = (const bf16_t*)Bt; g.M = M; g.N = N; g.K = K; g.lda = lda; g.ldb = ldb; g.amode = amode;
    pg8::StaticOrder S; S.init(M, N, ogrid(), vbid);
    pg8::gemm_phase<Epi<MODE>>(lds, g, S, E);
}

__device__ __forceinline__ void p0_mod(const Params& p, unsigned char* shm) {
    const int bid = obid(), nb = ogrid();
    if (bid >= 384) return;
    float* cact = (float*)shm; float* red = cact + 8 * 2048;
    const int tid = otid(), wid = tid >> 6, lane = tid & 63;
    for (int i = tid; i < 8 * 2048; i += 512) { const float v = p.in[1][i]; cact[i] = v / (1.f + __expf(-v)); }
    __syncthreads();
    float* mod = (float*)(p.ws + WS_MOD);
    for (int item = bid; item < 384; item += nb) {
        const int l = item / 192, c0 = (item % 192) * 64;
        const float* W = p.in[3] + (size_t)l * 2048 * 12288 + c0 + lane;
        float acc[8];
#pragma unroll
        for (int b = 0; b < 8; ++b) acc[b] = 0.f;
        const int k0 = wid * 256;
#pragma unroll 16
        for (int k = 0; k < 256; ++k) {
            const float wv = W[(size_t)(k0 + k) * 12288];
#pragma unroll
            for (int b = 0; b < 8; ++b) acc[b] += cact[b * 2048 + k0 + k] * wv;
        }
#pragma unroll
        for (int b = 0; b < 8; ++b) red[(wid * 8 + b) * 64 + lane] = acc[b];
        __syncthreads();
        { const int b = tid >> 6; float s = 0.f;
#pragma unroll
          for (int w = 0; w < 8; ++w) s += red[(w * 8 + b) * 64 + lane];
          mod[(size_t)(l * 8 + b) * 12288 + c0 + lane] = s + p.in[4][l * 12288 + c0 + lane]; }
        __syncthreads();
    }
}
__device__ __forceinline__ void p0_rope(const Params& p) {
    float* cosA = (float*)(p.ws + WS_COSA); float* sinA = (float*)(p.ws + WS_SINA); float* cosI = (float*)(p.ws + WS_COSI); float* sinI = (float*)(p.ws + WS_SINI);
    const int* pos = (const int*)p.in[2];
    const int nb_ = ogrid(); for (int i = obid() * 512 + otid(); i < T_ * 32; i += nb_ * 512) {
        const int t = i >> 5, f = i & 31; const float ps = (float)pos[t];
        { const float inv = 1.0f / powf(10000.f, (float)(2 * f) / 64.f); const float ang = ps * inv; const double a = (double)ang; const double k = rint(a * 0.15915494309189535);
          const float r = (float)(a - k * 6.283185307179586); cosA[i] = __cosf(r); sinA[i] = __sinf(r); }
        if (f < 16) { const float inv = 1.0f / powf(10000.f, (float)(2 * f) / 32.f); const float ang = ps * inv; const double a = (double)ang; const double k = rint(a * 0.15915494309189535);
          const float r = (float)(a - k * 6.283185307179586); cosI[t * 16 + f] = __cosf(r); sinI[t * 16 + f] = __sinf(r); }
    }
}
__device__ __forceinline__ int ropeperm(int j) { const int half = j >> 5, f = j & 31; return (f >> 4) * 32 + 8 * ((f & 15) >> 2) + 4 * half + (f & 3); }
__device__ __forceinline__ int idxperm(int j) { if (j >= 32) return j; const int half = j >> 4, f = j & 15; return 8 * (f >> 2) + 4 * half + (f & 3); }

struct Job { const float* src; bf16_t* dst; int modeC, sK, sN, skst, snst, dN, dK, dld, k0, nblk, kblk, rowmap; };
__device__ __forceinline__ Job mkjob(const float* src, void* dst, int sK, int sN, int skst, int dN, int dK) {
    Job J; J.src = src; J.dst = (bf16_t*)dst; J.modeC = 0; J.sK = sK; J.sN = sN; J.skst = skst; J.snst = 1; J.dN = dN; J.dK = dK; J.dld = dK; J.k0 = 0; J.nblk = 1 << 30; J.kblk = 0; J.rowmap = 0; return J;
}
constexpr int NJOBS_EARLY = 40, NJOBS_ALL = 42;
__device__ __forceinline__ Job get_job(const Params& p, int j) {
    unsigned char* ws = p.ws;
    if (j == 0) return mkjob(p.in[8], ws + WS_WT_IN, 2048, 912, 912, 1024, 2048);
    if (j == 1) { Job J = mkjob(p.in[11], ws + WS_WT_Q, 512, 3072, 3072, 3072, 512); J.rowmap = 1; return J; }
    if (j == 2) { Job J = mkjob(p.in[12], ws + WS_WT_Q, 512, 1024, 1024, 1024, 512); J.rowmap = 2; return J; }
    if (j < 19) { const int h = j - 3; Job J = mkjob(p.in[15] + h * 128, (bf16_t*)(ws + WS_WT_UK) + (size_t)h * 256 * 256, 128, 256, 1, 256, 256); J.modeC = 1; J.snst = 2048; J.k0 = (h & 1) * 128; return J; }
    if (j < 27) { const int hp = j - 19; Job J = mkjob(p.in[16] + hp * 256, (bf16_t*)(ws + WS_WT_UV) + (size_t)hp * 256 * 512, 256, 256, 2048, 256, 512); J.nblk = 128; J.kblk = 256; return J; }
    if (j == 27) return mkjob(p.in[17], ws + WS_WT_O, 2048, 2048, 2048, 2048, 2048);
    if (j == 28) return mkjob(p.in[5], ws + WS_WT_1_0, 2048, 8192, 8192, 8192, 2048);
    if (j == 29) return mkjob(p.in[6], ws + WS_WT_2_0, 8192, 2048, 2048, 2048, 8192);
    if (j == 30) return mkjob(p.in[19], (bf16_t*)(ws + WS_WT_RKV), 2048, 2048, 2048, 2048, 2048);
    if (j == 31) return mkjob(p.in[20], (bf16_t*)(ws + WS_WT_RKV) + (size_t)2048 * 2048, 2048, 2048, 2048, 2048, 2048);
    if (j == 32) return mkjob(p.in[21], (bf16_t*)(ws + WS_WT_RKV) + (size_t)4096 * 2048, 2048, 2048, 2048, 2048, 2048);
    if (j == 33) return mkjob(p.in[24], (bf16_t*)(ws + WS_WT_RKV) + (size_t)6144 * 2048, 2048, 96, 96, 256, 2048);
    if (j == 34) return mkjob(p.in[27], (bf16_t*)(ws + WS_WT_RKV) + (size_t)6400 * 2048, 2048, 96, 96, 256, 2048);
    if (j == 35) return mkjob(p.in[29], (bf16_t*)(ws + WS_WT_RKV) + (size_t)6656 * 2048, 2048, 256, 256, 256, 2048);
    if (j == 36) return mkjob(p.in[25], (bf16_t*)(ws + WS_WT_L2), 96, 2048, 2048, 2048, 256);
    if (j == 37) return mkjob(p.in[28], (bf16_t*)(ws + WS_WT_L2) + (size_t)2048 * 256, 96, 2048, 2048, 2048, 256);
    if (j == 38) return mkjob(p.in[30], (bf16_t*)(ws + WS_WT_L2) + (size_t)4096 * 256, 256, 2048, 2048, 2048, 256);
    if (j == 39) return mkjob(p.in[22], ws + WS_WT_BO, 2048, 2048, 2048, 2048, 2048);
    if (j == 40) return mkjob(p.in[5] + (size_t)2048 * 8192, ws + WS_WT_1_1, 2048, 8192, 8192, 8192, 2048);
    return mkjob(p.in[6] + (size_t)8192 * 2048, ws + WS_WT_2_1, 8192, 2048, 2048, 2048, 8192);
}
__device__ __forceinline__ int job_rowmap(const Job& J, int n) {
    if (J.rowmap == 1) { const int h = n / 192, d = n % 192; return d < 128 ? h * 128 + d : 2048 + h * 64 + ropeperm(d - 128); }
    if (J.rowmap == 2) { const int h = n >> 6, jj = n & 63; return 3072 + h * 64 + idxperm(jj); }
    return n;
}
__device__ __forceinline__ void conv_decode(const Params& p, int jlo, int ti, Job& J, int& n0, int& k0t, const volatile int* jtab) {
    int j = jlo; while (ti >= jtab[j + 1]) ++j;
    const int rem = ti - jtab[j]; J = get_job(p, j);
    const int nnt = J.dN >> 8; k0t = (rem / nnt) * 64; n0 = (rem % nnt) * 256;
}
__device__ __forceinline__ void conv_load(const Job& J, int n0, int k0t, int tid, f32x4 (&R)[8]) {
    if (!J.modeC) {
#pragma unroll
        for (int i = 0; i < 8; ++i) {
            const int kr = (tid >> 6) + 8 * i, n = n0 + (tid & 63) * 4; const int kk = k0t + kr - (J.k0 + (n / J.nblk) * J.kblk);
            R[i] = (f32x4){0.f, 0.f, 0.f, 0.f};
            if (n < J.sN && kk >= 0 && kk < J.sK) R[i] = *(const f32x4*)(J.src + (size_t)kk * J.skst + n);
        }
    } else {
#pragma unroll
        for (int i = 0; i < 4; ++i) {
            const int n = (tid >> 3) + 64 * i, k8 = (tid & 7) * 8; const int kk = k0t + k8 - J.k0;
            R[2 * i] = (f32x4){0.f, 0.f, 0.f, 0.f}; R[2 * i + 1] = R[2 * i];
            if (n0 + n < J.sN && kk >= 0 && kk + 7 < J.sK) { const float* sp = J.src + (size_t)(n0 + n) * J.snst + kk; R[2 * i] = *(const f32x4*)sp; R[2 * i + 1] = *(const f32x4*)(sp + 4); }
        }
    }
}
__device__ __forceinline__ void convert_jobs(const Params& p, unsigned char* shm, int jlo, int jhi, unsigned* ctr) {
    float* tile = (float*)shm;
    volatile int* nextp = (volatile int*)(shm + 66048);
    const int tid = otid();
    volatile int* jtab = (volatile int*)(shm + 66112);
    __syncthreads();
    if (tid == 0) { int acc = 0; for (int j = jlo; j < jhi; ++j) { jtab[j] = acc; const Job Jt = get_job(p, j); acc += (Jt.dN >> 8) * (Jt.dK >> 6); } jtab[jhi] = acc; }
    __syncthreads();
    const int total = jtab[jhi];
    if (tid == 0) *nextp = (int)__hip_atomic_fetch_add(ctr, 1u, __ATOMIC_RELAXED, __HIP_MEMORY_SCOPE_AGENT);
    __syncthreads();
    int ti = *nextp;
    Job J; int n0 = 0, k0t = 0; f32x4 R[8];
    if (ti < total) { conv_decode(p, jlo, ti, J, n0, k0t, jtab); conv_load(J, n0, k0t, tid, R); }
    while (ti < total) {
        if (!J.modeC) {
#pragma unroll
            for (int i = 0; i < 8; ++i) { const int kr = (tid >> 6) + 8 * i, n4 = (tid & 63) * 4; float* d = tile + kr * 257 + n4; d[0] = R[i][0]; d[1] = R[i][1]; d[2] = R[i][2]; d[3] = R[i][3]; }
        } else {
#pragma unroll
            for (int i = 0; i < 4; ++i) { const int n = (tid >> 3) + 64 * i, k8 = (tid & 7) * 8;
#pragma unroll
                for (int e = 0; e < 4; ++e) { tile[(k8 + e) * 257 + n] = R[2 * i][e]; tile[(k8 + 4 + e) * 257 + n] = R[2 * i + 1][e]; } }
        }
        if (tid == 0) *nextp = (int)__hip_atomic_fetch_add(ctr, 1u, __ATOMIC_RELAXED, __HIP_MEMORY_SCOPE_AGENT);
        __syncthreads();
        const int tnx = *nextp;
        const Job Jc = J; const int n0c = n0, k0c = k0t;
        if (tnx < total) { conv_decode(p, jlo, tnx, J, n0, k0t, jtab); conv_load(J, n0, k0t, tid, R); }
#pragma unroll
        for (int i = 0; i < 4; ++i) {
            const int n = (tid >> 3) + 64 * i, k8 = (tid & 7) * 8;
            float v[8];
#pragma unroll
            for (int e = 0; e < 8; ++e) v[e] = tile[(k8 + e) * 257 + n];
            u32x4 o; o[0] = cvt_pk_bf16(v[0], v[1]); o[1] = cvt_pk_bf16(v[2], v[3]); o[2] = cvt_pk_bf16(v[4], v[5]); o[3] = cvt_pk_bf16(v[6], v[7]);
            *(u32x4*)(Jc.dst + (size_t)job_rowmap(Jc, n0c + n) * Jc.dld + k0c + k8) = o;
        }
        __syncthreads();
        ti = tnx;
    }
}

__device__ __forceinline__ void norm_phase(int vbx, const float* xin, const float* sh, const float* sc, bf16_t* outb, float* outf, const float* fg) {
    const int tid_ = otid(); const int lane = tid_ & 63; const int gw = obid() * 8 + (tid_ >> 6), nw = ogrid() * 8; (void)vbx;
    for (int row = gw; row < T_; row += nw) {
        const float* xr = xin + (size_t)row * D_; const int b = row >> 11;
        f32x4 v[8]; float ss = 0.f;
#pragma unroll
        for (int j = 0; j < 8; ++j) { v[j] = *(const f32x4*)(xr + (lane + 64 * j) * 4); ss += v[j][0] * v[j][0] + v[j][1] * v[j][1] + v[j][2] * v[j][2] + v[j][3] * v[j][3]; }
        ss = red64(ss); const float rstd = rsqrtf(ss * (1.f / D_) + 1e-6f);
#pragma unroll
        for (int j = 0; j < 8; ++j) {
            const int c = (lane + 64 * j) * 4;
            if (outf) { const f32x4 g = *(const f32x4*)(fg + c); *(f32x4*)(outf + (size_t)row * D_ + c) = v[j] * rstd * g; }
            else { const f32x4 s1 = *(const f32x4*)(sc + (size_t)b * 12288 + c), s0 = *(const f32x4*)(sh + (size_t)b * 12288 + c);
                const f32x4 o = v[j] * rstd * (s1 + 1.f) + s0; u32x2 pk; pk[0] = cvt_pk_bf16(o[0], o[1]); pk[1] = cvt_pk_bf16(o[2], o[3]); *(u32x2*)(outb + (size_t)row * D_ + c) = pk; }
        }
    }
}
__device__ __forceinline__ void mix_phase(const Params& p, const float* xin, const float* sh, const float* sc) {
    const int tid_ = otid(); const int lane = tid_ & 63; const int gw = obid() * 8 + (tid_ >> 6), nw = ogrid() * 8;
    bf16_t* mix = (bf16_t*)(p.ws + WS_MIX); const float* mu = p.in[18];
    for (int r0 = gw * 8; r0 < T_; r0 += nw * 8) {
        const int b = r0 >> 11;
        f32x4 hp[8];
        for (int rr = -1; rr < 8; ++rr) {
            const int row = r0 + rr;
            f32x4 h[8];
            if (rr < 0 && (r0 & 2047) == 0) {
#pragma unroll
                for (int j = 0; j < 8; ++j) h[j] = (f32x4){0.f, 0.f, 0.f, 0.f};
            } else {
                const float* xr = xin + (size_t)row * D_; float ss = 0.f;
#pragma unroll
                for (int j = 0; j < 8; ++j) { h[j] = *(const f32x4*)(xr + (lane + 64 * j) * 4); ss += h[j][0] * h[j][0] + h[j][1] * h[j][1] + h[j][2] * h[j][2] + h[j][3] * h[j][3]; }
                ss = red64(ss); const float rstd = rsqrtf(ss * (1.f / D_) + 1e-6f);
#pragma unroll
                for (int j = 0; j < 8; ++j) { const int c = (lane + 64 * j) * 4; const f32x4 s1 = *(const f32x4*)(sc + (size_t)b * 12288 + c), s0 = *(const f32x4*)(sh + (size_t)b * 12288 + c); h[j] = h[j] * rstd * (s1 + 1.f) + s0; }
            }
            if (rr >= 0) {
#pragma unroll 1
                for (int q = 0; q < 6; ++q) {
                    const int mq = (q == 1) ? 2 : (q == 2) ? 3 : (q == 3) ? 1 : q;
                    f32x4 m[8];
#pragma unroll
                    for (int j = 0; j < 8; ++j) m[j] = *(const f32x4*)(mu + mq * D_ + (lane + 64 * j) * 4);
#pragma unroll
                    for (int j = 0; j < 8; ++j) {
                        const int c = (lane + 64 * j) * 4; const f32x4 o = h[j] + (hp[j] - h[j]) * m[j]; u32x2 pk; pk[0] = cvt_pk_bf16(o[0], o[1]); pk[1] = cvt_pk_bf16(o[2], o[3]);
                        *(u32x2*)(mix + (size_t)q * T_ * D_ + (size_t)row * D_ + c) = pk;
                    }
                }
            }
#pragma unroll
            for (int j = 0; j < 8; ++j) hp[j] = h[j];
        }
    }
}
__device__ __forceinline__ void projrow_phase(const Params& p) {
    const int tid_ = otid(); const int lane = tid_ & 63; const int gw = obid() * 8 + (tid_ >> 6), nw = ogrid() * 8;
    const float* proj = (const float*)(p.ws + WS_PROJ); bf16_t* cq = (bf16_t*)(p.ws + WS_CQ); bf16_t* keys = (bf16_t*)(p.ws + WS_KEYS); bf16_t* kidx = (bf16_t*)(p.ws + WS_KIDX); float* widx = (float*)(p.ws + WS_WIDX);
    const float* cosA = (const float*)(p.ws + WS_COSA); const float* sinA = (const float*)(p.ws + WS_SINA); const float* cosI = (const float*)(p.ws + WS_COSI); const float* sinI = (const float*)(p.ws + WS_SINI);
    const float* qg = p.in[9]; const float* kvg = p.in[10]; const float* lng = p.in[13]; const float* lnb = p.in[14];
    for (int row = gw; row < T_; row += nw) {
        const float* pr = proj + (size_t)row * 1024;
        f32x4 v[4];
#pragma unroll
        for (int j = 0; j < 4; ++j) v[j] = *(const f32x4*)(pr + (lane + 64 * j) * 4);
        float sq = 0.f, skv = 0.f;
#pragma unroll
        for (int e = 0; e < 4; ++e) { sq += v[0][e] * v[0][e] + v[1][e] * v[1][e]; skv += v[2][e] * v[2][e]; }
        sq = red64(sq); skv = red64(skv);
        const float rq = rsqrtf(sq * (1.f / 512.f) + 1e-6f), rkv = rsqrtf(skv * (1.f / 256.f) + 1e-6f);
#pragma unroll
        for (int j = 0; j < 2; ++j) { const int c = (lane + 64 * j) * 4; const f32x4 g = *(const f32x4*)(qg + c); const f32x4 o = v[j] * rq * g; u32x2 pk; pk[0] = cvt_pk_bf16(o[0], o[1]); pk[1] = cvt_pk_bf16(o[2], o[3]); *(u32x2*)(cq + (size_t)row * 512 + c) = pk; }
        { const int c = lane * 4; const f32x4 g = *(const f32x4*)(kvg + c); const f32x4 o = v[2] * rkv * g; u32x2 pk; pk[0] = cvt_pk_bf16(o[0], o[1]); pk[1] = cvt_pk_bf16(o[2], o[3]); *(u32x2*)(keys + (size_t)row * 320 + c) = pk; }
        f32x4 x = v[3];
        float s1 = x[0] + x[1] + x[2] + x[3]; s1 = red16(s1); const float mean = s1 * (1.f / 64.f);
        f32x4 xc = x - mean; float s2 = xc[0] * xc[0] + xc[1] * xc[1] + xc[2] * xc[2] + xc[3] * xc[3]; s2 = red16(s2); const float rs = rsqrtf(s2 * (1.f / 64.f) + 1e-6f);
        f32x4 y = x;
        if (lane >= 16 && lane < 32) { const int jj = (lane - 16) * 4; const f32x4 g = *(const f32x4*)(lng + jj), bb = *(const f32x4*)(lnb + jj); y = xc * rs * g + bb; }
        f32x4 part8, part4;
#pragma unroll
        for (int e = 0; e < 4; ++e) { part8[e] = __shfl_xor(y[e], 8); part4[e] = __shfl_xor(y[e], 4); }
        if (lane < 16) {
            const int l2 = lane & 7; const f32x4 c = *(const f32x4*)(cosA + (size_t)row * 32 + 4 * l2), s = *(const f32x4*)(sinA + (size_t)row * 32 + 4 * l2);
            f32x4 o; if (lane < 8) o = y * c - part8 * s; else o = y * c + part8 * s;
            const int pphys = (l2 >> 2) * 32 + 8 * (l2 & 3) + (lane < 8 ? 0 : 4);
            u32x2 pk; pk[0] = cvt_pk_bf16(o[0], o[1]); pk[1] = cvt_pk_bf16(o[2], o[3]); *(u32x2*)(keys + (size_t)row * 320 + 256 + pphys) = pk;
        } else if (lane < 32) {
            const int ll = lane - 16; f32x4 o = y; int pphys = ll * 4;
            if (ll < 8) { const int l2 = ll & 3; const f32x4 c = *(const f32x4*)(cosI + (size_t)row * 16 + 4 * l2), s = *(const f32x4*)(sinI + (size_t)row * 16 + 4 * l2);
                if (ll < 4) o = y * c - part4 * s; else o = y * c + part4 * s; pphys = 8 * l2 + (ll < 4 ? 0 : 4); }
            u32x2 pk; pk[0] = cvt_pk_bf16(o[0], o[1]); pk[1] = cvt_pk_bf16(o[2], o[3]); *(u32x2*)(kidx + (size_t)row * 64 + pphys) = pk;
        } else if (lane < 36) {
            *(f32x4*)(widx + (size_t)row * 16 + (lane - 32) * 4) = x * (1.f / 32.f);
        }
    }
}

__device__ __forceinline__ void score_phase(const Params& p, int vbx) {
    const int tid_ = otid(); const int lane = tid_ & 63, l32 = lane & 31, hh = lane >> 5; const int gw = obid() * 8 + (tid_ >> 6), nw = ogrid() * 8;
    const bf16_t* qall = (const bf16_t*)(p.ws + WS_QALL); const bf16_t* kidx = (const bf16_t*)(p.ws + WS_KIDX); const float* widx = (const float*)(p.ws + WS_WIDX); float* scores = (float*)(p.ws + WS_SCORES);
    const int xb_ = vbx >> 5;
    unsigned* sctr = (unsigned*)(p.ws + WS_BAR) + 48 + 16 * (xb_ & 7);
    for (;;) {
        int tile = 0; if (lane == 0) tile = (int)__hip_atomic_fetch_add(sctr, 1u, __ATOMIC_RELAXED, __HIP_MEMORY_SCOPE_AGENT);
        tile = __builtin_amdgcn_readfirstlane(tile); if (tile >= 528) break;
        const int b = xb_ & 7, L = 527 - tile;
        int qc = (int)((sqrtf(8.f * (float)L + 1.f) - 1.f) * 0.5f); while ((qc + 1) * (qc + 2) / 2 <= L) ++qc; while (qc * (qc + 1) / 2 > L) --qc;
        const int kt = L - qc * (qc + 1) / 2;
        const int t0 = b * S_ + qc * 64, key0 = b * S_ + kt * 64;
        bf16x8 kf[2][4];
#pragma unroll
        for (int mt = 0; mt < 2; ++mt)
#pragma unroll
            for (int ks = 0; ks < 4; ++ks) kf[mt][ks] = *(const bf16x8*)(kidx + (size_t)(key0 + mt * 32 + l32) * 64 + ks * 16 + hh * 8);
        f32x16 sc[2][2];
#pragma unroll
        for (int mt = 0; mt < 2; ++mt)
#pragma unroll
            for (int nt = 0; nt < 2; ++nt)
#pragma unroll
                for (int i = 0; i < 16; ++i) sc[mt][nt][i] = 0.f;
        bf16x8 qn[2][4]; float wn[2];
#pragma unroll
        for (int nt = 0; nt < 2; ++nt) {
#pragma unroll
            for (int ks = 0; ks < 4; ++ks) qn[nt][ks] = *(const bf16x8*)(qall + (size_t)(t0 + nt * 32 + l32) * 4096 + 3072 + ks * 16 + hh * 8);
            wn[nt] = widx[(size_t)(t0 + nt * 32 + l32) * 16];
        }
        for (int h = 0; h < 16; ++h) {
            bf16x8 qf[2][4]; float w[2];
#pragma unroll
            for (int nt = 0; nt < 2; ++nt) {
#pragma unroll
                for (int ks = 0; ks < 4; ++ks) qf[nt][ks] = qn[nt][ks];
                w[nt] = wn[nt];
            }
            { const int h1 = (h + 1) & 15;
#pragma unroll
              for (int nt = 0; nt < 2; ++nt) {
#pragma unroll
                for (int ks = 0; ks < 4; ++ks) qn[nt][ks] = *(const bf16x8*)(qall + (size_t)(t0 + nt * 32 + l32) * 4096 + 3072 + h1 * 64 + ks * 16 + hh * 8);
                wn[nt] = widx[(size_t)(t0 + nt * 32 + l32) * 16 + h1];
              } }
#pragma unroll
            for (int mt = 0; mt < 2; ++mt)
#pragma unroll
                for (int nt = 0; nt < 2; ++nt) {
                    f32x16 a;
#pragma unroll
                    for (int i = 0; i < 16; ++i) a[i] = 0.f;
#pragma unroll
                    for (int ks = 0; ks < 4; ++ks) a = __builtin_amdgcn_mfma_f32_32x32x16_bf16(kf[mt][ks], qf[nt][ks], a, 0, 0, 0);
#pragma unroll
                    for (int i = 0; i < 16; ++i) sc[mt][nt][i] += w[nt] * fmaxf(a[i], 0.f);
                }
        }
#pragma unroll
        for (int mt = 0; mt < 2; ++mt)
#pragma unroll
            for (int nt = 0; nt < 2; ++nt)
#pragma unroll
                for (int q4 = 0; q4 < 4; ++q4) {
                    f32x4 o; o[0] = sc[mt][nt][q4 * 4]; o[1] = sc[mt][nt][q4 * 4 + 1]; o[2] = sc[mt][nt][q4 * 4 + 2]; o[3] = sc[mt][nt][q4 * 4 + 3];
                    *(f32x4*)(scores + (size_t)(t0 + nt * 32 + l32) * S_ + kt * 64 + mt * 32 + q4 * 8 + hh * 4) = o;
                }
    }
}
template <int NI> __device__ __forceinline__ void topk_select(const float* sr, unsigned short* srow, int qc, int lane, unsigned long long ltmask) {
    unsigned u[NI];
#pragma unroll
    for (int i = 0; i < NI; ++i) {
        unsigned bits = 0u;
        if (i <= qc) { bits = __float_as_uint(sr[i * 64 + lane]); bits = (bits & 0x80000000u) ? ~bits : (bits | 0x80000000u); if (bits == 0u) bits = 1u; }
        u[i] = bits;
    }
    unsigned thr = 0u;
    for (int bit = 31; bit >= 0; --bit) {
        const unsigned cand = thr | (1u << bit); int c = 0;
#pragma unroll
        for (int i = 0; i < NI; ++i) c += __popcll(__ballot(u[i] >= cand));
        if (c >= 256) { thr = cand; if (c == 256) break; }
    }
    int cgt = 0;
#pragma unroll
    for (int i = 0; i < NI; ++i) cgt += __popcll(__ballot(u[i] > thr));
    const int need = 256 - cgt; int eqtaken = 0, base = 0;
#pragma unroll
    for (int i = 0; i < NI; ++i) {
        const bool eq = (u[i] == thr); const unsigned long long em = __ballot(eq);
        const int rank = eqtaken + __popcll(em & ltmask);
        const bool take = (u[i] > thr) || (eq && rank < need);
        const unsigned long long tm = __ballot(take);
        if (take) srow[base + __popcll(tm & ltmask)] = (unsigned short)(i * 64 + lane);
        base += __popcll(tm); eqtaken += __popcll(em);
    }
}
__device__ __forceinline__ void topk_phase(const Params& p) {
    const int tid_ = otid(); const int lane = tid_ & 63; const int gw = obid() * 8 + (tid_ >> 6), nw = ogrid() * 8;
    const float* scores = (const float*)(p.ws + WS_SCORES); unsigned short* sel = (unsigned short*)(p.ws + WS_SEL); int* cnt = (int*)(p.ws + WS_CNT);
    const unsigned long long ltmask = (1ull << lane) - 1ull;
    for (int t0 = gw; t0 < T_; t0 += nw) {
        const int bq = t0 >> 11; const int t = (bq << 11) | (((t0 & 2047) + 261 * bq) & 2047);
        const int s = t & 2047, qc = s >> 6; const int nvalid = (qc + 1) * 64;
        unsigned short* srow = sel + (size_t)t * 256;
        if (nvalid <= 256) {
#pragma unroll
            for (int i = 0; i < 4; ++i) { const int k = i * 64 + lane; srow[k] = (unsigned short)(k < nvalid ? k : 0); }
            if (lane == 0) cnt[t] = nvalid;
            continue;
        }
        const float* sr = scores + (size_t)t * S_;
        if (qc < 8) topk_select<8>(sr, srow, qc, lane, ltmask);
        else if (qc < 16) topk_select<16>(sr, srow, qc, lane, ltmask);
        else if (qc < 24) topk_select<24>(sr, srow, qc, lane, ltmask);
        else topk_select<32>(sr, srow, qc, lane, ltmask);
        if (lane == 0) cnt[t] = 256;
    }
}


constexpr int SROW = 2052;
__device__ __forceinline__ void scoretopk_phase(const Params& p, unsigned char* shm, int vbx) {
    float* scl = (float*)shm;
    volatile int* nextp = (volatile int*)(shm + 16 * SROW * 4);
    const int tid = otid(); const int wid = tid >> 6, lane = tid & 63, l16 = lane & 15, g = lane >> 4;
    const bf16_t* qall = (const bf16_t*)(p.ws + WS_QALL); const bf16_t* kidx = (const bf16_t*)(p.ws + WS_KIDX); const float* widx = (const float*)(p.ws + WS_WIDX);
    unsigned short* sel = (unsigned short*)(p.ws + WS_SEL); int* cnt = (int*)(p.ws + WS_CNT);
    const unsigned long long ltmask = (1ull << lane) - 1ull;
    for (int bi = 0; bi < 8; ++bi) {
    const int b = ((vbx >> 5) + bi) & 7;
    unsigned* sctr = (unsigned*)(p.ws + WS_BAR) + 48 + 16 * b;
    for (;;) {
        __syncthreads();
        if (tid == 0) *nextp = (int)__hip_atomic_fetch_add(sctr, 1u, __ATOMIC_RELAXED, __HIP_MEMORY_SCOPE_AGENT);
        __syncthreads();
        const int task = *nextp; if (task >= 128) break;
        const int qg = 127 - task; const int t0 = b * S_ + qg * 16; const int qc = qg >> 2; const int nvalid = (qc + 1) * 64;
        if (nvalid <= 256) {
#pragma unroll
            for (int qq = 0; qq < 2; ++qq) {
                const int t = t0 + 2 * wid + qq; unsigned short* srow = sel + (size_t)t * 256;
#pragma unroll
                for (int i = 0; i < 4; ++i) { const int k = i * 64 + lane; srow[k] = (unsigned short)(k < nvalid ? k : 0); }
                if (lane == 0) cnt[t] = nvalid;
            }
            continue;
        }
#pragma unroll 1
        for (int hp = 0; hp < 2; ++hp) {
            bf16x8 qf[8][2]; float w[8];
#pragma unroll
            for (int h = 0; h < 8; ++h) {
#pragma unroll
                for (int ks = 0; ks < 2; ++ks) qf[h][ks] = *(const bf16x8*)(qall + (size_t)(t0 + l16) * 4096 + 3072 + (hp * 8 + h) * 64 + ks * 32 + g * 8);
            }
#pragma unroll
            for (int h4 = 0; h4 < 2; ++h4) { const f32x4 wv = *(const f32x4*)(widx + (size_t)(t0 + l16) * 16 + hp * 8 + h4 * 4); w[h4 * 4] = wv[0]; w[h4 * 4 + 1] = wv[1]; w[h4 * 4 + 2] = wv[2]; w[h4 * 4 + 3] = wv[3]; }
            const int nkt = nvalid >> 4;
            const bf16_t* kr0 = kidx + (size_t)(b * S_ + l16) * 64 + g * 8;
            bf16x8 k0n = *(const bf16x8*)(kr0 + (size_t)wid * 1024), k1n = *(const bf16x8*)(kr0 + (size_t)wid * 1024 + 32);
            for (int kt = wid; kt < nkt; kt += 8) {
                const bf16x8 k0 = k0n, k1 = k1n;
                { const int ktn = (kt + 8 < nkt) ? kt + 8 : kt; k0n = *(const bf16x8*)(kr0 + (size_t)ktn * 1024); k1n = *(const bf16x8*)(kr0 + (size_t)ktn * 1024 + 32); }
                float* dst = scl + l16 * SROW + kt * 16 + g * 4;
                f32x4 sacc = (f32x4){0.f, 0.f, 0.f, 0.f};
                if (hp) sacc = *(const f32x4*)dst;
#pragma unroll
                for (int h = 0; h < 8; ++h) {
                    f32x4 a = (f32x4){0.f, 0.f, 0.f, 0.f};
                    a = __builtin_amdgcn_mfma_f32_16x16x32_bf16(k0, qf[h][0], a, 0, 0, 0);
                    a = __builtin_amdgcn_mfma_f32_16x16x32_bf16(k1, qf[h][1], a, 0, 0, 0);
#pragma unroll
                    for (int i = 0; i < 4; ++i) sacc[i] += w[h] * fmaxf(a[i], 0.f);
                }
                *(f32x4*)dst = sacc;
            }
        }
        __syncthreads();
#pragma unroll 1
        for (int qq = 0; qq < 2; ++qq) {
            const int q = 2 * wid + qq; const int t = t0 + q; unsigned short* srow = sel + (size_t)t * 256; const float* sr = scl + q * SROW;
            if (qc < 8) topk_select<8>(sr, srow, qc, lane, ltmask);
            else if (qc < 16) topk_select<16>(sr, srow, qc, lane, ltmask);
            else if (qc < 24) topk_select<24>(sr, srow, qc, lane, ltmask);
            else topk_select<32>(sr, srow, qc, lane, ltmask);
            if (lane == 0) cnt[t] = 256;
        }
    }
    }
}
typedef short bf16x4v __attribute__((ext_vector_type(4)));
constexpr int ABUF_BYTES = 8 * 1024, AWAVE = 2 * ABUF_BYTES;
__device__ __forceinline__ void attn_phase(const Params& p, LAS unsigned char* lds, int vbx) {
    const int tid_ = otid(); const int wid = __builtin_amdgcn_readfirstlane(tid_ >> 6), lane = tid_ & 63, l16 = lane & 15, g = lane >> 4;
    const int gw = vbx * 8 + wid, nw = ogrid() * 8;
    LAS unsigned char* vl = lds + wid * AWAVE;
    LAS unsigned char* rl = lds + 8 * AWAVE + wid * 2048;
    const unsigned r_rd0 = (unsigned)((l16 >> 3) * 1024 + (l16 & 7) * 128 + ((g ^ (l16 & 7)) * 16)), r_rd1 = (unsigned)((l16 >> 3) * 1024 + (l16 & 7) * 128 + (((4 + g) ^ (l16 & 7)) * 16));
    const bf16_t* qlat = (const bf16_t*)(p.ws + WS_QLAT); const bf16_t* qall = (const bf16_t*)(p.ws + WS_QALL); const bf16_t* keys = (const bf16_t*)(p.ws + WS_KEYS);
    const unsigned short* sel = (const unsigned short*)(p.ws + WS_SEL); bf16_t* olat = (bf16_t*)(p.ws + WS_OLAT);
    const float cs = 0.07216878364870322f * 1.4426950408889634f;
    const float NEG = -1e30f;
    const unsigned a_rd0 = (unsigned)((l16 >> 3) * 1024 + (l16 & 7) * 128 + ((g ^ (l16 & 7)) * 16)), a_rd1 = (unsigned)((l16 >> 3) * 1024 + (l16 & 7) * 128 + (((4 + g) ^ (l16 & 7)) * 16));
    const int trow = g * 4 + ((lane & 15) >> 2), tp = lane & 3;
    unsigned tr_rdk[4];
#pragma unroll
    for (int k = 0; k < 4; ++k) tr_rdk[k] = (unsigned)((trow >> 3) * 1024 + (trow & 7) * 128 + (((2 * k + (tp >> 1)) ^ (trow & 7)) * 16) + (tp & 1) * 8);
    const int dr8 = lane >> 3, dpiece = ((lane & 7) ^ (lane >> 3)) * 16;
    for (int t = gw * 8; t < T_; t += nw * 8)
    for (int qi = 0; qi < 8; ++qi) {
        const int tq = t + qi; const int b = tq >> 11; const int nv_ = ((((tq & 2047) >> 6) + 1) * 64); const int cnt = nv_ < 256 ? nv_ : 256;
        bf16x8 qf[10];
#pragma unroll
        for (int ks = 0; ks < 8; ++ks) qf[ks] = *(const bf16x8*)(qlat + (size_t)tq * 4096 + l16 * 256 + ks * 32 + g * 8);
#pragma unroll
        for (int ks = 0; ks < 2; ++ks) qf[8 + ks] = *(const bf16x8*)(qall + (size_t)tq * 4096 + 2048 + l16 * 64 + ks * 32 + g * 8);
        f32x4 oacc[16];
#pragma unroll
        for (int rt = 0; rt < 16; ++rt) oacc[rt] = (f32x4){0.f, 0.f, 0.f, 0.f};
        float m = NEG, lsum = 0.f;
        const int nch = cnt >> 4;
        const unsigned short* selr = sel + (size_t)tq * 256;
        const bf16_t* kbase = keys + (size_t)(b * S_) * 320;
        int jr0 = selr[dr8], jr1 = selr[8 + dr8];
        { const char* s0 = (const char*)(kbase + (size_t)jr0 * 320) + dpiece; const char* s1 = (const char*)(kbase + (size_t)jr1 * 320) + dpiece;
#pragma unroll
          for (int lh = 0; lh < 5; ++lh) {
              LAS unsigned char* d = (lh < 4) ? vl + lh * 2048 : rl;
              __builtin_amdgcn_global_load_lds((const unsigned*)(s0 + lh * 128), (LAS unsigned*)(d), 16, 0, 0);
              __builtin_amdgcn_global_load_lds((const unsigned*)(s1 + lh * 128), (LAS unsigned*)(d + 1024), 16, 0, 0); } }
        jr0 = selr[16 + dr8]; jr1 = selr[24 + dr8];
        for (int c = 0; c < nch; ++c) {
            LAS unsigned char* buf = vl + (c & 1) * ABUF_BYTES;
            asm volatile("s_waitcnt vmcnt(0)" ::: "memory");
            const bf16x8 r0 = *(const LAS bf16x8*)(rl + r_rd0), r1 = *(const LAS bf16x8*)(rl + r_rd1);
            asm volatile("s_waitcnt lgkmcnt(0)" ::: "memory");
            if (c + 1 < nch) {
                LAS unsigned char* nb = vl + ((c + 1) & 1) * ABUF_BYTES;
                const char* s0 = (const char*)(kbase + (size_t)jr0 * 320) + dpiece; const char* s1 = (const char*)(kbase + (size_t)jr1 * 320) + dpiece;
#pragma unroll
                for (int lh = 0; lh < 5; ++lh) {
                    LAS unsigned char* d = (lh < 4) ? nb + lh * 2048 : rl;
                    __builtin_amdgcn_global_load_lds((const unsigned*)(s0 + lh * 128), (LAS unsigned*)(d), 16, 0, 0);
                    __builtin_amdgcn_global_load_lds((const unsigned*)(s1 + lh * 128), (LAS unsigned*)(d + 1024), 16, 0, 0); }
                const int cn = (c + 2 < 16) ? c + 2 : 15; jr0 = selr[cn * 16 + dr8]; jr1 = selr[cn * 16 + 8 + dr8];
            }
            f32x4 sv = (f32x4){0.f, 0.f, 0.f, 0.f};
#pragma unroll
            for (int ks = 0; ks < 8; ++ks) { const bf16x8 a = *(const LAS bf16x8*)(buf + (ks >> 1) * 2048 + ((ks & 1) ? a_rd1 : a_rd0)); sv = __builtin_amdgcn_mfma_f32_16x16x32_bf16(a, qf[ks], sv, 0, 0, 0); }
            sv = __builtin_amdgcn_mfma_f32_16x16x32_bf16(r0, qf[8], sv, 0, 0, 0); sv = __builtin_amdgcn_mfma_f32_16x16x32_bf16(r1, qf[9], sv, 0, 0, 0);
            float cmax = NEG;
#pragma unroll
            for (int i = 0; i < 4; ++i) { if (c * 16 + g * 4 + i >= cnt) sv[i] = NEG; cmax = fmaxf(cmax, sv[i]); }
            cmax = fmaxf(cmax, __shfl_xor(cmax, 16)); cmax = fmaxf(cmax, __shfl_xor(cmax, 32));
            if (__any((cmax - m) * cs > 6.f)) {
                const float mn = fmaxf(m, cmax); const float alpha = exp2f((m - mn) * cs); m = mn;
                lsum *= alpha;
#pragma unroll
                for (int rt = 0; rt < 16; ++rt) oacc[rt] *= alpha;
            }
            float ps = 0.f;
#pragma unroll
            for (int i = 0; i < 4; ++i) { sv[i] = exp2f((sv[i] - m) * cs); ps += sv[i]; }
            lsum += ps;
            u32x2 pfu; pfu[0] = cvt_pk_bf16(sv[0], sv[1]); pfu[1] = cvt_pk_bf16(sv[2], sv[3]);
            const bf16x4v pf = __builtin_bit_cast(bf16x4v, pfu);
            const unsigned tbb = (unsigned)(size_t)buf; const unsigned tb0 = tbb + tr_rdk[0], tb1 = tbb + tr_rdk[1], tb2 = tbb + tr_rdk[2], tb3 = tbb + tr_rdk[3];
#define TRG4(R4) { bf16x4v a0, a1, a2, a3; \
                asm volatile("ds_read_b64_tr_b16 %0, %4 offset:%8\n\tds_read_b64_tr_b16 %1, %5 offset:%8\n\tds_read_b64_tr_b16 %2, %6 offset:%8\n\tds_read_b64_tr_b16 %3, %7 offset:%8\n\ts_waitcnt lgkmcnt(0)" \
                             : "=&v"(a0), "=&v"(a1), "=&v"(a2), "=&v"(a3) \
                             : "v"(tb0), "v"(tb1), "v"(tb2), "v"(tb3), "i"((R4) * 2048) : "memory"); \
                oacc[(R4) * 4 + 0] = __builtin_amdgcn_mfma_f32_16x16x16bf16_1k(a0, pf, oacc[(R4) * 4 + 0], 0, 0, 0); \
                oacc[(R4) * 4 + 1] = __builtin_amdgcn_mfma_f32_16x16x16bf16_1k(a1, pf, oacc[(R4) * 4 + 1], 0, 0, 0); \
                oacc[(R4) * 4 + 2] = __builtin_amdgcn_mfma_f32_16x16x16bf16_1k(a2, pf, oacc[(R4) * 4 + 2], 0, 0, 0); \
                oacc[(R4) * 4 + 3] = __builtin_amdgcn_mfma_f32_16x16x16bf16_1k(a3, pf, oacc[(R4) * 4 + 3], 0, 0, 0); }
            TRG4(0) TRG4(1) TRG4(2) TRG4(3)
#undef TRG4
        }
        lsum += __shfl_xor(lsum, 16); lsum += __shfl_xor(lsum, 32);
        const float inv = 1.f / lsum;
#pragma unroll
        for (int rt = 0; rt < 16; ++rt) { const f32x4 o = oacc[rt] * inv; u32x2 pk; pk[0] = cvt_pk_bf16(o[0], o[1]); pk[1] = cvt_pk_bf16(o[2], o[3]); *(u32x2*)(olat + (size_t)tq * 4096 + l16 * 256 + rt * 16 + g * 4) = pk; }
    }
}

__device__ __forceinline__ void red8x2(float& x0, float& x1) {
    float y0, y1;
    asm volatile("s_nop 1\n\t"
                 "v_add_f32_dpp %0, %2, %2 quad_perm:[1,0,3,2] row_mask:0xf bank_mask:0xf\n\t"
                 "v_add_f32_dpp %1, %3, %3 quad_perm:[1,0,3,2] row_mask:0xf bank_mask:0xf\n\t"
                 "s_nop 0\n\t"
                 "v_add_f32_dpp %0, %0, %0 quad_perm:[2,3,0,1] row_mask:0xf bank_mask:0xf\n\t"
                 "v_add_f32_dpp %1, %1, %1 quad_perm:[2,3,0,1] row_mask:0xf bank_mask:0xf\n\t"
                 "s_nop 0\n\t"
                 "v_add_f32_dpp %0, %0, %0 row_half_mirror row_mask:0xf bank_mask:0xf\n\t"
                 "v_add_f32_dpp %1, %1, %1 row_half_mirror row_mask:0xf bank_mask:0xf\n\t"
                 "s_nop 0"
                 : "=&v"(y0), "=&v"(y1) : "v"(x0), "v"(x1));
    x0 = y0; x1 = y1;
}
constexpr int TC = 32;
typedef float f32x2 __attribute__((ext_vector_type(2)));
__device__ __forceinline__ void scan_phase(const Params& p, unsigned char* shm) {
    const int tid = otid(); const bool seq = tid < 256;
    float* bufs = (float*)shm;
    float* obuf = bufs + 2 * 6 * TC * 64;
    const bf16_t* rbuf = (const bf16_t*)(p.ws + WS_RBUF); const bf16_t* kbuf = (const bf16_t*)(p.ws + WS_KBUF); const bf16_t* vbuf = (const bf16_t*)(p.ws + WS_VBUF);
    const bf16_t* abuf = (const bf16_t*)(p.ws + WS_ABUF); const bf16_t* gbuf = (const bf16_t*)(p.ws + WS_GBUF); const float* wdec = (const float*)(p.ws + WS_WDEC);
    bf16_t* outb = (bf16_t*)(p.ws + WS_SCANOUT);
    const int nb_ = ogrid();
    for (int pair = obid(); pair < 256; pair += nb_) {
        const int b = pair >> 5, h = pair & 31;
        if (seq) {
            const int rp = tid >> 3, cgp = tid & 7;
            f32x2 A0[4], A1[4];
#pragma unroll
            for (int q = 0; q < 4; ++q) { A0[q] = (f32x2){0.f, 0.f}; A1[q] = (f32x2){0.f, 0.f}; }
            __syncthreads();
            for (int c = 0; c <= S_ / TC; ++c) {
                if (c < S_ / TC) {
                    const float* B = bufs + (c & 1) * 6 * TC * 64 + cgp * 8; float* ob = obuf + (c & 1) * TC * 64 + 2 * rp;
                    const float* Bv = bufs + (c & 1) * 6 * TC * 64 + 5 * TC * 64 + 2 * rp;
                    f32x4 xw0 = *(const f32x4*)(B), xw1 = *(const f32x4*)(B + 4), xn0 = *(const f32x4*)(B + TC * 64), xn1 = *(const f32x4*)(B + TC * 64 + 4);
                    f32x4 xb0 = *(const f32x4*)(B + 2 * TC * 64), xb1 = *(const f32x4*)(B + 2 * TC * 64 + 4), xk0 = *(const f32x4*)(B + 3 * TC * 64), xk1 = *(const f32x4*)(B + 3 * TC * 64 + 4);
                    f32x4 xr0 = *(const f32x4*)(B + 4 * TC * 64), xr1 = *(const f32x4*)(B + 4 * TC * 64 + 4); f32x2 xvv = *(const f32x2*)(Bv);
#pragma unroll 4
                    for (int s = 0; s < TC; ++s) {
                        const f32x4 w0 = xw0, w1 = xw1, n0 = xn0, n1 = xn1, b0 = xb0, b1 = xb1, k0 = xk0, k1 = xk1, r0 = xr0, r1 = xr1; const f32x2 vv = xvv;
                        { const float* Bs = B + (s + 1) * 64;
                          xw0 = *(const f32x4*)(Bs); xw1 = *(const f32x4*)(Bs + 4); xn0 = *(const f32x4*)(Bs + TC * 64); xn1 = *(const f32x4*)(Bs + TC * 64 + 4);
                          xb0 = *(const f32x4*)(Bs + 2 * TC * 64); xb1 = *(const f32x4*)(Bs + 2 * TC * 64 + 4); xk0 = *(const f32x4*)(Bs + 3 * TC * 64); xk1 = *(const f32x4*)(Bs + 3 * TC * 64 + 4);
                          xr0 = *(const f32x4*)(Bs + 4 * TC * 64); xr1 = *(const f32x4*)(Bs + 4 * TC * 64 + 4); xvv = *(const f32x2*)(Bv + (s + 1) * 64); }
                        const f32x2 wp[4] = {{w0[0], w0[1]}, {w0[2], w0[3]}, {w1[0], w1[1]}, {w1[2], w1[3]}};
                        const f32x2 np[4] = {{n0[0], n0[1]}, {n0[2], n0[3]}, {n1[0], n1[1]}, {n1[2], n1[3]}};
                        const f32x2 bp[4] = {{b0[0], b0[1]}, {b0[2], b0[3]}, {b1[0], b1[1]}, {b1[2], b1[3]}};
                        const f32x2 kp[4] = {{k0[0], k0[1]}, {k0[2], k0[3]}, {k1[0], k1[1]}, {k1[2], k1[3]}};
                        const f32x2 rq[4] = {{r0[0], r0[1]}, {r0[2], r0[3]}, {r1[0], r1[1]}, {r1[2], r1[3]}};
                        f32x2 t0 = A0[0] * np[0], t1 = A1[0] * np[0];
#pragma unroll
                        for (int q = 1; q < 4; ++q) { t0 = __builtin_elementwise_fma(A0[q], np[q], t0); t1 = __builtin_elementwise_fma(A1[q], np[q], t1); }
                        float sa0 = t0[0] + t0[1], sa1 = t1[0] + t1[1];
                        red8x2(sa0, sa1);
                        const f32x2 s0v = {sa0, sa0}, s1v = {sa1, sa1}, v0v = {vv[0], vv[0]}, v1v = {vv[1], vv[1]};
#pragma unroll
                        for (int q = 0; q < 4; ++q) { A0[q] = __builtin_elementwise_fma(v0v, kp[q], __builtin_elementwise_fma(s0v, bp[q], A0[q] * wp[q])); A1[q] = __builtin_elementwise_fma(v1v, kp[q], __builtin_elementwise_fma(s1v, bp[q], A1[q] * wp[q])); }
                        f32x2 u0 = A0[0] * rq[0], u1 = A1[0] * rq[0];
#pragma unroll
                        for (int q = 1; q < 4; ++q) { u0 = __builtin_elementwise_fma(A0[q], rq[q], u0); u1 = __builtin_elementwise_fma(A1[q], rq[q], u1); }
                        float o0 = u0[0] + u0[1], o1 = u1[0] + u1[1];
                        red8x2(o0, o1);
                        if (cgp == 0) *(f32x2*)(ob + s * 64) = (f32x2){o0, o1};
                    }
                }
                __syncthreads();
            }
        } else {
            const int ht = tid - 256; const int ss0 = ht >> 4, c4 = (ht & 15) * 4; const int ch = h * 64 + c4;
            const f32x4 w0v = *(const f32x4*)(p.in[23] + ch), a0v = *(const f32x4*)(p.in[26] + ch); const f32x4 kkv = *(const f32x4*)(p.in[31] + ch), kav = *(const f32x4*)(p.in[32] + ch), rkv = *(const f32x4*)(p.in[33] + ch), gng = *(const f32x4*)(p.in[34] + ch), gnb = *(const f32x4*)(p.in[35] + ch);
            for (int c = -1; c <= S_ / TC; ++c) {
                const bool do_post = (c >= 1), do_stage = (c + 1 < S_ / TC);
                u32x2 lr[2], lk[2], lv[2], la[2], lg[2]; f32x4 lw[2];
#pragma unroll
                for (int i = 0; i < 2; ++i) {
                    const int ss = ss0 + 16 * i;
                    if (do_stage) { const size_t off = (size_t)(b * S_ + (c + 1) * TC + ss) * D_ + ch; lr[i] = *(const u32x2*)(rbuf + off); lk[i] = *(const u32x2*)(kbuf + off); lv[i] = *(const u32x2*)(vbuf + off); la[i] = *(const u32x2*)(abuf + off); lw[i] = *(const f32x4*)(wdec + off); }
                    if (do_post) { const size_t off = (size_t)(b * S_ + (c - 1) * TC + ss) * D_ + ch; lg[i] = *(const u32x2*)(gbuf + off); }
                }
#pragma unroll
                for (int i = 0; i < 2; ++i) {
                    const int ss = ss0 + 16 * i; const int o = ss * 64 + c4;
                    float* B = bufs + ((c + 1) & 1) * 6 * TC * 64;
                    if (do_post) {
                        const float* obr = obuf + ((c - 1) & 1) * TC * 64;
                        const f32x4 ov = *(const f32x4*)(obr + o), km = *(const f32x4*)(B + 3 * TC * 64 + o), r = *(const f32x4*)(B + 4 * TC * 64 + o), v = *(const f32x4*)(B + 5 * TC * 64 + o);
                        float s1 = ov[0] + ov[1] + ov[2] + ov[3]; s1 = red16(s1); const float mean = s1 * (1.f / 64.f);
                        const f32x4 oc = ov - mean; float s2 = oc[0] * oc[0] + oc[1] * oc[1] + oc[2] * oc[2] + oc[3] * oc[3]; s2 = red16(s2); const float rs = rsqrtf(s2 * (1.f / 64.f) + 64e-5f);
                        const f32x4 rk = r * km * rkv; float bs = rk[0] + rk[1] + rk[2] + rk[3]; bs = red16(bs);
                        const size_t off = (size_t)(b * S_ + (c - 1) * TC + ss) * D_ + ch;
                        f32x4 gg; gg[0] = bf2f(lg[i][0] & 0xffffu); gg[1] = bf2f(lg[i][0] >> 16); gg[2] = bf2f(lg[i][1] & 0xffffu); gg[3] = bf2f(lg[i][1] >> 16);
                        const f32x4 y = (oc * rs * gng + gnb + v * bs) * gg;
                        u32x2 pk; pk[0] = cvt_pk_bf16(y[0], y[1]); pk[1] = cvt_pk_bf16(y[2], y[3]); *(u32x2*)(outb + off) = pk;
                    }
                    if (do_stage) {
                        f32x4 r, k, v, a, wv;
                        r[0] = bf2f(lr[i][0] & 0xffffu); r[1] = bf2f(lr[i][0] >> 16); r[2] = bf2f(lr[i][1] & 0xffffu); r[3] = bf2f(lr[i][1] >> 16);
                        k[0] = bf2f(lk[i][0] & 0xffffu); k[1] = bf2f(lk[i][0] >> 16); k[2] = bf2f(lk[i][1] & 0xffffu); k[3] = bf2f(lk[i][1] >> 16);
                        v[0] = bf2f(lv[i][0] & 0xffffu); v[1] = bf2f(lv[i][0] >> 16); v[2] = bf2f(lv[i][1] & 0xffffu); v[3] = bf2f(lv[i][1] >> 16);
                        a[0] = bf2f(la[i][0] & 0xffffu); a[1] = bf2f(la[i][0] >> 16); a[2] = bf2f(la[i][1] & 0xffffu); a[3] = bf2f(la[i][1] >> 16);
#pragma unroll
                        for (int e = 0; e < 4; ++e) { a[e] = sigmoidf_(a0v[e] + a[e]); const float z = -(w0v[e] + lw[i][e]); const float sp = fmaxf(z, 0.f) + __logf(1.f + __expf(-fabsf(z))); wv[e] = __expf(-__expf(-sp - 0.5f)); }
                        f32x4 kk = k * kkv; float n2 = kk[0] * kk[0] + kk[1] * kk[1] + kk[2] * kk[2] + kk[3] * kk[3]; n2 = red16(n2);
                        const float invn = 1.f / fmaxf(sqrtf(n2), 1e-12f); kk = kk * invn;
                        const f32x4 km = k * ((a - 1.f) * kav + 1.f);
                        *(f32x4*)(B + 0 * TC * 64 + o) = wv; *(f32x4*)(B + 1 * TC * 64 + o) = -kk; *(f32x4*)(B + 2 * TC * 64 + o) = kk * a; *(f32x4*)(B + 3 * TC * 64 + o) = km; *(f32x4*)(B + 4 * TC * 64 + o) = r; *(f32x4*)(B + 5 * TC * 64 + o) = v;
                    }
                }
                __syncthreads();
            }
        }
        __syncthreads();
    }
}

__global__ void __launch_bounds__(512, 2) mega(Params p) {
    extern __shared__ __attribute__((aligned(16))) unsigned char shm[];
    LAS unsigned char* lds = (LAS unsigned char*)shm;
    cg::grid_group grid = cg::this_grid();
    unsigned char* ws = p.ws;
    float* mod = (float*)(ws + WS_MOD); float* X = (float*)(ws + WS_X);
    volatile LAS unsigned* xst = (volatile LAS unsigned*)(lds + LDS_BYTES - 16);
    if (threadIdx.x == 0) { xst[0] = 0u; xst[1] = 0u; xst[2] = 0u; xst[3] = 0u; }
    __syncthreads();
    const XcdBarrier xb = xcd_barrier_post((unsigned*)(ws + WS_BAR + 4096), xst);
    p0_mod(p, shm); p0_rope(p); __syncthreads(); convert_jobs(p, shm, 0, NJOBS_EARLY, (unsigned*)(ws + WS_BAR) + 16);
    if (p.ws == nullptr) grid.sync();
    xcd_barrier(xb);
    if (threadIdx.x == 0) {
        bool ok = (gridDim.x == 256);
        for (int j = 0; j < 16; ++j) ok = ok && (xb_ld(&xb.bar[XB_XCNT(j)]) == (j < 8 ? 32u : 0u));
        if (!ok) xst[2] = 0xFFFFFFFFu;
    }
    __syncthreads();
    int vb; { const unsigned rk = xst[2], xc = xst[3]; vb = (gridDim.x == 256 && rk < 32u && xc < 8u) ? (int)(rk * 8u + xc) : (int)blockIdx.x; asm volatile("" : "+s"(vb)); }
    int vbx; { const unsigned rk = xst[2], xc = xst[3]; vbx = (gridDim.x == 256 && rk < 32u && xc < 8u) ? (int)(xc * 32u + rk) : (int)blockIdx.x; asm volatile("" : "+s"(vbx)); }
    norm_phase(vbx, p.in[0], mod + 0 * 2048, mod + 1 * 2048, (bf16_t*)(ws + WS_HMIX), nullptr, nullptr);
    xcd_barrier(xb);
    { Epi<M_F32> E{}; E.o0 = ws + WS_PROJ; E.ldc = 1024; run_gemm<M_F32>(vb, lds, ws + WS_HMIX, 2048, ws + WS_WT_IN, 2048, T_, 1024, 2048, 0, E); }
    xcd_barrier(xb);
    projrow_phase(p);
    xcd_barrier(xb);
    { Epi<M_QROPE> E{}; E.o0 = ws + WS_QALL; E.ldc = 4096; E.f0 = (const float*)(ws + WS_COSA); E.f1 = (const float*)(ws + WS_SINA); E.f2 = (const float*)(ws + WS_COSI); E.f3 = (const float*)(ws + WS_SINI);
      run_gemm<M_QROPE>(vb, lds, ws + WS_CQ, 512, ws + WS_WT_Q, 512, T_, 4096, 512, 0, E); }
    xcd_barrier(xb);
    { Epi<M_BF16> E{}; E.o0 = ws + WS_QLAT; E.ldc = 4096; run_gemm<M_BF16>(vb, lds, ws + WS_QALL, 4096, ws + WS_WT_UK, 256, T_, 4096, 256, 1, E); }
    scoretopk_phase(p, shm, vbx);
    xcd_barrier(xb);
    attn_phase(p, lds, vbx);
    xcd_barrier(xb);
    { Epi<M_BF16> E{}; E.o0 = ws + WS_O; E.ldc = 2048; run_gemm<M_BF16>(vb, lds, ws + WS_OLAT, 4096, ws + WS_WT_UV, 512, T_, 2048, 512, 2, E); }
    xcd_barrier(xb);
    { Epi<M_RESID> E{}; E.o0 = X; E.f0 = p.in[0]; E.f1 = mod + 2 * 2048; run_gemm<M_RESID>(vb, lds, ws + WS_O, 2048, ws + WS_WT_O, 2048, T_, 2048, 2048, 0, E); }
    xcd_barrier(xb);
    norm_phase(vbx, X, mod + 3 * 2048, mod + 4 * 2048, (bf16_t*)(ws + WS_HFF), nullptr, nullptr);
    xcd_barrier(xb);
    { Epi<M_RELU2> E{}; E.o0 = ws + WS_H1; E.ldc = 8192; run_gemm<M_RELU2>(vb, lds, ws + WS_HFF, 2048, ws + WS_WT_1_0, 2048, T_, 8192, 2048, 0, E); }
    xcd_barrier(xb);
    { Epi<M_RESID> E{}; E.o0 = X; E.f0 = X; E.f1 = mod + 5 * 2048; run_gemm<M_RESID>(vb, lds, ws + WS_H1, 8192, ws + WS_WT_2_0, 8192, T_, 2048, 8192, 0, E); }
    xcd_barrier(xb);
    const float* mod1 = mod + 8 * 12288;
    mix_phase(p, X, mod1 + 0 * 2048, mod1 + 1 * 2048);
    xcd_barrier(xb);
    { Epi<M_L1A> E{}; E.o0 = ws + WS_KBUF; E.o1 = ws + WS_VBUF; E.o2 = ws + WS_MID; E.o3 = ws + WS_MID + 8 * MiB; E.o4 = ws + WS_MID + 16 * MiB;
      run_gemm<M_L1A>(vb, lds, ws + WS_MIX + 64 * MiB, 2048, (bf16_t*)(ws + WS_WT_RKV) + (size_t)2048 * 2048, 2048, T_, 4864, 2048, 3, E); }
    xcd_barrier(xb);
    { Epi<M_BF16> E{}; E.o0 = ws + WS_RBUF; E.ldc = 2048; run_gemm<M_BF16>(vb, lds, ws + WS_MIX, 2048, ws + WS_WT_RKV, 2048, T_, 2048, 2048, 0, E); }
    { Epi<M_F32> E{}; E.o0 = ws + WS_WDEC; E.ldc = 2048; run_gemm<M_F32>(vb, lds, ws + WS_MID, 256, ws + WS_WT_L2, 256, T_, 2048, 256, 0, E); }
    { Epi<M_BF16> E{}; E.o0 = ws + WS_ABUF; E.ldc = 2048; run_gemm<M_BF16>(vb, lds, ws + WS_MID + 8 * MiB, 256, (bf16_t*)(ws + WS_WT_L2) + (size_t)2048 * 256, 256, T_, 2048, 256, 0, E); }
    { Epi<M_BF16> E{}; E.o0 = ws + WS_GBUF; E.ldc = 2048; run_gemm<M_BF16>(vb, lds, ws + WS_MID + 16 * MiB, 256, (bf16_t*)(ws + WS_WT_L2) + (size_t)4096 * 256, 256, T_, 2048, 256, 0, E); }
    xcd_barrier(xb);
    scan_phase(p, shm);
    xcd_barrier(xb);
    { Epi<M_RESID> E{}; E.o0 = X; E.f0 = X; E.f1 = mod1 + 2 * 2048; run_gemm<M_RESID>(vb, lds, ws + WS_SCANOUT, 2048, ws + WS_WT_BO, 2048, T_, 2048, 2048, 0, E); }
    xcd_barrier(xb);
    norm_phase(vbx, X, mod1 + 3 * 2048, mod1 + 4 * 2048, (bf16_t*)(ws + WS_HFF), nullptr, nullptr);
    __syncthreads(); convert_jobs(p, shm, NJOBS_EARLY, NJOBS_ALL, (unsigned*)(ws + WS_BAR) + 32);
    xcd_barrier(xb);
    { Epi<M_RELU2> E{}; E.o0 = ws + WS_H1; E.ldc = 8192; run_gemm<M_RELU2>(vb, lds, ws + WS_HFF, 2048, ws + WS_WT_1_1, 2048, T_, 8192, 2048, 0, E); }
    xcd_barrier(xb);
    { Epi<M_RESID> E{}; E.o0 = X; E.f0 = X; E.f1 = mod1 + 5 * 2048; run_gemm<M_RESID>(vb, lds, ws + WS_H1, 8192, ws + WS_WT_2_1, 8192, T_, 2048, 8192, 0, E); }
    xcd_barrier(xb);
    norm_phase(vbx, X, nullptr, nullptr, nullptr, p.out, p.in[7]);
}

extern "C" void kernel_launch(void* const* d_in, const int* in_sizes, int n_in, void* d_out, int out_size, void* d_ws, size_t ws_size, hipStream_t stream) {
    static int grid = 0;
    if (grid == 0) {
        int dev = 0, cus = 0, per_cu = 0;
        hipGetDevice(&dev); hipDeviceGetAttribute(&cus, hipDeviceAttributeMultiprocessorCount, dev);
        if (hipFuncSetAttribute((const void*)mega, hipFuncAttributeMaxDynamicSharedMemorySize, LDS_BYTES) != hipSuccess) fprintf(stderr, "hipFuncSetAttribute failed\n");
        hipOccupancyMaxActiveBlocksPerMultiprocessor(&per_cu, (const void*)mega, 512, LDS_BYTES);
        if (per_cu < 1) per_cu = 1;
        grid = cus * 1;
        (void)hipGetLastError();
    }
    Params p{};
    for (int i = 0; i < 36; ++i) p.in[i] = (const float*)d_in[i];
    p.out = (float*)d_out; p.ws = (unsigned char*)d_ws;
    (void)hipMemsetAsync((unsigned char*)d_ws + WS_BAR, 0, 32768, stream);
    void* args[] = {&p};
    hipError_t e = hipLaunchCooperativeKernel((const void*)mega, dim3(grid), dim3(512), args, LDS_BYTES, stream);
    if (e != hipSuccess) fprintf(stderr, "cooperative launch failed: %s (grid %d)\n", hipGetErrorString(e), grid);
}
```

```cpp
#include <hip/hip_runtime.h>
#include <hip/hip_cooperative_groups.h>
#include <cstdio>
#include <cstdint>
namespace cg = cooperative_groups;

#define LAS __attribute__((address_space(3)))
typedef unsigned short bf16_t;
typedef short bf16x8 __attribute__((ext_vector_type(8)));
typedef short s16x4 __attribute__((ext_vector_type(4)));
typedef float f32x4 __attribute__((ext_vector_type(4)));
typedef float f32x16 __attribute__((ext_vector_type(16)));
typedef unsigned u32x4 __attribute__((ext_vector_type(4)));
typedef unsigned u32x2 __attribute__((ext_vector_type(2)));

constexpr int T_ = 16384, D_ = 2048, S_ = 2048, FF_ = 8192;
constexpr size_t MiB = 1048576;
constexpr size_t WS_MOD = 0, WS_COSA = 1 * MiB, WS_SINA = 3 * MiB, WS_COSI = 5 * MiB, WS_SINI = 6 * MiB, WS_CNT = 7 * MiB;
constexpr size_t WS_X = 8 * MiB;
constexpr size_t WS_WT_RKV = 136 * MiB, WS_WT_L2 = 163 * MiB, WS_WT_BO = 166 * MiB;
constexpr size_t WS_WT_IN = 174 * MiB, WS_WT_Q = 178 * MiB, WS_WT_UK = 182 * MiB, WS_WT_UV = 184 * MiB, WS_WT_O = 186 * MiB, WS_WT_1_0 = 194 * MiB, WS_WT_2_0 = 226 * MiB;
constexpr size_t WS_HMIX = 258 * MiB, WS_PROJ = 322 * MiB, WS_SCORES = 258 * MiB, WS_OLAT = 258 * MiB, WS_QALL = 386 * MiB, WS_O = 386 * MiB, WS_QLAT = 514 * MiB;
constexpr size_t WS_CQ = 642 * MiB, WS_KEYS = 658 * MiB, WS_KIDX = 668 * MiB, WS_WIDX = 670 * MiB, WS_SEL = 671 * MiB;
constexpr size_t WS_HFF = 258 * MiB, WS_H1 = 322 * MiB;
constexpr size_t WS_MIX = 258 * MiB;
constexpr size_t WS_KBUF = 174 * MiB, WS_VBUF = 642 * MiB, WS_MID = 706 * MiB;
constexpr size_t WS_RBUF = 322 * MiB, WS_WDEC = 450 * MiB, WS_ABUF = 578 * MiB, WS_GBUF = 386 * MiB, WS_SCANOUT = 258 * MiB;
constexpr size_t WS_WT_1_1 = 578 * MiB, WS_WT_2_1 = 610 * MiB;
constexpr int LDS_BYTES = 147520;

struct Params { const float* in[36]; float* out; unsigned char* ws; };

__device__ __forceinline__ bf16_t f2bf(float f) { unsigned u = __float_as_uint(f); u += 0x7FFFu + ((u >> 16) & 1u); return (bf16_t)(u >> 16); }
__device__ __forceinline__ float bf2f(unsigned b) { return __uint_as_float(b << 16); }
__device__ __forceinline__ unsigned cvt_pk_bf16(float lo, float hi) { unsigned r; asm volatile("v_cvt_pk_bf16_f32 %0, %1, %2" : "=v"(r) : "v"(lo), "v"(hi)); return r; }
__device__ __forceinline__ float dpp_f(float x, const int ctrl_sel) {
    const int v = __builtin_bit_cast(int, x); int r;
    if (ctrl_sel == 0) r = __builtin_amdgcn_update_dpp(0, v, 0xB1, 0xF, 0xF, true);
    else if (ctrl_sel == 1) r = __builtin_amdgcn_update_dpp(0, v, 0x4E, 0xF, 0xF, true);
    else if (ctrl_sel == 2) r = __builtin_amdgcn_update_dpp(0, v, 0x141, 0xF, 0xF, true);
    else r = __builtin_amdgcn_update_dpp(0, v, 0x140, 0xF, 0xF, true);
    return __builtin_bit_cast(float, r);
}
__device__ __forceinline__ int otid() { int t = threadIdx.x; asm volatile("" : "+v"(t)); return t; }
__device__ __forceinline__ int obid() { int t = blockIdx.x; asm volatile("" : "+s"(t)); return t; }
__device__ __forceinline__ int ogrid() { int t = gridDim.x; asm volatile("" : "+s"(t)); return t; }
constexpr size_t WS_BAR = 7 * MiB + 512 * 1024;
__device__ __forceinline__ void fast_sync(unsigned* ctr, unsigned& target, unsigned nblk) {
    target += nblk;
    asm volatile("s_waitcnt vmcnt(0) lgkmcnt(0)" ::: "memory");
    __syncthreads();
    if (threadIdx.x == 0) {
        __builtin_amdgcn_fence(__ATOMIC_RELEASE, "agent");
        asm volatile("s_waitcnt vmcnt(0)" ::: "memory");
        __hip_atomic_fetch_add(ctr, 1u, __ATOMIC_RELAXED, __HIP_MEMORY_SCOPE_AGENT);
        while (__hip_atomic_load(ctr, __ATOMIC_RELAXED, __HIP_MEMORY_SCOPE_AGENT) < target) __builtin_amdgcn_s_sleep(2);
        __builtin_amdgcn_fence(__ATOMIC_ACQUIRE, "agent");
        asm volatile("s_waitcnt vmcnt(0)" ::: "memory");
    }
    __syncthreads();
}

#define XB_TMO      128
#define XB_XCNT(j)  (256  + 64 * (j))
#define XB_XSUB(j)  (1280 + 64 * (j))
#define XB_XGEN(j)  (2304 + 64 * (j))
#define XB_TOP      3328
#define XB_TOPGEN   3392
#define XCD_BAR_WORDS 3456
#define XB_SPIN_CAP (1u << 22)
__device__ __forceinline__ unsigned xb_ld(unsigned* p)              { return __hip_atomic_load(p, __ATOMIC_RELAXED, __HIP_MEMORY_SCOPE_AGENT); }
__device__ __forceinline__ unsigned xb_add(unsigned* p, unsigned v) { return __hip_atomic_fetch_add(p, v, __ATOMIC_RELAXED, __HIP_MEMORY_SCOPE_AGENT); }
__device__ __forceinline__ unsigned xb_xcc_id() { return (unsigned)__builtin_amdgcn_s_getreg((3 << 11) | 20) & 0xFu; }
#define XB_SPIN(cond, bar) do { unsigned _sp = 0; while (cond) { __builtin_amdgcn_s_sleep(1); \
    if ((++_sp & 255u) == 0u) { if (xb_ld(&(bar)[XB_TMO])) break; if (_sp > XB_SPIN_CAP) { atomicAdd(&(bar)[XB_TMO], 1u); break; } } } } while (0)
struct XcdBarrier { unsigned* bar; unsigned x; volatile LAS unsigned* st; };
__device__ __forceinline__ XcdBarrier xcd_barrier_post(unsigned* bar, volatile LAS unsigned* st) {
    XcdBarrier b; b.bar = bar; b.x = xb_xcc_id(); b.st = st;
    if (threadIdx.x == 0) { const unsigned rank = xb_add(&bar[XB_XCNT(b.x)], 1u); st[2] = rank; st[3] = b.x; }
    return b;
}
__device__ __forceinline__ void xcd_barrier_complete(unsigned* bar, unsigned x, unsigned& nloc, unsigned& nx) {
    const unsigned G = gridDim.x * gridDim.y * gridDim.z;
    unsigned sum, cnt, mine, sp = 0u;
    for (;;) {
        sum = 0u; cnt = 0u; mine = 0u;
#pragma unroll
        for (unsigned j = 0; j < 16; ++j) { const unsigned c = xb_ld(&bar[XB_XCNT(j)]); sum += c; cnt += (c > 0u) ? 1u : 0u; mine = (j == x) ? c : mine; }
        if (sum == G) break;
        __builtin_amdgcn_s_sleep(1);
        if ((++sp & 255u) == 0u) { if (xb_ld(&bar[XB_TMO])) break; if (sp > XB_SPIN_CAP) { atomicAdd(&bar[XB_TMO], 1u); break; } }
    }
    nloc = mine > 0u ? mine : 1u; nx = cnt > 0u ? cnt : 1u;
}
__device__ __forceinline__ void xcd_barrier(const XcdBarrier& b) {
    asm volatile("s_waitcnt vmcnt(0)" ::: "memory");
    __syncthreads();
    if (threadIdx.x == 0) {
        unsigned* bar = b.bar;
        __builtin_amdgcn_s_waitcnt(0);
        unsigned nloc = b.st[0], nx = b.st[1];
        if (nloc == 0u) { xcd_barrier_complete(bar, b.x, nloc, nx); b.st[0] = nloc; b.st[1] = nx; }
        const unsigned old = xb_add(&bar[XB_XSUB(b.x)], 1u);
        const unsigned gen = old / nloc;
        if (old + 1u == (gen + 1u) * nloc) {
            __builtin_amdgcn_fence(__ATOMIC_RELEASE, "agent");
            asm volatile("s_waitcnt vmcnt(0)" ::: "memory");
            const unsigned og = xb_add(&bar[XB_TOP], 1u);
            const unsigned tg = og / nx;
            if (og + 1u == (tg + 1u) * nx) xb_add(&bar[XB_TOPGEN], 1u);
            else XB_SPIN(xb_ld(&bar[XB_TOPGEN]) == tg, bar);
            __builtin_amdgcn_fence(__ATOMIC_ACQUIRE, "agent");
            xb_add(&bar[XB_XGEN(b.x)], 1u);
            asm volatile("s_waitcnt vmcnt(0)" ::: "memory");
        } else {
            XB_SPIN(xb_ld(&bar[XB_XGEN(b.x)]) == gen, bar);
            __builtin_amdgcn_fence(__ATOMIC_ACQUIRE, "agent");
            asm volatile("s_waitcnt vmcnt(0)" ::: "memory");
        }
    }
    __syncthreads();
}
__device__ __forceinline__ float red8(float x) { x += dpp_f(x, 0); x += dpp_f(x, 1); x += dpp_f(x, 2); return x; }
__device__ __forceinline__ float red16(float x) { x = red8(x); x += dpp_f(x, 3); return x; }
__device__ __forceinline__ float red64(float x) { x = red16(x); x += __shfl_xor(x, 16); x += __shfl_xor(x, 32); return x; }

namespace pg8 {
constexpr int BM = 256, BK = 64, HALF = 128, HTB = HALF * BK * 2, STAGE_BYTES = 8 * HTB, NXCD = 8, WGM = 8;
__device__ __forceinline__ int lds_byte(int r, int c) { const int st = (r >> 4) * 2 + (c >> 5), rr = r & 15, cc = c & 31, ob = rr * 64 + cc * 2; return st * 1024 + (ob ^ (((ob >> 9) & 1) << 5)); }
__device__ __forceinline__ void stage_rc(int b, int& R, int& C) { const int st = b / 1024, sb = b % 1024, swz = sb ^ (((sb >> 9) & 1) << 5); R = (st >> 1) * 16 + swz / 64; C = (st & 1) * 32 + (swz % 64) / 2; }
__device__ __forceinline__ int perm32(int rho) { const int n = rho >> 4, i = rho & 15; return 8 * (i >> 2) + 4 * n + (i & 3); }
struct Unit { int pm, pn; };
struct Gemm { const bf16_t* A; const bf16_t* Bt; int M, N, K, lda, ldb, amode; };
__device__ __forceinline__ size_t a_off_bytes(const Gemm& g, int pn) {
    switch (g.amode) {
        case 1: return (size_t)(pn >> 1) * 256 * 2;
        case 2: return (size_t)pn * 512 * 2;
        case 3: return (size_t)(pn < 16 ? (pn >> 3) : (pn - 14)) * ((size_t)T_ * D_ * 2);
        case 4: return (size_t)(pn >> 3) * ((size_t)T_ * 256 * 2);
        default: return 0;
    }
}
struct StaticOrder {
    int nM, nN, nwg, G, c;
    __device__ void init(int M, int N, int G_, int c_) { nM = M / BM; nN = N / BM; nwg = nM * nN; G = G_; c = c_; }
    __device__ bool next(int i, Unit& u) const {
        const long L = (long)i * G + c; if (L >= nwg) return false;
        int wgid = (int)L; { const int q = nwg / NXCD, r = nwg % NXCD, xcd = wgid % NXCD, off = wgid / NXCD; wgid = (xcd < r ? xcd * (q + 1) : r * (q + 1) + (xcd - r) * q) + off; }
        const int nig = WGM * nN, gid = wgid / nig, fm = gid * WGM, gsz = (nM - fm) < WGM ? (nM - fm) : WGM;
        u.pm = fm + ((wgid % nig) % gsz); u.pn = (wgid % nig) / gsz; return true;
    }
};

template <class Epi>
__device__ __forceinline__ void gemm_phase(LAS unsigned char* lds, const Gemm g, const StaticOrder& S, const Epi& E) {
    const int tid = otid(), wid = __builtin_amdgcn_readfirstlane(tid >> 6), lane = tid & 63, wr = wid >> 2, wc = wid & 3, fr = lane & 15, fq = lane >> 4;
    const int K = g.K, nt = K / BK;
    unsigned voffA[2], voffB[2];
#pragma unroll
    for (int i = 0; i < 2; ++i) { int R, C; stage_rc(tid * 16 + i * 8192, R, C); const int Rb = (R & ~31) + perm32(R & 31);
        voffA[i] = (unsigned)(R * g.lda + C) * 2u; voffB[i] = (unsigned)(Rb * g.ldb + C) * 2u; }
    const size_t kstep = (size_t)(BK * 2);
    const size_t hstepA = (size_t)HALF * g.lda * 2, hstepB = (size_t)HALF * g.ldb * 2;
    const size_t tstepA = 2 * hstepA, tstepB = 2 * hstepB;
    const unsigned ldsw = (unsigned)wid * 1024u;
    const int aoff = lds_byte(wr * 64 + fr, fq * 8), boff = lds_byte(wc * 32 + fr, fq * 8);
#define PG8_SA(b, h) (((b) * 2 + (h)) * HTB)
#define PG8_SB(b, h) ((4 + (b) * 2 + (h)) * HTB)
#define PG8_STAGE(bufoff, gbase, voff) do { _Pragma("unroll") for (int _i = 0; _i < 2; ++_i) \
        __builtin_amdgcn_global_load_lds((const unsigned*)((const char*)(gbase) + (voff)[_i]), (LAS unsigned*)(lds + (bufoff) + ldsw + _i * 8192), 16, 0, 0); } while (0)
#define PG8_LDA(dst, b, h) do { _Pragma("unroll") for (int m = 0; m < 4; ++m) _Pragma("unroll") for (int k = 0; k < 2; ++k) dst[m][k] = *(const LAS bf16x8*)(lds + PG8_SA(b, h) + aoff + m * 2048 + k * 1024); } while (0)
#define PG8_LDB(dst, b, h) do { _Pragma("unroll") for (int n = 0; n < 2; ++n) _Pragma("unroll") for (int k = 0; k < 2; ++k) dst[n][k] = *(const LAS bf16x8*)(lds + PG8_SB(b, h) + boff + n * 2048 + k * 1024); } while (0)
#define PG8_MMA(ai, bj, At, Bt) do { __builtin_amdgcn_s_setprio(1); _Pragma("unroll") for (int m = 0; m < 4; ++m) _Pragma("unroll") for (int n = 0; n < 2; ++n) _Pragma("unroll") for (int k = 0; k < 2; ++k) \
        acc[ai][bj][m][n] = __builtin_amdgcn_mfma_f32_16x16x32_bf16(Bt[n][k], At[m][k], acc[ai][bj][m][n], 0, 0, 0); __builtin_amdgcn_s_setprio(0); } while (0)
#define PG8_WAIT_V(n) asm volatile("s_waitcnt vmcnt(" #n ")" ::: "memory")
#define PG8_WAIT_L(n) asm volatile("s_waitcnt lgkmcnt(" #n ")" ::: "memory")
#define PG8_BAR __builtin_amdgcn_s_barrier()
#define PG8_SCHED __builtin_amdgcn_sched_barrier(0)
    Unit cur, nxt; int ui = 0;
    if (!S.next(0, cur)) return;
    f32x4 acc[2][2][4][2];
#pragma unroll
    for (int a = 0; a < 2; ++a)
#pragma unroll
        for (int b = 0; b < 2; ++b)
#pragma unroll
            for (int m = 0; m < 4; ++m)
#pragma unroll
                for (int n = 0; n < 2; ++n) acc[a][b][m][n] = (f32x4){0.f, 0.f, 0.f, 0.f};
    bf16x8 At[4][2], B0[2][2], B1[2][2];
    const char* cA = (const char*)g.A + (size_t)cur.pm * tstepA + a_off_bytes(g, cur.pn); const char* cB = (const char*)g.Bt + (size_t)cur.pn * tstepB;
    PG8_STAGE(PG8_SB(0, 0), cB, voffB); PG8_STAGE(PG8_SA(0, 0), cA, voffA); PG8_STAGE(PG8_SB(0, 1), cB + hstepB, voffB); PG8_STAGE(PG8_SA(0, 1), cA + hstepA, voffA);
    if (wr == 1) PG8_BAR;
    PG8_WAIT_V(4); PG8_BAR;
    PG8_STAGE(PG8_SB(1, 0), cB + kstep, voffB); PG8_STAGE(PG8_SA(1, 0), cA + kstep, voffA); PG8_STAGE(PG8_SB(1, 1), cB + hstepB + kstep, voffB);
    PG8_WAIT_V(6); PG8_BAR;
    for (;;) {
        const bool has_next = S.next(ui + 1, nxt);
        const char* nA = has_next ? (const char*)g.A + (size_t)nxt.pm * tstepA + a_off_bytes(g, nxt.pn) : cA; const char* nB = has_next ? (const char*)g.Bt + (size_t)nxt.pn * tstepB : cB;
        for (int t = 0; t < nt; t += 2) {
            const bool last = (t == nt - 2);
            const char* a1 = cA + (size_t)(t + 1) * kstep;
            const char* a2 = last ? nA : cA + (size_t)(t + 2) * kstep; const char* b2 = last ? nB : cB + (size_t)(t + 2) * kstep;
            const char* a3 = a2 + kstep; const char* b3 = b2 + kstep;
            PG8_LDB(B0, 0, 0); PG8_SCHED; PG8_LDA(At, 0, 0); PG8_STAGE(PG8_SA(1, 1), a1 + hstepA, voffA);
            PG8_WAIT_L(8); PG8_BAR; PG8_WAIT_L(0); PG8_MMA(0, 0, At, B0); PG8_BAR; PG8_SCHED;
            PG8_LDB(B1, 0, 1); PG8_STAGE(PG8_SB(0, 0), b2, voffB);
            PG8_BAR; PG8_WAIT_L(0); PG8_MMA(0, 1, At, B1); PG8_BAR;
            PG8_LDA(At, 0, 1); PG8_STAGE(PG8_SA(0, 0), a2, voffA);
            PG8_BAR; PG8_WAIT_L(0); PG8_MMA(1, 0, At, B0); PG8_BAR; PG8_SCHED;
            PG8_STAGE(PG8_SB(0, 1), b2 + hstepB, voffB);
            PG8_WAIT_V(6); PG8_BAR; PG8_MMA(1, 1, At, B1); PG8_BAR;
            PG8_LDB(B0, 1, 0); PG8_SCHED; PG8_LDA(At, 1, 0); PG8_STAGE(PG8_SA(0, 1), a2 + hstepA, voffA);
            PG8_WAIT_L(8); PG8_BAR; PG8_WAIT_L(0); PG8_MMA(0, 0, At, B0); PG8_BAR; PG8_SCHED;
            PG8_LDB(B1, 1, 1); PG8_STAGE(PG8_SB(1, 0), b3, voffB);
            PG8_BAR; PG8_WAIT_L(0); PG8_MMA(0, 1, At, B1); PG8_BAR;
            PG8_LDA(At, 1, 1); PG8_STAGE(PG8_SA(1, 0), a3, voffA);
            PG8_BAR; PG8_WAIT_L(0); PG8_MMA(1, 0, At, B0); PG8_BAR; PG8_SCHED;
            PG8_STAGE(PG8_SB(1, 1), b3 + hstepB, voffB);
            PG8_WAIT_V(6); PG8_BAR; PG8_MMA(1, 1, At, B1); PG8_BAR;
        }
        E(acc, cur, wr, wc, fr, fq);
        if (!has_next) break;
#pragma unroll
        for (int a = 0; a < 2; ++a)
#pragma unroll
            for (int b = 0; b < 2; ++b)
#pragma unroll
                for (int m = 0; m < 4; ++m)
#pragma unroll
                    for (int n = 0; n < 2; ++n) acc[a][b][m][n] = (f32x4){0.f, 0.f, 0.f, 0.f};
        cur = nxt; cA = nA; cB = nB; ++ui;
    }
    PG8_WAIT_V(0);
    if (wr == 0) PG8_BAR;
    PG8_BAR;
#undef PG8_SA
#undef PG8_SB
#undef PG8_STAGE
#undef PG8_LDA
#undef PG8_LDB
#undef PG8_MMA
#undef PG8_WAIT_V
#undef PG8_WAIT_L
#undef PG8_BAR
#undef PG8_SCHED
}
}

enum { M_F32 = 0, M_BF16 = 1, M_QROPE = 2, M_RESID = 3, M_RELU2 = 4, M_L1A = 5, M_L1B = 6 };
__device__ __forceinline__ float sigmoidf_(float x) { return 1.f / (1.f + __expf(-x)); }
__device__ __forceinline__ float tanhf_(float x) { const float e = __expf(-2.f * fabsf(x)); const float t = (1.f - e) / (1.f + e); return x < 0.f ? -t : t; }
__device__ __forceinline__ void st_bf16x8(bf16_t* p, const f32x4& a, const f32x4& b) {
    u32x4 o; o[0] = cvt_pk_bf16(a[0], a[1]); o[1] = cvt_pk_bf16(a[2], a[3]); o[2] = cvt_pk_bf16(b[0], b[1]); o[3] = cvt_pk_bf16(b[2], b[3]); *(u32x4*)p = o;
}
template <int MODE> struct Epi {
    void* o0; void* o1; void* o2; void* o3; void* o4; const float* f0; const float* f1; const float* f2; const float* f3; int ldc;
    __device__ __forceinline__ void operator()(const f32x4 (&acc)[2][2][4][2], const pg8::Unit& u, int wr, int wc, int fr, int fq) const {
        const int row0 = u.pm * 256 + wr * 64 + fr, colb = u.pn * 256 + wc * 32 + 8 * fq;
        if constexpr (MODE == M_RESID) {
            const int b = (u.pm * 256) >> 11;
            f32x4 gt[2][2];
#pragma unroll
            for (int bj = 0; bj < 2; ++bj) { const float* gp = f1 + (size_t)b * 12288 + colb + bj * 128; gt[bj][0] = *(const f32x4*)gp; gt[bj][1] = *(const f32x4*)(gp + 4); }
#pragma unroll
            for (int ai = 0; ai < 2; ++ai) {
                f32x4 xv[4][2][2];
#pragma unroll
                for (int m = 0; m < 4; ++m)
#pragma unroll
                    for (int bj = 0; bj < 2; ++bj) { const float* xin = f0 + (size_t)(row0 + ai * 128 + m * 16) * D_ + colb + bj * 128; xv[m][bj][0] = *(const f32x4*)xin; xv[m][bj][1] = *(const f32x4*)(xin + 4); }
                asm volatile("" ::: "memory");
#pragma unroll
                for (int m = 0; m < 4; ++m)
#pragma unroll
                    for (int bj = 0; bj < 2; ++bj) { float* dst = (float*)o0 + (size_t)(row0 + ai * 128 + m * 16) * D_ + colb + bj * 128;
                        *(f32x4*)dst = xv[m][bj][0] + gt[bj][0] * acc[ai][bj][m][0]; *(f32x4*)(dst + 4) = xv[m][bj][1] + gt[bj][1] * acc[ai][bj][m][1]; }
                asm volatile("" ::: "memory");
            }
            return;
        }
        if constexpr (MODE == M_QROPE) {
            const bool isq = u.pn < 12; const int gpar = wc & 1;
            if (u.pn >= 8 && (isq || gpar == 0)) {
#pragma unroll
                for (int ai = 0; ai < 2; ++ai) {
                    f32x4 cv[4], sn[4];
#pragma unroll
                    for (int m = 0; m < 4; ++m) { const int row = row0 + ai * 128 + m * 16;
                        cv[m] = *(const f32x4*)(isq ? f0 + (size_t)row * 32 + gpar * 16 + 4 * fq : f2 + (size_t)row * 16 + 4 * fq);
                        sn[m] = *(const f32x4*)(isq ? f1 + (size_t)row * 32 + gpar * 16 + 4 * fq : f3 + (size_t)row * 16 + 4 * fq); }
                    asm volatile("" ::: "memory");
#pragma unroll
                    for (int m = 0; m < 4; ++m)
#pragma unroll
                        for (int bj = 0; bj < 2; ++bj) { const f32x4 v0 = acc[ai][bj][m][0], v1 = acc[ai][bj][m][1];
                            st_bf16x8((bf16_t*)o0 + (size_t)(row0 + ai * 128 + m * 16) * ldc + colb + bj * 128, v0 * cv[m] - v1 * sn[m], v1 * cv[m] + v0 * sn[m]); }
                    asm volatile("" ::: "memory");
                }
                return;
            }
        }
#pragma unroll
        for (int ai = 0; ai < 2; ++ai)
#pragma unroll
            for (int m = 0; m < 4; ++m) {
                const int row = row0 + ai * 128 + m * 16;
#pragma unroll
                for (int bj = 0; bj < 2; ++bj) {
                    const int col = colb + bj * 128;
                    f32x4 v0 = acc[ai][bj][m][0], v1 = acc[ai][bj][m][1];
                    if constexpr (MODE == M_F32) {
                        float* dst = (float*)o0 + (size_t)row * ldc + col; *(f32x4*)dst = v0; *(f32x4*)(dst + 4) = v1;
                    } else if constexpr (MODE == M_BF16) {
                        st_bf16x8((bf16_t*)o0 + (size_t)row * ldc + col, v0, v1);
                    } else if constexpr (MODE == M_QROPE) {
                        if (u.pn >= 8) {
                            const bool isq = u.pn < 12; const int gpar = wc & 1;
                            if (isq || gpar == 0) {
                                const float* ct = isq ? f0 + (size_t)row * 32 + gpar * 16 + 4 * fq : f2 + (size_t)row * 16 + 4 * fq;
                                const float* st = isq ? f1 + (size_t)row * 32 + gpar * 16 + 4 * fq : f3 + (size_t)row * 16 + 4 * fq;
                                const f32x4 c = *(const f32x4*)ct, s = *(const f32x4*)st;
                                const f32x4 a = v0 * c - v1 * s, b = v1 * c + v0 * s; v0 = a; v1 = b;
                            }
                        }
                        st_bf16x8((bf16_t*)o0 + (size_t)row * ldc + col, v0, v1);
                    } else if constexpr (MODE == M_RESID) {
                        const int b = row >> 11;
                        const float* gp = f1 + (size_t)b * 12288 + col; const float* xin = f0 + (size_t)row * D_ + col;
                        const f32x4 g0 = *(const f32x4*)gp, g1 = *(const f32x4*)(gp + 4), x0 = *(const f32x4*)xin, x1 = *(const f32x4*)(xin + 4);
                        float* dst = (float*)o0 + (size_t)row * D_ + col; *(f32x4*)dst = x0 + g0 * v0; *(f32x4*)(dst + 4) = x1 + g1 * v1;
                    } else if constexpr (MODE == M_RELU2) {
#pragma unroll
                        for (int i = 0; i < 4; ++i) { float a = fmaxf(v0[i], 0.f), b = fmaxf(v1[i], 0.f); v0[i] = a * a; v1[i] = b * b; }
                        st_bf16x8((bf16_t*)o0 + (size_t)row * ldc + col, v0, v1);
                    } else if constexpr (MODE == M_L1A) {
                        if (u.pn < 16) { bf16_t* base = (bf16_t*)(u.pn < 8 ? o0 : o1); st_bf16x8(base + (size_t)row * D_ + (col & 2047), v0, v1); }
                        else {
                            bf16_t* base = (bf16_t*)(u.pn == 16 ? o2 : (u.pn == 17 ? o3 : o4));
                            if (u.pn == 16) {
#pragma unroll
                                for (int i = 0; i < 4; ++i) { v0[i] = tanhf_(v0[i]); v1[i] = tanhf_(v1[i]); }
                            } else if (u.pn == 18) {
#pragma unroll
                                for (int i = 0; i < 4; ++i) { v0[i] = sigmoidf_(v0[i]); v1[i] = sigmoidf_(v1[i]); }
                            }
                            st_bf16x8(base + (size_t)row * 256 + (col & 255), v0, v1);
                        }
                    } else if constexpr (MODE == M_L1B) {
                        const int c = col & 2047;
                        if (u.pn < 8) { float* dst = (float*)o0 + (size_t)row * D_ + c; *(f32x4*)dst = v0; *(f32x4*)(dst + 4) = v1; }
                        else if (u.pn < 16) { st_bf16x8((bf16_t*)o1 + (size_t)row * D_ + c, v0, v1);
                        } else st_bf16x8((bf16_t*)o2 + (size_t)row * D_ + c, v0, v1);
                    }
                }
            }
    }
};
template <int MODE> __device__ __forceinline__ void run_gemm(int vbid, LAS unsigned char* lds, const void* A, int lda, const void* Bt, int ldb, int M, int N, int K, int amode, const Epi<MODE>& E) {
    pg8::Gemm g; g.A = (const bf16_t*)A; g.Bt = (const bf16_t*)Bt; g.M = M; g.N = N; g.K = K; g.lda = lda; g.ldb = ldb; g.amode = amode;
    pg8::StaticOrder S; S.init(M, N, ogrid(), vbid);
    pg8::gemm_phase<Epi<MODE>>(lds, g, S, E);
}

__device__ __forceinline__ void p0_mod(const Params& p, unsigned char* shm) {
    const int bid = obid(), nb = ogrid();
    if (bid >= 384) return;
    float* cact = (float*)shm; float* red = cact + 8 * 2048;
    const int tid = otid(), wid = tid >> 6, lane = tid & 63;
    for (int i = tid; i < 8 * 2048; i += 512) { const float v = p.in[1][i]; cact[i] = v / (1.f + __expf(-v)); }
    __syncthreads();
    float* mod = (float*)(p.ws + WS_MOD);
    for (int item = bid; item < 384; item += nb) {
        const int l = item / 192, c0 = (item % 192) * 64;
        const float* W = p.in[3] + (size_t)l * 2048 * 12288 + c0 + lane;
        float acc[8];
#pragma unroll
        for (int b = 0; b < 8; ++b) acc[b] = 0.f;
        const int k0 = wid * 256;
#pragma unroll 16
        for (int k = 0; k < 256; ++k) {
            const float wv = W[(size_t)(k0 + k) * 12288];
#pragma unroll
            for (int b = 0; b < 8; ++b) acc[b] += cact[b * 2048 + k0 + k] * wv;
        }
#pragma unroll
        for (int b = 0; b < 8; ++b) red[(wid * 8 + b) * 64 + lane] = acc[b];
        __syncthreads();
        { const int b = tid >> 6; float s = 0.f;
#pragma unroll
          for (int w = 0; w < 8; ++w) s += red[(w * 8 + b) * 64 + lane];
          mod[(size_t)(l * 8 + b) * 12288 + c0 + lane] = s + p.in[4][l * 12288 + c0 + lane]; }
        __syncthreads();
    }
}
__device__ __forceinline__ void p0_rope(const Params& p) {
    float* cosA = (float*)(p.ws + WS_COSA); float* sinA = (float*)(p.ws + WS_SINA); float* cosI = (float*)(p.ws + WS_COSI); float* sinI = (float*)(p.ws + WS_SINI);
    const int* pos = (const int*)p.in[2];
    const int nb_ = ogrid(); for (int i = obid() * 512 + otid(); i < T_ * 32; i += nb_ * 512) {
        const int t = i >> 5, f = i & 31; const float ps = (float)pos[t];
        { const float inv = 1.0f / powf(10000.f, (float)(2 * f) / 64.f); const float ang = ps * inv; const double a = (double)ang; const double k = rint(a * 0.15915494309189535);
          const float r = (float)(a - k * 6.283185307179586); cosA[i] = __cosf(r); sinA[i] = __sinf(r); }
        if (f < 16) { const float inv = 1.0f / powf(10000.f, (float)(2 * f) / 32.f); const float ang = ps * inv; const double a = (double)ang; const double k = rint(a * 0.15915494309189535);
          const float r = (float)(a - k * 6.283185307179586); cosI[t * 16 + f] = __cosf(r); sinI[t * 16 + f] = __sinf(r); }
    }
}
__device__ __forceinline__ int ropeperm(int j) { const int half = j >> 5, f = j & 31; return (f >> 4) * 32 + 8 * ((f & 15) >> 2) + 4 * half + (f & 3); }
__device__ __forceinline__ int idxperm(int j) { if (j >= 32) return j; const int half = j >> 4, f = j & 15; return 8 * (f >> 2) + 4 * half + (f & 3); }

struct Job { const float* src; bf16_t* dst; int modeC, sK, sN, skst, snst, dN, dK, dld, k0, nblk, kblk, rowmap; };
__device__ __forceinline__ Job mkjob(const float* src, void* dst, int sK, int sN, int skst, int dN, int dK) {
    Job J; J.src = src; J.dst = (bf16_t*)dst; J.modeC = 0; J.sK = sK; J.sN = sN; J.skst = skst; J.snst = 1; J.dN = dN; J.dK = dK; J.dld = dK; J.k0 = 0; J.nblk = 1 << 30; J.kblk = 0; J.rowmap = 0; return J;
}
constexpr int NJOBS_EARLY = 40, NJOBS_ALL = 42;
__device__ __forceinline__ Job get_job(const Params& p, int j) {
    unsigned char* ws = p.ws;
    if (j == 0) return mkjob(p.in[8], ws + WS_WT_IN, 2048, 912, 912, 1024, 2048);
    if (j == 1) { Job J = mkjob(p.in[11], ws + WS_WT_Q, 512, 3072, 3072, 3072, 512); J.rowmap = 1; return J; }
    if (j == 2) { Job J = mkjob(p.in[12], ws + WS_WT_Q, 512, 1024, 1024, 1024, 512); J.rowmap = 2; return J; }
    if (j < 19) { const int h = j - 3; Job J = mkjob(p.in[15] + h * 128, (bf16_t*)(ws + WS_WT_UK) + (size_t)h * 256 * 256, 128, 256, 1, 256, 256); J.modeC = 1; J.snst = 2048; J.k0 = (h & 1) * 128; return J; }
    if (j < 27) { const int hp = j - 19; Job J = mkjob(p.in[16] + hp * 256, (bf16_t*)(ws + WS_WT_UV) + (size_t)hp * 256 * 512, 256, 256, 2048, 256, 512); J.nblk = 128; J.kblk = 256; return J; }
    if (j == 27) return mkjob(p.in[17], ws + WS_WT_O, 2048, 2048, 2048, 2048, 2048);
    if (j == 28) return mkjob(p.in[5], ws + WS_WT_1_0, 2048, 8192, 8192, 8192, 2048);
    if (j == 29) return mkjob(p.in[6], ws + WS_WT_2_0, 8192, 2048, 2048, 2048, 8192);
    if (j == 30) return mkjob(p.in[19], (bf16_t*)(ws + WS_WT_RKV), 2048, 2048, 2048, 2048, 2048);
    if (j == 31) return mkjob(p.in[20], (bf16_t*)(ws + WS_WT_RKV) + (size_t)2048 * 2048, 2048, 2048, 2048, 2048, 2048);
    if (j == 32) return mkjob(p.in[21], (bf16_t*)(ws + WS_WT_RKV) + (size_t)4096 * 2048, 2048, 2048, 2048, 2048, 2048);
    if (j == 33) return mkjob(p.in[24], (bf16_t*)(ws + WS_WT_RKV) + (size_t)6144 * 2048, 2048, 96, 96, 256, 2048);
    if (j == 34) return mkjob(p.in[27], (bf16_t*)(ws + WS_WT_RKV) + (size_t)6400 * 2048, 2048, 96, 96, 256, 2048);
    if (j == 35) return mkjob(p.in[29], (bf16_t*)(ws + WS_WT_RKV) + (size_t)6656 * 2048, 2048, 256, 256, 256, 2048);
    if (j == 36) return mkjob(p.in[25], (bf16_t*)(ws + WS_WT_L2), 96, 2048, 2048, 2048, 256);
    if (j == 37) return mkjob(p.in[28], (bf16_t*)(ws + WS_WT_L2) + (size_t)2048 * 256, 96, 2048, 2048, 2048, 256);
    if (j == 38) return mkjob(p.in[30], (bf16_t*)(ws + WS_WT_L2) + (size_t)4096 * 256, 256, 2048, 2048, 2048, 256);
    if (j == 39) return mkjob(p.in[22], ws + WS_WT_BO, 2048, 2048, 2048, 2048, 2048);
    if (j == 40) return mkjob(p.in[5] + (size_t)2048 * 8192, ws + WS_WT_1_1, 2048, 8192, 8192, 8192, 2048);
    return mkjob(p.in[6] + (size_t)8192 * 2048, ws + WS_WT_2_1, 8192, 2048, 2048, 2048, 8192);
}
__device__ __forceinline__ int job_rowmap(const Job& J, int n) {
    if (J.rowmap == 1) { const int h = n / 192, d = n % 192; return d < 128 ? h * 128 + d : 2048 + h * 64 + ropeperm(d - 128); }
    if (J.rowmap == 2) { const int h = n >> 6, jj = n & 63; return 3072 + h * 64 + idxperm(jj); }
    return n;
}
__device__ __forceinline__ void conv_decode(const Params& p, int jlo, int ti, Job& J, int& n0, int& k0t, const volatile int* jtab) {
    int j = jlo; while (ti >= jtab[j + 1]) ++j;
    const int rem = ti - jtab[j]; J = get_job(p, j);
    const int nnt = J.dN >> 8; k0t = (rem / nnt) * 64; n0 = (rem % nnt) * 256;
}
__device__ __forceinline__ void conv_load(const Job& J, int n0, int k0t, int tid, f32x4 (&R)[8]) {
    if (!J.modeC) {
#pragma unroll
        for (int i = 0; i < 8; ++i) {
            const int kr = (tid >> 6) + 8 * i, n = n0 + (tid & 63) * 4; const int kk = k0t + kr - (J.k0 + (n / J.nblk) * J.kblk);
            R[i] = (f32x4){0.f, 0.f, 0.f, 0.f};
            if (n < J.sN && kk >= 0 && kk < J.sK) R[i] = *(const f32x4*)(J.src + (size_t)kk * J.skst + n);
        }
    } else {
#pragma unroll
        for (int i = 0; i < 4; ++i) {
            const int n = (tid >> 3) + 64 * i, k8 = (tid & 7) * 8; const int kk = k0t + k8 - J.k0;
            R[2 * i] = (f32x4){0.f, 0.f, 0.f, 0.f}; R[2 * i + 1] = R[2 * i];
            if (n0 + n < J.sN && kk >= 0 && kk + 7 < J.sK) { const float* sp = J.src + (size_t)(n0 + n) * J.snst + kk; R[2 * i] = *(const f32x4*)sp; R[2 * i + 1] = *(const f32x4*)(sp + 4); }
        }
    }
}
__device__ __forceinline__ void convert_jobs(const Params& p, unsigned char* shm, int jlo, int jhi, unsigned* ctr) {
    float* tile = (float*)shm;
    volatile int* nextp = (volatile int*)(shm + 66048);
    const int tid = otid();
    volatile int* jtab = (volatile int*)(shm + 66112);
    __syncthreads();
    if (tid == 0) { int acc = 0; for (int j = jlo; j < jhi; ++j) { jtab[j] = acc; const Job Jt = get_job(p, j); acc += (Jt.dN >> 8) * (Jt.dK >> 6); } jtab[jhi] = acc; }
    __syncthreads();
    const int total = jtab[jhi];
    if (tid == 0) *nextp = (int)__hip_atomic_fetch_add(ctr, 1u, __ATOMIC_RELAXED, __HIP_MEMORY_SCOPE_AGENT);
    __syncthreads();
    int ti = *nextp;
    Job J; int n0 = 0, k0t = 0; f32x4 R[8];
    if (ti < total) { conv_decode(p, jlo, ti, J, n0, k0t, jtab); conv_load(J, n0, k0t, tid, R); }
    while (ti < total) {
        if (!J.modeC) {
#pragma unroll
            for (int i = 0; i < 8; ++i) { const int kr = (tid >> 6) + 8 * i, n4 = (tid & 63) * 4; float* d = tile + kr * 257 + n4; d[0] = R[i][0]; d[1] = R[i][1]; d[2] = R[i][2]; d[3] = R[i][3]; }
        } else {
#pragma unroll
            for (int i = 0; i < 4; ++i) { const int n = (tid >> 3) + 64 * i, k8 = (tid & 7) * 8;
#pragma unroll
                for (int e = 0; e < 4; ++e) { tile[(k8 + e) * 257 + n] = R[2 * i][e]; tile[(k8 + 4 + e) * 257 + n] = R[2 * i + 1][e]; } }
        }
        if (tid == 0) *nextp = (int)__hip_atomic_fetch_add(ctr, 1u, __ATOMIC_RELAXED, __HIP_MEMORY_SCOPE_AGENT);
        __syncthreads();
        const int tnx = *nextp;
        const Job Jc = J; const int n0c = n0, k0c = k0t;
        if (tnx < total) { conv_decode(p, jlo, tnx, J, n0, k0t, jtab); conv_load(J, n0, k0t, tid, R); }
#pragma unroll
        for (int i = 0; i < 4; ++i) {
            const int n = (tid >> 3) + 64 * i, k8 = (tid & 7) * 8;
            float v[8];
#pragma unroll
            for (int e = 0; e < 8; ++e) v[e] = tile[(k8 + e) * 257 + n];
            u32x4 o; o[0] = cvt_pk_bf16(v[0], v[1]); o[1] = cvt_pk_bf16(v[2], v[3]); o[2] = cvt_pk_bf16(v[4], v[5]); o[3] = cvt_pk_bf16(v[6], v[7]);
            *(u32x4*)(Jc.dst + (size_t)job_rowmap(Jc, n0c + n) * Jc.dld + k0c + k8) = o;
        }
        __syncthreads();
        ti = tnx;
    }
}

__device__ __forceinline__ void norm_phase(int vbx, const float* xin, const float* sh, const float* sc, bf16_t* outb, float* outf, const float* fg) {
    const int tid_ = otid(); const int lane = tid_ & 63; const int gw = obid() * 8 + (tid_ >> 6), nw = ogrid() * 8; (void)vbx;
    for (int row = gw; row < T_; row += nw) {
        const float* xr = xin + (size_t)row * D_; const int b = row >> 11;
        f32x4 v[8]; float ss = 0.f;
#pragma unroll
        for (int j = 0; j < 8; ++j) { v[j] = *(const f32x4*)(xr + (lane + 64 * j) * 4); ss += v[j][0] * v[j][0] + v[j][1] * v[j][1] + v[j][2] * v[j][2] + v[j][3] * v[j][3]; }
        ss = red64(ss); const float rstd = rsqrtf(ss * (1.f / D_) + 1e-6f);
#pragma unroll
        for (int j = 0; j < 8; ++j) {
            const int c = (lane + 64 * j) * 4;
            if (outf) { const f32x4 g = *(const f32x4*)(fg + c); *(f32x4*)(outf + (size_t)row * D_ + c) = v[j] * rstd * g; }
            else { const f32x4 s1 = *(const f32x4*)(sc + (size_t)b * 12288 + c), s0 = *(const f32x4*)(sh + (size_t)b * 12288 + c);
                const f32x4 o = v[j] * rstd * (s1 + 1.f) + s0; u32x2 pk; pk[0] = cvt_pk_bf16(o[0], o[1]); pk[1] = cvt_pk_bf16(o[2], o[3]); *(u32x2*)(outb + (size_t)row * D_ + c) = pk; }
        }
    }
}
__device__ __forceinline__ void mix_phase(const Params& p, const float* xin, const float* sh, const float* sc, unsigned char* shm) {
    const int tid_ = otid(); const int lane = tid_ & 63; const int gw = obid() * 8 + (tid_ >> 6), nw = ogrid() * 8;
    bf16_t* mix = (bf16_t*)(p.ws + WS_MIX); const float* mu = p.in[18];
    float* lmu = (float*)shm;
    __syncthreads();
#pragma unroll
    for (int i = 0; i < 6; ++i) *(f32x4*)(lmu + (tid_ + 512 * i) * 4) = *(const f32x4*)(mu + (tid_ + 512 * i) * 4);
    __syncthreads();
    for (int r0 = gw * 8; r0 < T_; r0 += nw * 8) {
        const int b = r0 >> 11;
        f32x4 hp[8];
        for (int rr = -1; rr < 8; ++rr) {
            const int row = r0 + rr;
            f32x4 h[8];
            if (rr < 0 && (r0 & 2047) == 0) {
#pragma unroll
                for (int j = 0; j < 8; ++j) h[j] = (f32x4){0.f, 0.f, 0.f, 0.f};
            } else {
                const float* xr = xin + (size_t)row * D_; float ss = 0.f;
#pragma unroll
                for (int j = 0; j < 8; ++j) { h[j] = *(const f32x4*)(xr + (lane + 64 * j) * 4); ss += h[j][0] * h[j][0] + h[j][1] * h[j][1] + h[j][2] * h[j][2] + h[j][3] * h[j][3]; }
                ss = red64(ss); const float rstd = rsqrtf(ss * (1.f / D_) + 1e-6f);
#pragma unroll
                for (int j = 0; j < 8; ++j) { const int c = (lane + 64 * j) * 4; const f32x4 s1 = *(const f32x4*)(sc + (size_t)b * 12288 + c), s0 = *(const f32x4*)(sh + (size_t)b * 12288 + c); h[j] = h[j] * rstd * (s1 + 1.f) + s0; }
            }
            if (rr >= 0) {
#pragma unroll 1
                for (int q = 0; q < 6; ++q) {
                    const int mq = (q == 1) ? 2 : (q == 2) ? 3 : (q == 3) ? 1 : q;
                    f32x4 m[8];
#pragma unroll
                    for (int j = 0; j < 8; ++j) m[j] = *(const f32x4*)(lmu + mq * D_ + (lane + 64 * j) * 4);
#pragma unroll
                    for (int j = 0; j < 8; ++j) {
                        const int c = (lane + 64 * j) * 4; const f32x4 o = h[j] + (hp[j] - h[j]) * m[j]; u32x2 pk; pk[0] = cvt_pk_bf16(o[0], o[1]); pk[1] = cvt_pk_bf16(o[2], o[3]);
                        *(u32x2*)(mix + (size_t)q * T_ * D_ + (size_t)row * D_ + c) = pk;
                    }
                }
            }
#pragma unroll
            for (int j = 0; j < 8; ++j) hp[j] = h[j];
        }
    }
}
__device__ __forceinline__ void projrow_phase(const Params& p) {
    const int tid_ = otid(); const int lane = tid_ & 63; const int gw = obid() * 8 + (tid_ >> 6), nw = ogrid() * 8;
    const float* proj = (const float*)(p.ws + WS_PROJ); bf16_t* cq = (bf16_t*)(p.ws + WS_CQ); bf16_t* keys = (bf16_t*)(p.ws + WS_KEYS); bf16_t* kidx = (bf16_t*)(p.ws + WS_KIDX); float* widx = (float*)(p.ws + WS_WIDX);
    const float* cosA = (const float*)(p.ws + WS_COSA); const float* sinA = (const float*)(p.ws + WS_SINA); const float* cosI = (const float*)(p.ws + WS_COSI); const float* sinI = (const float*)(p.ws + WS_SINI);
    const float* qg = p.in[9]; const float* kvg = p.in[10]; const float* lng = p.in[13]; const float* lnb = p.in[14];
    for (int row = gw; row < T_; row += nw) {
        const float* pr = proj + (size_t)row * 1024;
        f32x4 v[4];
#pragma unroll
        for (int j = 0; j < 4; ++j) v[j] = *(const f32x4*)(pr + (lane + 64 * j) * 4);
        float sq = 0.f, skv = 0.f;
#pragma unroll
        for (int e = 0; e < 4; ++e) { sq += v[0][e] * v[0][e] + v[1][e] * v[1][e]; skv += v[2][e] * v[2][e]; }
        sq = red64(sq); skv = red64(skv);
        const float rq = rsqrtf(sq * (1.f / 512.f) + 1e-6f), rkv = rsqrtf(skv * (1.f / 256.f) + 1e-6f);
#pragma unroll
        for (int j = 0; j < 2; ++j) { const int c = (lane + 64 * j) * 4; const f32x4 g = *(const f32x4*)(qg + c); const f32x4 o = v[j] * rq * g; u32x2 pk; pk[0] = cvt_pk_bf16(o[0], o[1]); pk[1] = cvt_pk_bf16(o[2], o[3]); *(u32x2*)(cq + (size_t)row * 512 + c) = pk; }
        { const int c = lane * 4; const f32x4 g = *(const f32x4*)(kvg + c); const f32x4 o = v[2] * rkv * g; u32x2 pk; pk[0] = cvt_pk_bf16(o[0], o[1]); pk[1] = cvt_pk_bf16(o[2], o[3]); *(u32x2*)(keys + (size_t)row * 320 + c) = pk; }
        f32x4 x = v[3];
        float s1 = x[0] + x[1] + x[2] + x[3]; s1 = red16(s1); const float mean = s1 * (1.f / 64.f);
        f32x4 xc = x - mean; float s2 = xc[0] * xc[0] + xc[1] * xc[1] + xc[2] * xc[2] + xc[3] * xc[3]; s2 = red16(s2); const float rs = rsqrtf(s2 * (1.f / 64.f) + 1e-6f);
        f32x4 y = x;
        if (lane >= 16 && lane < 32) { const int jj = (lane - 16) * 4; const f32x4 g = *(const f32x4*)(lng + jj), bb = *(const f32x4*)(lnb + jj); y = xc * rs * g + bb; }
        f32x4 part8, part4;
#pragma unroll
        for (int e = 0; e < 4; ++e) { part8[e] = __shfl_xor(y[e], 8); part4[e] = __shfl_xor(y[e], 4); }
        if (lane < 16) {
            const int l2 = lane & 7; const f32x4 c = *(const f32x4*)(cosA + (size_t)row * 32 + 4 * l2), s = *(const f32x4*)(sinA + (size_t)row * 32 + 4 * l2);
            f32x4 o; if (lane < 8) o = y * c - part8 * s; else o = y * c + part8 * s;
            const int pphys = (l2 >> 2) * 32 + 8 * (l2 & 3) + (lane < 8 ? 0 : 4);
            u32x2 pk; pk[0] = cvt_pk_bf16(o[0], o[1]); pk[1] = cvt_pk_bf16(o[2], o[3]); *(u32x2*)(keys + (size_t)row * 320 + 256 + pphys) = pk;
        } else if (lane < 32) {
            const int ll = lane - 16; f32x4 o = y; int pphys = ll * 4;
            if (ll < 8) { const int l2 = ll & 3; const f32x4 c = *(const f32x4*)(cosI + (size_t)row * 16 + 4 * l2), s = *(const f32x4*)(sinI + (size_t)row * 16 + 4 * l2);
                if (ll < 4) o = y * c - part4 * s; else o = y * c + part4 * s; pphys = 8 * l2 + (ll < 4 ? 0 : 4); }
            u32x2 pk; pk[0] = cvt_pk_bf16(o[0], o[1]); pk[1] = cvt_pk_bf16(o[2], o[3]); *(u32x2*)(kidx + (size_t)row * 64 + pphys) = pk;
        } else if (lane < 36) {
            *(f32x4*)(widx + (size_t)row * 16 + (lane - 32) * 4) = x * (1.f / 32.f);
        }
    }
}

__device__ __forceinline__ void score_phase(const Params& p, int vbx) {
    const int tid_ = otid(); const int lane = tid_ & 63, l32 = lane & 31, hh = lane >> 5; const int gw = obid() * 8 + (tid_ >> 6), nw = ogrid() * 8;
    const bf16_t* qall = (const bf16_t*)(p.ws + WS_QALL); const bf16_t* kidx = (const bf16_t*)(p.ws + WS_KIDX); const float* widx = (const float*)(p.ws + WS_WIDX); float* scores = (float*)(p.ws + WS_SCORES);
    const int xb_ = vbx >> 5;
    unsigned* sctr = (unsigned*)(p.ws + WS_BAR) + 48 + 16 * (xb_ & 7);
    for (;;) {
        int tile = 0; if (lane == 0) tile = (int)__hip_atomic_fetch_add(sctr, 1u, __ATOMIC_RELAXED, __HIP_MEMORY_SCOPE_AGENT);
        tile = __builtin_amdgcn_readfirstlane(tile); if (tile >= 528) break;
        const int b = xb_ & 7, L = 527 - tile;
        int qc = (int)((sqrtf(8.f * (float)L + 1.f) - 1.f) * 0.5f); while ((qc + 1) * (qc + 2) / 2 <= L) ++qc; while (qc * (qc + 1) / 2 > L) --qc;
        const int kt = L - qc * (qc + 1) / 2;
        const int t0 = b * S_ + qc * 64, key0 = b * S_ + kt * 64;
        bf16x8 kf[2][4];
#pragma unroll
        for (int mt = 0; mt < 2; ++mt)
#pragma unroll
            for (int ks = 0; ks < 4; ++ks) kf[mt][ks] = *(const bf16x8*)(kidx + (size_t)(key0 + mt * 32 + l32) * 64 + ks * 16 + hh * 8);
        f32x16 sc[2][2];
#pragma unroll
        for (int mt = 0; mt < 2; ++mt)
#pragma unroll
            for (int nt = 0; nt < 2; ++nt)
#pragma unroll
                for (int i = 0; i < 16; ++i) sc[mt][nt][i] = 0.f;
        bf16x8 qn[2][4]; float wn[2];
#pragma unroll
        for (int nt = 0; nt < 2; ++nt) {
#pragma unroll
            for (int ks = 0; ks < 4; ++ks) qn[nt][ks] = *(const bf16x8*)(qall + (size_t)(t0 + nt * 32 + l32) * 4096 + 3072 + ks * 16 + hh * 8);
            wn[nt] = widx[(size_t)(t0 + nt * 32 + l32) * 16];
        }
        for (int h = 0; h < 16; ++h) {
            bf16x8 qf[2][4]; float w[2];
#pragma unroll
            for (int nt = 0; nt < 2; ++nt) {
#pragma unroll
                for (int ks = 0; ks < 4; ++ks) qf[nt][ks] = qn[nt][ks];
                w[nt] = wn[nt];
            }
            { const int h1 = (h + 1) & 15;
#pragma unroll
              for (int nt = 0; nt < 2; ++nt) {
#pragma unroll
                for (int ks = 0; ks < 4; ++ks) qn[nt][ks] = *(const bf16x8*)(qall + (size_t)(t0 + nt * 32 + l32) * 4096 + 3072 + h1 * 64 + ks * 16 + hh * 8);
                wn[nt] = widx[(size_t)(t0 + nt * 32 + l32) * 16 + h1];
              } }
#pragma unroll
            for (int mt = 0; mt < 2; ++mt)
#pragma unroll
                for (int nt = 0; nt < 2; ++nt) {
                    f32x16 a;
#pragma unroll
                    for (int i = 0; i < 16; ++i) a[i] = 0.f;
#pragma unroll
                    for (int ks = 0; ks < 4; ++ks) a = __builtin_amdgcn_mfma_f32_32x32x16_bf16(kf[mt][ks], qf[nt][ks], a, 0, 0, 0);
#pragma unroll
                    for (int i = 0; i < 16; ++i) sc[mt][nt][i] += w[nt] * fmaxf(a[i], 0.f);
                }
        }
#pragma unroll
        for (int mt = 0; mt < 2; ++mt)
#pragma unroll
            for (int nt = 0; nt < 2; ++nt)
#pragma unroll
                for (int q4 = 0; q4 < 4; ++q4) {
                    f32x4 o; o[0] = sc[mt][nt][q4 * 4]; o[1] = sc[mt][nt][q4 * 4 + 1]; o[2] = sc[mt][nt][q4 * 4 + 2]; o[3] = sc[mt][nt][q4 * 4 + 3];
                    *(f32x4*)(scores + (size_t)(t0 + nt * 32 + l32) * S_ + kt * 64 + mt * 32 + q4 * 8 + hh * 4) = o;
                }
    }
}
template <int NI> __device__ __forceinline__ void topk_select(const float* sr, unsigned short* srow, int qc, int lane, unsigned long long ltmask) {
    unsigned u[NI];
#pragma unroll
    for (int i = 0; i < NI; ++i) {
        unsigned bits = 0u;
        if (i <= qc) { bits = __float_as_uint(sr[i * 64 + lane]); bits = (bits & 0x80000000u) ? ~bits : (bits | 0x80000000u); if (bits == 0u) bits = 1u; }
        u[i] = bits;
    }
    unsigned thr = 0u;
    for (int bit = 31; bit >= 0; --bit) {
        const unsigned cand = thr | (1u << bit); int c = 0;
#pragma unroll
        for (int i = 0; i < NI; ++i) c += __popcll(__ballot(u[i] >= cand));
        if (c >= 256) { thr = cand; if (c == 256) break; }
    }
    int cgt = 0;
#pragma unroll
    for (int i = 0; i < NI; ++i) cgt += __popcll(__ballot(u[i] > thr));
    const int need = 256 - cgt; int eqtaken = 0, base = 0;
#pragma unroll
    for (int i = 0; i < NI; ++i) {
        const bool eq = (u[i] == thr); const unsigned long long em = __ballot(eq);
        const int rank = eqtaken + __popcll(em & ltmask);
        const bool take = (u[i] > thr) || (eq && rank < need);
        const unsigned long long tm = __ballot(take);
        if (take) srow[base + __popcll(tm & ltmask)] = (unsigned short)(i * 64 + lane);
        base += __popcll(tm); eqtaken += __popcll(em);
    }
}
__device__ __forceinline__ void topk_phase(const Params& p) {
    const int tid_ = otid(); const int lane = tid_ & 63; const int gw = obid() * 8 + (tid_ >> 6), nw = ogrid() * 8;
    const float* scores = (const float*)(p.ws + WS_SCORES); unsigned short* sel = (unsigned short*)(p.ws + WS_SEL); int* cnt = (int*)(p.ws + WS_CNT);
    const unsigned long long ltmask = (1ull << lane) - 1ull;
    for (int t0 = gw; t0 < T_; t0 += nw) {
        const int bq = t0 >> 11; const int t = (bq << 11) | (((t0 & 2047) + 261 * bq) & 2047);
        const int s = t & 2047, qc = s >> 6; const int nvalid = (qc + 1) * 64;
        unsigned short* srow = sel + (size_t)t * 256;
        if (nvalid <= 256) {
#pragma unroll
            for (int i = 0; i < 4; ++i) { const int k = i * 64 + lane; srow[k] = (unsigned short)(k < nvalid ? k : 0); }
            if (lane == 0) cnt[t] = nvalid;
            continue;
        }
        const float* sr = scores + (size_t)t * S_;
        if (qc < 8) topk_select<8>(sr, srow, qc, lane, ltmask);
        else if (qc < 16) topk_select<16>(sr, srow, qc, lane, ltmask);
        else if (qc < 24) topk_select<24>(sr, srow, qc, lane, ltmask);
        else topk_select<32>(sr, srow, qc, lane, ltmask);
        if (lane == 0) cnt[t] = 256;
    }
}


constexpr int SROW = 2052;
__device__ __forceinline__ void scoretopk_phase(const Params& p, unsigned char* shm, int vbx) {
    float* scl = (float*)shm;
    volatile int* nextp = (volatile int*)(shm + 16 * SROW * 4);
    const int tid = otid(); const int wid = tid >> 6, lane = tid & 63, l16 = lane & 15, g = lane >> 4;
    const bf16_t* qall = (const bf16_t*)(p.ws + WS_QALL); const bf16_t* kidx = (const bf16_t*)(p.ws + WS_KIDX); const float* widx = (const float*)(p.ws + WS_WIDX);
    unsigned short* sel = (unsigned short*)(p.ws + WS_SEL); int* cnt = (int*)(p.ws + WS_CNT);
    const unsigned long long ltmask = (1ull << lane) - 1ull;
    for (int bi = 0; bi < 8; ++bi) {
    const int b = ((vbx >> 5) + bi) & 7;
    unsigned* sctr = (unsigned*)(p.ws + WS_BAR) + 48 + 16 * b;
    for (;;) {
        __syncthreads();
        if (tid == 0) *nextp = (int)__hip_atomic_fetch_add(sctr, 1u, __ATOMIC_RELAXED, __HIP_MEMORY_SCOPE_AGENT);
        __syncthreads();
        const int task = *nextp; if (task >= 128) break;
        const int qg = 127 - task; const int t0 = b * S_ + qg * 16; const int qc = qg >> 2; const int nvalid = (qc + 1) * 64;
        if (nvalid <= 256) {
#pragma unroll
            for (int qq = 0; qq < 2; ++qq) {
                const int t = t0 + 2 * wid + qq; unsigned short* srow = sel + (size_t)t * 256;
#pragma unroll
                for (int i = 0; i < 4; ++i) { const int k = i * 64 + lane; srow[k] = (unsigned short)(k < nvalid ? k : 0); }
                if (lane == 0) cnt[t] = nvalid;
            }
            continue;
        }
#pragma unroll 1
        for (int hp = 0; hp < 2; ++hp) {
            bf16x8 qf[8][2]; float w[8];
#pragma unroll
            for (int h = 0; h < 8; ++h) {
#pragma unroll
                for (int ks = 0; ks < 2; ++ks) qf[h][ks] = *(const bf16x8*)(qall + (size_t)(t0 + l16) * 4096 + 3072 + (hp * 8 + h) * 64 + ks * 32 + g * 8);
            }
#pragma unroll
            for (int h4 = 0; h4 < 2; ++h4) { const f32x4 wv = *(const f32x4*)(widx + (size_t)(t0 + l16) * 16 + hp * 8 + h4 * 4); w[h4 * 4] = wv[0]; w[h4 * 4 + 1] = wv[1]; w[h4 * 4 + 2] = wv[2]; w[h4 * 4 + 3] = wv[3]; }
            const int nkt = nvalid >> 4;
            const bf16_t* kr0 = kidx + (size_t)(b * S_ + l16) * 64 + g * 8;
            bf16x8 k0n = *(const bf16x8*)(kr0 + (size_t)wid * 1024), k1n = *(const bf16x8*)(kr0 + (size_t)wid * 1024 + 32);
            for (int kt = wid; kt < nkt; kt += 8) {
                const bf16x8 k0 = k0n, k1 = k1n;
                { const int ktn = (kt + 8 < nkt) ? kt + 8 : kt; k0n = *(const bf16x8*)(kr0 + (size_t)ktn * 1024); k1n = *(const bf16x8*)(kr0 + (size_t)ktn * 1024 + 32); }
                float* dst = scl + l16 * SROW + kt * 16 + g * 4;
                f32x4 sacc = (f32x4){0.f, 0.f, 0.f, 0.f};
                if (hp) sacc = *(const f32x4*)dst;
#pragma unroll
                for (int h = 0; h < 8; ++h) {
                    f32x4 a = (f32x4){0.f, 0.f, 0.f, 0.f};
                    a = __builtin_amdgcn_mfma_f32_16x16x32_bf16(k0, qf[h][0], a, 0, 0, 0);
                    a = __builtin_amdgcn_mfma_f32_16x16x32_bf16(k1, qf[h][1], a, 0, 0, 0);
#pragma unroll
                    for (int i = 0; i < 4; ++i) sacc[i] += w[h] * fmaxf(a[i], 0.f);
                }
                *(f32x4*)dst = sacc;
            }
        }
        __syncthreads();
#pragma unroll 1
        for (int qq = 0; qq < 2; ++qq) {
            const int q = 2 * wid + qq; const int t = t0 + q; unsigned short* srow = sel + (size_t)t * 256; const float* sr = scl + q * SROW;
            if (qc < 8) topk_select<8>(sr, srow, qc, lane, ltmask);
            else if (qc < 16) topk_select<16>(sr, srow, qc, lane, ltmask);
            else if (qc < 24) topk_select<24>(sr, srow, qc, lane, ltmask);
            else topk_select<32>(sr, srow, qc, lane, ltmask);
            if (lane == 0) cnt[t] = 256;
        }
    }
    }
}
typedef short bf16x4v __attribute__((ext_vector_type(4)));
constexpr int ABUF_BYTES = 8 * 1024, AWAVE = 2 * ABUF_BYTES;
__device__ __forceinline__ void attn_phase(const Params& p, LAS unsigned char* lds, int vbx) {
    const int tid_ = otid(); const int wid = __builtin_amdgcn_readfirstlane(tid_ >> 6), lane = tid_ & 63, l16 = lane & 15, g = lane >> 4;
    const int gw = vbx * 8 + wid, nw = ogrid() * 8;
    LAS unsigned char* vl = lds + wid * AWAVE;
    LAS unsigned char* rl = lds + 8 * AWAVE + wid * 2048;
    const unsigned r_rd0 = (unsigned)((l16 >> 3) * 1024 + (l16 & 7) * 128 + ((g ^ (l16 & 7)) * 16)), r_rd1 = (unsigned)((l16 >> 3) * 1024 + (l16 & 7) * 128 + (((4 + g) ^ (l16 & 7)) * 16));
    const bf16_t* qlat = (const bf16_t*)(p.ws + WS_QLAT); const bf16_t* qall = (const bf16_t*)(p.ws + WS_QALL); const bf16_t* keys = (const bf16_t*)(p.ws + WS_KEYS);
    const unsigned short* sel = (const unsigned short*)(p.ws + WS_SEL); bf16_t* olat = (bf16_t*)(p.ws + WS_OLAT);
    const float cs = 0.07216878364870322f * 1.4426950408889634f;
    const float NEG = -1e30f;
    const unsigned a_rd0 = (unsigned)((l16 >> 3) * 1024 + (l16 & 7) * 128 + ((g ^ (l16 & 7)) * 16)), a_rd1 = (unsigned)((l16 >> 3) * 1024 + (l16 & 7) * 128 + (((4 + g) ^ (l16 & 7)) * 16));
    const int trow = g * 4 + ((lane & 15) >> 2), tp = lane & 3;
    unsigned tr_rdk[4];
#pragma unroll
    for (int k = 0; k < 4; ++k) tr_rdk[k] = (unsigned)((trow >> 3) * 1024 + (trow & 7) * 128 + (((2 * k + (tp >> 1)) ^ (trow & 7)) * 16) + (tp & 1) * 8);
    const int dr8 = lane >> 3, dpiece = ((lane & 7) ^ (lane >> 3)) * 16;
    for (int t = gw * 8; t < T_; t += nw * 8)
    for (int qi = 0; qi < 8; ++qi) {
        const int tq = t + qi; const int b = tq >> 11; const int nv_ = ((((tq & 2047) >> 6) + 1) * 64); const int cnt = nv_ < 256 ? nv_ : 256;
        bf16x8 qf[10];
#pragma unroll
        for (int ks = 0; ks < 8; ++ks) qf[ks] = *(const bf16x8*)(qlat + (size_t)tq * 4096 + l16 * 256 + ks * 32 + g * 8);
#pragma unroll
        for (int ks = 0; ks < 2; ++ks) qf[8 + ks] = *(const bf16x8*)(qall + (size_t)tq * 4096 + 2048 + l16 * 64 + ks * 32 + g * 8);
        f32x4 oacc[16];
#pragma unroll
        for (int rt = 0; rt < 16; ++rt) oacc[rt] = (f32x4){0.f, 0.f, 0.f, 0.f};
        float m = NEG, lsum = 0.f;
        const int nch = cnt >> 4;
        const unsigned short* selr = sel + (size_t)tq * 256;
        const bf16_t* kbase = keys + (size_t)(b * S_) * 320;
        int jr0 = selr[dr8], jr1 = selr[8 + dr8];
        { const char* s0 = (const char*)(kbase + (size_t)jr0 * 320) + dpiece; const char* s1 = (const char*)(kbase + (size_t)jr1 * 320) + dpiece;
#pragma unroll
          for (int lh = 0; lh < 5; ++lh) {
              LAS unsigned char* d = (lh < 4) ? vl + lh * 2048 : rl;
              __builtin_amdgcn_global_load_lds((const unsigned*)(s0 + lh * 128), (LAS unsigned*)(d), 16, 0, 0);
              __builtin_amdgcn_global_load_lds((const unsigned*)(s1 + lh * 128), (LAS unsigned*)(d + 1024), 16, 0, 0); } }
        jr0 = selr[16 + dr8]; jr1 = selr[24 + dr8];
        for (int c = 0; c < nch; ++c) {
            LAS unsigned char* buf = vl + (c & 1) * ABUF_BYTES;
            asm volatile("s_waitcnt vmcnt(0)" ::: "memory");
            const bf16x8 r0 = *(const LAS bf16x8*)(rl + r_rd0), r1 = *(const LAS bf16x8*)(rl + r_rd1);
            asm volatile("s_waitcnt lgkmcnt(0)" ::: "memory");
            if (c + 1 < nch) {
                LAS unsigned char* nb = vl + ((c + 1) & 1) * ABUF_BYTES;
                const char* s0 = (const char*)(kbase + (size_t)jr0 * 320) + dpiece; const char* s1 = (const char*)(kbase + (size_t)jr1 * 320) + dpiece;
#pragma unroll
                for (int lh = 0; lh < 5; ++lh) {
                    LAS unsigned char* d = (lh < 4) ? nb + lh * 2048 : rl;
                    __builtin_amdgcn_global_load_lds((const unsigned*)(s0 + lh * 128), (LAS unsigned*)(d), 16, 0, 0);
                    __builtin_amdgcn_global_load_lds((const unsigned*)(s1 + lh * 128), (LAS unsigned*)(d + 1024), 16, 0, 0); }
                const int cn = (c + 2 < 16) ? c + 2 : 15; jr0 = selr[cn * 16 + dr8]; jr1 = selr[cn * 16 + 8 + dr8];
            }
            f32x4 sv = (f32x4){0.f, 0.f, 0.f, 0.f};
#pragma unroll
            for (int ks = 0; ks < 8; ++ks) { const bf16x8 a = *(const LAS bf16x8*)(buf + (ks >> 1) * 2048 + ((ks & 1) ? a_rd1 : a_rd0)); sv = __builtin_amdgcn_mfma_f32_16x16x32_bf16(a, qf[ks], sv, 0, 0, 0); }
            sv = __builtin_amdgcn_mfma_f32_16x16x32_bf16(r0, qf[8], sv, 0, 0, 0); sv = __builtin_amdgcn_mfma_f32_16x16x32_bf16(r1, qf[9], sv, 0, 0, 0);
            float cmax = NEG;
#pragma unroll
            for (int i = 0; i < 4; ++i) { if (c * 16 + g * 4 + i >= cnt) sv[i] = NEG; cmax = fmaxf(cmax, sv[i]); }
            cmax = fmaxf(cmax, __shfl_xor(cmax, 16)); cmax = fmaxf(cmax, __shfl_xor(cmax, 32));
            if (__any((cmax - m) * cs > 6.f)) {
                const float mn = fmaxf(m, cmax); const float alpha = exp2f((m - mn) * cs); m = mn;
                lsum *= alpha;
#pragma unroll
                for (int rt = 0; rt < 16; ++rt) oacc[rt] *= alpha;
            }
            float ps = 0.f;
#pragma unroll
            for (int i = 0; i < 4; ++i) { sv[i] = exp2f((sv[i] - m) * cs); ps += sv[i]; }
            lsum += ps;
            u32x2 pfu; pfu[0] = cvt_pk_bf16(sv[0], sv[1]); pfu[1] = cvt_pk_bf16(sv[2], sv[3]);
            const bf16x4v pf = __builtin_bit_cast(bf16x4v, pfu);
            const unsigned tbb = (unsigned)(size_t)buf; const unsigned tb0 = tbb + tr_rdk[0], tb1 = tbb + tr_rdk[1], tb2 = tbb + tr_rdk[2], tb3 = tbb + tr_rdk[3];
#define TRG4(R4) { bf16x4v a0, a1, a2, a3; \
                asm volatile("ds_read_b64_tr_b16 %0, %4 offset:%8\n\tds_read_b64_tr_b16 %1, %5 offset:%8\n\tds_read_b64_tr_b16 %2, %6 offset:%8\n\tds_read_b64_tr_b16 %3, %7 offset:%8\n\ts_waitcnt lgkmcnt(0)" \
                             : "=&v"(a0), "=&v"(a1), "=&v"(a2), "=&v"(a3) \
                             : "v"(tb0), "v"(tb1), "v"(tb2), "v"(tb3), "i"((R4) * 2048) : "memory"); \
                oacc[(R4) * 4 + 0] = __builtin_amdgcn_mfma_f32_16x16x16bf16_1k(a0, pf, oacc[(R4) * 4 + 0], 0, 0, 0); \
                oacc[(R4) * 4 + 1] = __builtin_amdgcn_mfma_f32_16x16x16bf16_1k(a1, pf, oacc[(R4) * 4 + 1], 0, 0, 0); \
                oacc[(R4) * 4 + 2] = __builtin_amdgcn_mfma_f32_16x16x16bf16_1k(a2, pf, oacc[(R4) * 4 + 2], 0, 0, 0); \
                oacc[(R4) * 4 + 3] = __builtin_amdgcn_mfma_f32_16x16x16bf16_1k(a3, pf, oacc[(R4) * 4 + 3], 0, 0, 0); }
            TRG4(0) TRG4(1) TRG4(2) TRG4(3)
#undef TRG4
        }
        lsum += __shfl_xor(lsum, 16); lsum += __shfl_xor(lsum, 32);
        const float inv = 1.f / lsum;
#pragma unroll
        for (int rt = 0; rt < 16; ++rt) { const f32x4 o = oacc[rt] * inv; u32x2 pk; pk[0] = cvt_pk_bf16(o[0], o[1]); pk[1] = cvt_pk_bf16(o[2], o[3]); *(u32x2*)(olat + (size_t)tq * 4096 + l16 * 256 + rt * 16 + g * 4) = pk; }
    }
}

__device__ __forceinline__ void red8x2(float& x0, float& x1) {
    float y0, y1;
    asm volatile("s_nop 1\n\t"
                 "v_add_f32_dpp %0, %2, %2 quad_perm:[1,0,3,2] row_mask:0xf bank_mask:0xf\n\t"
                 "v_add_f32_dpp %1, %3, %3 quad_perm:[1,0,3,2] row_mask:0xf bank_mask:0xf\n\t"
                 "s_nop 0\n\t"
                 "v_add_f32_dpp %0, %0, %0 quad_perm:[2,3,0,1] row_mask:0xf bank_mask:0xf\n\t"
                 "v_add_f32_dpp %1, %1, %1 quad_perm:[2,3,0,1] row_mask:0xf bank_mask:0xf\n\t"
                 "s_nop 0\n\t"
                 "v_add_f32_dpp %0, %0, %0 row_half_mirror row_mask:0xf bank_mask:0xf\n\t"
                 "v_add_f32_dpp %1, %1, %1 row_half_mirror row_mask:0xf bank_mask:0xf\n\t"
                 "s_nop 0"
                 : "=&v"(y0), "=&v"(y1) : "v"(x0), "v"(x1));
    x0 = y0; x1 = y1;
}
constexpr int TC = 32;
typedef float f32x2 __attribute__((ext_vector_type(2)));
__device__ __forceinline__ void scan_phase(const Params& p, unsigned char* shm) {
    const int tid = otid(); const bool seq = tid < 256;
    float* bufs = (float*)shm;
    float* obuf = bufs + 2 * 6 * TC * 64;
    const bf16_t* rbuf = (const bf16_t*)(p.ws + WS_RBUF); const bf16_t* kbuf = (const bf16_t*)(p.ws + WS_KBUF); const bf16_t* vbuf = (const bf16_t*)(p.ws + WS_VBUF);
    const bf16_t* abuf = (const bf16_t*)(p.ws + WS_ABUF); const bf16_t* gbuf = (const bf16_t*)(p.ws + WS_GBUF); const float* wdec = (const float*)(p.ws + WS_WDEC);
    bf16_t* outb = (bf16_t*)(p.ws + WS_SCANOUT);
    const int nb_ = ogrid();
    for (int pair = obid(); pair < 256; pair += nb_) {
        const int b = pair >> 5, h = pair & 31;
        if (seq) {
            const int rp = tid >> 3, cgp = tid & 7;
            f32x2 A0[4], A1[4];
#pragma unroll
            for (int q = 0; q < 4; ++q) { A0[q] = (f32x2){0.f, 0.f}; A1[q] = (f32x2){0.f, 0.f}; }
            __syncthreads();
            for (int c = 0; c <= S_ / TC; ++c) {
                if (c < S_ / TC) {
                    const float* B = bufs + (c & 1) * 6 * TC * 64 + cgp * 8; float* ob = obuf + (c & 1) * TC * 64 + 2 * rp;
                    const float* Bv = bufs + (c & 1) * 6 * TC * 64 + 5 * TC * 64 + 2 * rp;
                    f32x4 xw0 = *(const f32x4*)(B), xw1 = *(const f32x4*)(B + 4), xn0 = *(const f32x4*)(B + TC * 64), xn1 = *(const f32x4*)(B + TC * 64 + 4);
                    f32x4 xb0 = *(const f32x4*)(B + 2 * TC * 64), xb1 = *(const f32x4*)(B + 2 * TC * 64 + 4), xk0 = *(const f32x4*)(B + 3 * TC * 64), xk1 = *(const f32x4*)(B + 3 * TC * 64 + 4);
                    f32x4 xr0 = *(const f32x4*)(B + 4 * TC * 64), xr1 = *(const f32x4*)(B + 4 * TC * 64 + 4); f32x2 xvv = *(const f32x2*)(Bv);
#pragma unroll 4
                    for (int s = 0; s < TC; ++s) {
                        const f32x4 w0 = xw0, w1 = xw1, n0 = xn0, n1 = xn1, b0 = xb0, b1 = xb1, k0 = xk0, k1 = xk1, r0 = xr0, r1 = xr1; const f32x2 vv = xvv;
                        { const float* Bs = B + (s + 1) * 64;
                          xw0 = *(const f32x4*)(Bs); xw1 = *(const f32x4*)(Bs + 4); xn0 = *(const f32x4*)(Bs + TC * 64); xn1 = *(const f32x4*)(Bs + TC * 64 + 4);
                          xb0 = *(const f32x4*)(Bs + 2 * TC * 64); xb1 = *(const f32x4*)(Bs + 2 * TC * 64 + 4); xk0 = *(const f32x4*)(Bs + 3 * TC * 64); xk1 = *(const f32x4*)(Bs + 3 * TC * 64 + 4);
                          xr0 = *(const f32x4*)(Bs + 4 * TC * 64); xr1 = *(const f32x4*)(Bs + 4 * TC * 64 + 4); xvv = *(const f32x2*)(Bv + (s + 1) * 64); }
                        const f32x2 wp[4] = {{w0[0], w0[1]}, {w0[2], w0[3]}, {w1[0], w1[1]}, {w1[2], w1[3]}};
                        const f32x2 np[4] = {{n0[0], n0[1]}, {n0[2], n0[3]}, {n1[0], n1[1]}, {n1[2], n1[3]}};
                        const f32x2 bp[4] = {{b0[0], b0[1]}, {b0[2], b0[3]}, {b1[0], b1[1]}, {b1[2], b1[3]}};
                        const f32x2 kp[4] = {{k0[0], k0[1]}, {k0[2], k0[3]}, {k1[0], k1[1]}, {k1[2], k1[3]}};
                        const f32x2 rq[4] = {{r0[0], r0[1]}, {r0[2], r0[3]}, {r1[0], r1[1]}, {r1[2], r1[3]}};
                        f32x2 t0 = A0[0] * np[0], t1 = A1[0] * np[0];
#pragma unroll
                        for (int q = 1; q < 4; ++q) { t0 = __builtin_elementwise_fma(A0[q], np[q], t0); t1 = __builtin_elementwise_fma(A1[q], np[q], t1); }
                        float sa0 = t0[0] + t0[1], sa1 = t1[0] + t1[1];
                        red8x2(sa0, sa1);
                        const f32x2 s0v = {sa0, sa0}, s1v = {sa1, sa1}, v0v = {vv[0], vv[0]}, v1v = {vv[1], vv[1]};
#pragma unroll
                        for (int q = 0; q < 4; ++q) { A0[q] = __builtin_elementwise_fma(v0v, kp[q], __builtin_elementwise_fma(s0v, bp[q], A0[q] * wp[q])); A1[q] = __builtin_elementwise_fma(v1v, kp[q], __builtin_elementwise_fma(s1v, bp[q], A1[q] * wp[q])); }
                        f32x2 u0 = A0[0] * rq[0], u1 = A1[0] * rq[0];
#pragma unroll
                        for (int q = 1; q < 4; ++q) { u0 = __builtin_elementwise_fma(A0[q], rq[q], u0); u1 = __builtin_elementwise_fma(A1[q], rq[q], u1); }
                        float o0 = u0[0] + u0[1], o1 = u1[0] + u1[1];
                        red8x2(o0, o1);
                        if (cgp == 0) *(f32x2*)(ob + s * 64) = (f32x2){o0, o1};
                    }
                }
                __syncthreads();
            }
        } else {
            const int ht = tid - 256; const int ss0 = ht >> 4, c4 = (ht & 15) * 4; const int ch = h * 64 + c4;
            const f32x4 w0v = *(const f32x4*)(p.in[23] + ch), a0v = *(const f32x4*)(p.in[26] + ch); const f32x4 kkv = *(const f32x4*)(p.in[31] + ch), kav = *(const f32x4*)(p.in[32] + ch), rkv = *(const f32x4*)(p.in[33] + ch), gng = *(const f32x4*)(p.in[34] + ch), gnb = *(const f32x4*)(p.in[35] + ch);
            for (int c = -1; c <= S_ / TC; ++c) {
                const bool do_post = (c >= 1), do_stage = (c + 1 < S_ / TC);
                u32x2 lr[2], lk[2], lv[2], la[2], lg[2]; f32x4 lw[2];
#pragma unroll
                for (int i = 0; i < 2; ++i) {
                    const int ss = ss0 + 16 * i;
                    if (do_stage) { const size_t off = (size_t)(b * S_ + (c + 1) * TC + ss) * D_ + ch; lr[i] = *(const u32x2*)(rbuf + off); lk[i] = *(const u32x2*)(kbuf + off); lv[i] = *(const u32x2*)(vbuf + off); la[i] = *(const u32x2*)(abuf + off); lw[i] = *(const f32x4*)(wdec + off); }
                    if (do_post) { const size_t off = (size_t)(b * S_ + (c - 1) * TC + ss) * D_ + ch; lg[i] = *(const u32x2*)(gbuf + off); }
                }
#pragma unroll
                for (int i = 0; i < 2; ++i) {
                    const int ss = ss0 + 16 * i; const int o = ss * 64 + c4;
                    float* B = bufs + ((c + 1) & 1) * 6 * TC * 64;
                    if (do_post) {
                        const float* obr = obuf + ((c - 1) & 1) * TC * 64;
                        const f32x4 ov = *(const f32x4*)(obr + o), km = *(const f32x4*)(B + 3 * TC * 64 + o), r = *(const f32x4*)(B + 4 * TC * 64 + o), v = *(const f32x4*)(B + 5 * TC * 64 + o);
                        float s1 = ov[0] + ov[1] + ov[2] + ov[3]; s1 = red16(s1); const float mean = s1 * (1.f / 64.f);
                        const f32x4 oc = ov - mean; float s2 = oc[0] * oc[0] + oc[1] * oc[1] + oc[2] * oc[2] + oc[3] * oc[3]; s2 = red16(s2); const float rs = rsqrtf(s2 * (1.f / 64.f) + 64e-5f);
                        const f32x4 rk = r * km * rkv; float bs = rk[0] + rk[1] + rk[2] + rk[3]; bs = red16(bs);
                        const size_t off = (size_t)(b * S_ + (c - 1) * TC + ss) * D_ + ch;
                        f32x4 gg; gg[0] = bf2f(lg[i][0] & 0xffffu); gg[1] = bf2f(lg[i][0] >> 16); gg[2] = bf2f(lg[i][1] & 0xffffu); gg[3] = bf2f(lg[i][1] >> 16);
                        const f32x4 y = (oc * rs * gng + gnb + v * bs) * gg;
                        u32x2 pk; pk[0] = cvt_pk_bf16(y[0], y[1]); pk[1] = cvt_pk_bf16(y[2], y[3]); *(u32x2*)(outb + off) = pk;
                    }
                    if (do_stage) {
                        f32x4 r, k, v, a, wv;
                        r[0] = bf2f(lr[i][0] & 0xffffu); r[1] = bf2f(lr[i][0] >> 16); r[2] = bf2f(lr[i][1] & 0xffffu); r[3] = bf2f(lr[i][1] >> 16);
                        k[0] = bf2f(lk[i][0] & 0xffffu); k[1] = bf2f(lk[i][0] >> 16); k[2] = bf2f(lk[i][1] & 0xffffu); k[3] = bf2f(lk[i][1] >> 16);
                        v[0] = bf2f(lv[i][0] & 0xffffu); v[1] = bf2f(lv[i][0] >> 16); v[2] = bf2f(lv[i][1] & 0xffffu); v[3] = bf2f(lv[i][1] >> 16);
                        a[0] = bf2f(la[i][0] & 0xffffu); a[1] = bf2f(la[i][0] >> 16); a[2] = bf2f(la[i][1] & 0xffffu); a[3] = bf2f(la[i][1] >> 16);
#pragma unroll
                        for (int e = 0; e < 4; ++e) { a[e] = sigmoidf_(a0v[e] + a[e]); const float z = -(w0v[e] + lw[i][e]); const float sp = fmaxf(z, 0.f) + __logf(1.f + __expf(-fabsf(z))); wv[e] = __expf(-__expf(-sp - 0.5f)); }
                        f32x4 kk = k * kkv; float n2 = kk[0] * kk[0] + kk[1] * kk[1] + kk[2] * kk[2] + kk[3] * kk[3]; n2 = red16(n2);
                        const float invn = 1.f / fmaxf(sqrtf(n2), 1e-12f); kk = kk * invn;
                        const f32x4 km = k * ((a - 1.f) * kav + 1.f);
                        *(f32x4*)(B + 0 * TC * 64 + o) = wv; *(f32x4*)(B + 1 * TC * 64 + o) = -kk; *(f32x4*)(B + 2 * TC * 64 + o) = kk * a; *(f32x4*)(B + 3 * TC * 64 + o) = km; *(f32x4*)(B + 4 * TC * 64 + o) = r; *(f32x4*)(B + 5 * TC * 64 + o) = v;
                    }
                }
                __syncthreads();
            }
        }
        __syncthreads();
    }
}

__global__ void __launch_bounds__(512, 2) mega(Params p) {
    extern __shared__ __attribute__((aligned(16))) unsigned char shm[];
    LAS unsigned char* lds = (LAS unsigned char*)shm;
    cg::grid_group grid = cg::this_grid();
    unsigned char* ws = p.ws;
    float* mod = (float*)(ws + WS_MOD); float* X = (float*)(ws + WS_X);
    volatile LAS unsigned* xst = (volatile LAS unsigned*)(lds + LDS_BYTES - 16);
    if (threadIdx.x == 0) { xst[0] = 0u; xst[1] = 0u; xst[2] = 0u; xst[3] = 0u; }
    __syncthreads();
    const XcdBarrier xb = xcd_barrier_post((unsigned*)(ws + WS_BAR + 4096), xst);
    p0_mod(p, shm); p0_rope(p); __syncthreads(); convert_jobs(p, shm, 0, NJOBS_EARLY, (unsigned*)(ws + WS_BAR) + 16);
    if (p.ws == nullptr) grid.sync();
    xcd_barrier(xb);
    if (threadIdx.x == 0) {
        bool ok = (gridDim.x == 256);
        for (int j = 0; j < 16; ++j) ok = ok && (xb_ld(&xb.bar[XB_XCNT(j)]) == (j < 8 ? 32u : 0u));
        if (!ok) xst[2] = 0xFFFFFFFFu;
    }
    __syncthreads();
    int vb; { const unsigned rk = xst[2], xc = xst[3]; vb = (gridDim.x == 256 && rk < 32u && xc < 8u) ? (int)(rk * 8u + xc) : (int)blockIdx.x; asm volatile("" : "+s"(vb)); }
    int vbx; { const unsigned rk = xst[2], xc = xst[3]; vbx = (gridDim.x == 256 && rk < 32u && xc < 8u) ? (int)(xc * 32u + rk) : (int)blockIdx.x; asm volatile("" : "+s"(vbx)); }
    norm_phase(vbx, p.in[0], mod + 0 * 2048, mod + 1 * 2048, (bf16_t*)(ws + WS_HMIX), nullptr, nullptr);
    xcd_barrier(xb);
    { Epi<M_F32> E{}; E.o0 = ws + WS_PROJ; E.ldc = 1024; run_gemm<M_F32>(vb, lds, ws + WS_HMIX, 2048, ws + WS_WT_IN, 2048, T_, 1024, 2048, 0, E); }
    xcd_barrier(xb);
    projrow_phase(p);
    xcd_barrier(xb);
    { Epi<M_QROPE> E{}; E.o0 = ws + WS_QALL; E.ldc = 4096; E.f0 = (const float*)(ws + WS_COSA); E.f1 = (const float*)(ws + WS_SINA); E.f2 = (const float*)(ws + WS_COSI); E.f3 = (const float*)(ws + WS_SINI);
      run_gemm<M_QROPE>(vb, lds, ws + WS_CQ, 512, ws + WS_WT_Q, 512, T_, 4096, 512, 0, E); }
    xcd_barrier(xb);
    { Epi<M_BF16> E{}; E.o0 = ws + WS_QLAT; E.ldc = 4096; run_gemm<M_BF16>(vb, lds, ws + WS_QALL, 4096, ws + WS_WT_UK, 256, T_, 4096, 256, 1, E); }
    scoretopk_phase(p, shm, vbx);
    xcd_barrier(xb);
    attn_phase(p, lds, vbx);
    xcd_barrier(xb);
    { Epi<M_BF16> E{}; E.o0 = ws + WS_O; E.ldc = 2048; run_gemm<M_BF16>(vb, lds, ws + WS_OLAT, 4096, ws + WS_WT_UV, 512, T_, 2048, 512, 2, E); }
    xcd_barrier(xb);
    { Epi<M_RESID> E{}; E.o0 = X; E.f0 = p.in[0]; E.f1 = mod + 2 * 2048; run_gemm<M_RESID>(vb, lds, ws + WS_O, 2048, ws + WS_WT_O, 2048, T_, 2048, 2048, 0, E); }
    xcd_barrier(xb);
    norm_phase(vbx, X, mod + 3 * 2048, mod + 4 * 2048, (bf16_t*)(ws + WS_HFF), nullptr, nullptr);
    xcd_barrier(xb);
    { Epi<M_RELU2> E{}; E.o0 = ws + WS_H1; E.ldc = 8192; run_gemm<M_RELU2>(vb, lds, ws + WS_HFF, 2048, ws + WS_WT_1_0, 2048, T_, 8192, 2048, 0, E); }
    xcd_barrier(xb);
    { Epi<M_RESID> E{}; E.o0 = X; E.f0 = X; E.f1 = mod + 5 * 2048; run_gemm<M_RESID>(vb, lds, ws + WS_H1, 8192, ws + WS_WT_2_0, 8192, T_, 2048, 8192, 0, E); }
    xcd_barrier(xb);
    const float* mod1 = mod + 8 * 12288;
    mix_phase(p, X, mod1 + 0 * 2048, mod1 + 1 * 2048, shm);
    xcd_barrier(xb);
    { Epi<M_L1A> E{}; E.o0 = ws + WS_KBUF; E.o1 = ws + WS_VBUF; E.o2 = ws + WS_MID; E.o3 = ws + WS_MID + 8 * MiB; E.o4 = ws + WS_MID + 16 * MiB;
      run_gemm<M_L1A>(vb, lds, ws + WS_MIX + 64 * MiB, 2048, (bf16_t*)(ws + WS_WT_RKV) + (size_t)2048 * 2048, 2048, T_, 4864, 2048, 3, E); }
    xcd_barrier(xb);
    { Epi<M_BF16> E{}; E.o0 = ws + WS_RBUF; E.ldc = 2048; run_gemm<M_BF16>(vb, lds, ws + WS_MIX, 2048, ws + WS_WT_RKV, 2048, T_, 2048, 2048, 0, E); }
    { Epi<M_F32> E{}; E.o0 = ws + WS_WDEC; E.ldc = 2048; run_gemm<M_F32>(vb, lds, ws + WS_MID, 256, ws + WS_WT_L2, 256, T_, 2048, 256, 0, E); }
    { Epi<M_BF16> E{}; E.o0 = ws + WS_ABUF; E.ldc = 2048; run_gemm<M_BF16>(vb, lds, ws + WS_MID + 8 * MiB, 256, (bf16_t*)(ws + WS_WT_L2) + (size_t)2048 * 256, 256, T_, 2048, 256, 0, E); }
    { Epi<M_BF16> E{}; E.o0 = ws + WS_GBUF; E.ldc = 2048; run_gemm<M_BF16>(vb, lds, ws + WS_MID + 16 * MiB, 256, (bf16_t*)(ws + WS_WT_L2) + (size_t)4096 * 256, 256, T_, 2048, 256, 0, E); }
    xcd_barrier(xb);
    scan_phase(p, shm);
    xcd_barrier(xb);
    { Epi<M_RESID> E{}; E.o0 = X; E.f0 = X; E.f1 = mod1 + 2 * 2048; run_gemm<M_RESID>(vb, lds, ws + WS_SCANOUT, 2048, ws + WS_WT_BO, 2048, T_, 2048, 2048, 0, E); }
    xcd_barrier(xb);
    norm_phase(vbx, X, mod1 + 3 * 2048, mod1 + 4 * 2048, (bf16_t*)(ws + WS_HFF), nullptr, nullptr);
    __syncthreads(); convert_jobs(p, shm, NJOBS_EARLY, NJOBS_ALL, (unsigned*)(ws + WS_BAR) + 32);
    xcd_barrier(xb);
    { Epi<M_RELU2> E{}; E.o0 = ws + WS_H1; E.ldc = 8192; run_gemm<M_RELU2>(vb, lds, ws + WS_HFF, 2048, ws + WS_WT_1_1, 2048, T_, 8192, 2048, 0, E); }
    xcd_barrier(xb);
    { Epi<M_RESID> E{}; E.o0 = X; E.f0 = X; E.f1 = mod1 + 5 * 2048; run_gemm<M_RESID>(vb, lds, ws + WS_H1, 8192, ws + WS_WT_2_1, 8192, T_, 2048, 8192, 0, E); }
    xcd_barrier(xb);
    norm_phase(vbx, X, nullptr, nullptr, nullptr, p.out, p.in[7]);
}

extern "C" void kernel_launch(void* const* d_in, const int* in_sizes, int n_in, void* d_out, int out_size, void* d_ws, size_t ws_size, hipStream_t stream) {
    static int grid = 0;
    if (grid == 0) {
        int dev = 0, cus = 0, per_cu = 0;
        hipGetDevice(&dev); hipDeviceGetAttribute(&cus, hipDeviceAttributeMultiprocessorCount, dev);
        if (hipFuncSetAttribute((const void*)mega, hipFuncAttributeMaxDynamicSharedMemorySize, LDS_BYTES) != hipSuccess) fprintf(stderr, "hipFuncSetAttribute failed\n");
        hipOccupancyMaxActiveBlocksPerMultiprocessor(&per_cu, (const void*)mega, 512, LDS_BYTES);
        if (per_cu < 1) per_cu = 1;
        grid = cus * 1;
        (void)hipGetLastError();
    }
    Params p{};
    for (int i = 0; i < 36; ++i) p.in[i] = (const float*)d_in[i];
    p.out = (float*)d_out; p.ws = (unsigned char*)d_ws;
    (void)hipMemsetAsync((unsigned char*)d_ws + WS_BAR, 0, 32768, stream);
    void* args[] = {&p};
    hipError_t e = hipLaunchCooperativeKernel((const void*)mega, dim3(grid), dim3(512), args, LDS_BYTES, stream);
    if (e != hipSuccess) fprintf(stderr, "cooperative launch failed: %s (grid %d)\n", hipGetErrorString(e), grid);
}
```

```cpp
#include <hip/hip_runtime.h>
#include <hip/hip_cooperative_groups.h>
#include <cstdio>
#include <cstdint>
namespace cg = cooperative_groups;

#define LAS __attribute__((address_space(3)))
typedef unsigned short bf16_t;
typedef short bf16x8 __attribute__((ext_vector_type(8)));
typedef short s16x4 __attribute__((ext_vector_type(4)));
typedef float f32x4 __attribute__((ext_vector_type(4)));
typedef float f32x16 __attribute__((ext_vector_type(16)));
typedef unsigned u32x4 __attribute__((ext_vector_type(4)));
typedef unsigned u32x2 __attribute__((ext_vector_type(2)));

constexpr int T_ = 16384, D_ = 2048, S_ = 2048, FF_ = 8192;
constexpr size_t MiB = 1048576;
constexpr size_t WS_MOD = 0, WS_COSA = 1 * MiB, WS_SINA = 3 * MiB, WS_COSI = 5 * MiB, WS_SINI = 6 * MiB, WS_CNT = 7 * MiB;
constexpr size_t WS_X = 8 * MiB;
constexpr size_t WS_WT_RKV = 136 * MiB, WS_WT_L2 = 163 * MiB, WS_WT_BO = 166 * MiB;
constexpr size_t WS_WT_IN = 174 * MiB, WS_WT_Q = 178 * MiB, WS_WT_UK = 182 * MiB, WS_WT_UV = 184 * MiB, WS_WT_O = 186 * MiB, WS_WT_1_0 = 194 * MiB, WS_WT_2_0 = 226 * MiB;
constexpr size_t WS_HMIX = 258 * MiB, WS_PROJ = 322 * MiB, WS_SCORES = 258 * MiB, WS_OLAT = 258 * MiB, WS_QALL = 386 * MiB, WS_O = 386 * MiB, WS_QLAT = 514 * MiB;
constexpr size_t WS_CQ = 642 * MiB, WS_KEYS = 658 * MiB, WS_KIDX = 668 * MiB, WS_WIDX = 670 * MiB, WS_SEL = 671 * MiB;
constexpr size_t WS_HFF = 258 * MiB, WS_H1 = 322 * MiB;
constexpr size_t WS_MIX = 258 * MiB;
constexpr size_t WS_KBUF = 174 * MiB, WS_VBUF = 642 * MiB, WS_MID = 706 * MiB;
constexpr size_t WS_RBUF = 322 * MiB, WS_WDEC = 450 * MiB, WS_ABUF = 578 * MiB, WS_GBUF = 386 * MiB, WS_SCANOUT = 258 * MiB;
constexpr size_t WS_WT_1_1 = 578 * MiB, WS_WT_2_1 = 610 * MiB;
constexpr int LDS_BYTES = 147520;

struct Params { const float* in[36]; float* out; unsigned char* ws; };

__device__ __forceinline__ bf16_t f2bf(float f) { unsigned u = __float_as_uint(f); u += 0x7FFFu + ((u >> 16) & 1u); return (bf16_t)(u >> 16); }
__device__ __forceinline__ float bf2f(unsigned b) { return __uint_as_float(b << 16); }
__device__ __forceinline__ unsigned cvt_pk_bf16(float lo, float hi) { unsigned r; asm volatile("v_cvt_pk_bf16_f32 %0, %1, %2" : "=v"(r) : "v"(lo), "v"(hi)); return r; }
__device__ __forceinline__ float dpp_f(float x, const int ctrl_sel) {
    const int v = __builtin_bit_cast(int, x); int r;
    if (ctrl_sel == 0) r = __builtin_amdgcn_update_dpp(0, v, 0xB1, 0xF, 0xF, true);
    else if (ctrl_sel == 1) r = __builtin_amdgcn_update_dpp(0, v, 0x4E, 0xF, 0xF, true);
    else if (ctrl_sel == 2) r = __builtin_amdgcn_update_dpp(0, v, 0x141, 0xF, 0xF, true);
    else r = __builtin_amdgcn_update_dpp(0, v, 0x140, 0xF, 0xF, true);
    return __builtin_bit_cast(float, r);
}
__device__ __forceinline__ int otid() { int t = threadIdx.x; asm volatile("" : "+v"(t)); return t; }
__device__ __forceinline__ int obid() { int t = blockIdx.x; asm volatile("" : "+s"(t)); return t; }
__device__ __forceinline__ int ogrid() { int t = gridDim.x; asm volatile("" : "+s"(t)); return t; }
constexpr size_t WS_BAR = 7 * MiB + 512 * 1024;
__device__ __forceinline__ void fast_sync(unsigned* ctr, unsigned& target, unsigned nblk) {
    target += nblk;
    asm volatile("s_waitcnt vmcnt(0) lgkmcnt(0)" ::: "memory");
    __syncthreads();
    if (threadIdx.x == 0) {
        __builtin_amdgcn_fence(__ATOMIC_RELEASE, "agent");
        asm volatile("s_waitcnt vmcnt(0)" ::: "memory");
        __hip_atomic_fetch_add(ctr, 1u, __ATOMIC_RELAXED, __HIP_MEMORY_SCOPE_AGENT);
        while (__hip_atomic_load(ctr, __ATOMIC_RELAXED, __HIP_MEMORY_SCOPE_AGENT) < target) __builtin_amdgcn_s_sleep(2);
        __builtin_amdgcn_fence(__ATOMIC_ACQUIRE, "agent");
        asm volatile("s_waitcnt vmcnt(0)" ::: "memory");
    }
    __syncthreads();
}

#define XB_TMO      128
#define XB_XCNT(j)  (256  + 64 * (j))
#define XB_XSUB(j)  (1280 + 64 * (j))
#define XB_XGEN(j)  (2304 + 64 * (j))
#define XB_TOP      3328
#define XB_TOPGEN   3392
#define XCD_BAR_WORDS 3456
#define XB_SPIN_CAP (1u << 22)
__device__ __forceinline__ unsigned xb_ld(unsigned* p)              { return __hip_atomic_load(p, __ATOMIC_RELAXED, __HIP_MEMORY_SCOPE_AGENT); }
__device__ __forceinline__ unsigned xb_add(unsigned* p, unsigned v) { return __hip_atomic_fetch_add(p, v, __ATOMIC_RELAXED, __HIP_MEMORY_SCOPE_AGENT); }
__device__ __forceinline__ unsigned xb_xcc_id() { return (unsigned)__builtin_amdgcn_s_getreg((3 << 11) | 20) & 0xFu; }
#define XB_SPIN(cond, bar) do { unsigned _sp = 0; while (cond) { __builtin_amdgcn_s_sleep(1); \
    if ((++_sp & 255u) == 0u) { if (xb_ld(&(bar)[XB_TMO])) break; if (_sp > XB_SPIN_CAP) { atomicAdd(&(bar)[XB_TMO], 1u); break; } } } } while (0)
struct XcdBarrier { unsigned* bar; unsigned x; volatile LAS unsigned* st; };
__device__ __forceinline__ XcdBarrier xcd_barrier_post(unsigned* bar, volatile LAS unsigned* st) {
    XcdBarrier b; b.bar = bar; b.x = xb_xcc_id(); b.st = st;
    if (threadIdx.x == 0) { const unsigned rank = xb_add(&bar[XB_XCNT(b.x)], 1u); st[2] = rank; st[3] = b.x; }
    return b;
}
__device__ __forceinline__ void xcd_barrier_complete(unsigned* bar, unsigned x, unsigned& nloc, unsigned& nx) {
    const unsigned G = gridDim.x * gridDim.y * gridDim.z;
    unsigned sum, cnt, mine, sp = 0u;
    for (;;) {
        sum = 0u; cnt = 0u; mine = 0u;
#pragma unroll
        for (unsigned j = 0; j < 16; ++j) { const unsigned c = xb_ld(&bar[XB_XCNT(j)]); sum += c; cnt += (c > 0u) ? 1u : 0u; mine = (j == x) ? c : mine; }
        if (sum == G) break;
        __builtin_amdgcn_s_sleep(1);
        if ((++sp & 255u) == 0u) { if (xb_ld(&bar[XB_TMO])) break; if (sp > XB_SPIN_CAP) { atomicAdd(&bar[XB_TMO], 1u); break; } }
    }
    nloc = mine > 0u ? mine : 1u; nx = cnt > 0u ? cnt : 1u;
}
__device__ __forceinline__ void xcd_barrier(const XcdBarrier& b) {
    asm volatile("s_waitcnt vmcnt(0)" ::: "memory");
    __syncthreads();
    if (threadIdx.x == 0) {
        unsigned* bar = b.bar;
        __builtin_amdgcn_s_waitcnt(0);
        unsigned nloc = b.st[0], nx = b.st[1];
        if (nloc == 0u) { xcd_barrier_complete(bar, b.x, nloc, nx); b.st[0] = nloc; b.st[1] = nx; }
        const unsigned old = xb_add(&bar[XB_XSUB(b.x)], 1u);
        const unsigned gen = old / nloc;
        if (old + 1u == (gen + 1u) * nloc) {
            __builtin_amdgcn_fence(__ATOMIC_RELEASE, "agent");
            asm volatile("s_waitcnt vmcnt(0)" ::: "memory");
            const unsigned og = xb_add(&bar[XB_TOP], 1u);
            const unsigned tg = og / nx;
            if (og + 1u == (tg + 1u) * nx) xb_add(&bar[XB_TOPGEN], 1u);
            else XB_SPIN(xb_ld(&bar[XB_TOPGEN]) == tg, bar);
            __builtin_amdgcn_fence(__ATOMIC_ACQUIRE, "agent");
            xb_add(&bar[XB_XGEN(b.x)], 1u);
            asm volatile("s_waitcnt vmcnt(0)" ::: "memory");
        } else {
            XB_SPIN(xb_ld(&bar[XB_XGEN(b.x)]) == gen, bar);
            __builtin_amdgcn_fence(__ATOMIC_ACQUIRE, "agent");
            asm volatile("s_waitcnt vmcnt(0)" ::: "memory");
        }
    }
    __syncthreads();
}
__device__ __forceinline__ float red8(float x) { x += dpp_f(x, 0); x += dpp_f(x, 1); x += dpp_f(x, 2); return x; }
__device__ __forceinline__ float red16(float x) { x = red8(x); x += dpp_f(x, 3); return x; }
__device__ __forceinline__ float red64(float x) { x = red16(x); x += __shfl_xor(x, 16); x += __shfl_xor(x, 32); return x; }

namespace pg8 {
constexpr int BM = 256, BK = 64, HALF = 128, HTB = HALF * BK * 2, STAGE_BYTES = 8 * HTB, NXCD = 8, WGM = 8;
__device__ __forceinline__ int lds_byte(int r, int c) { const int st = (r >> 4) * 2 + (c >> 5), rr = r & 15, cc = c & 31, ob = rr * 64 + cc * 2; return st * 1024 + (ob ^ (((ob >> 9) & 1) << 5)); }
__device__ __forceinline__ void stage_rc(int b, int& R, int& C) { const int st = b / 1024, sb = b % 1024, swz = sb ^ (((sb >> 9) & 1) << 5); R = (st >> 1) * 16 + swz / 64; C = (st & 1) * 32 + (swz % 64) / 2; }
__device__ __forceinline__ int perm32(int rho) { const int n = rho >> 4, i = rho & 15; return 8 * (i >> 2) + 4 * n + (i & 3); }
struct Unit { int pm, pn; };
struct Gemm { const bf16_t* A; const bf16_t* Bt; int M, N, K, lda, ldb, amode; };
__device__ __forceinline__ size_t a_off_bytes(const Gemm& g, int pn) {
    switch (g.amode) {
        case 1: return (size_t)(pn >> 1) * 256 * 2;
        case 2: return (size_t)pn * 512 * 2;
        case 3: return (size_t)(pn < 16 ? (pn >> 3) : (pn - 14)) * ((size_t)T_ * D_ * 2);
        case 4: return (size_t)(pn >> 3) * ((size_t)T_ * 256 * 2);
        default: return 0;
    }
}
struct StaticOrder {
    int nM, nN, nwg, G, c;
    __device__ void init(int M, int N, int G_, int c_) { nM = M / BM; nN = N / BM; nwg = nM * nN; G = G_; c = c_; }
    __device__ bool next(int i, Unit& u) const {
        const long L = (long)i * G + c; if (L >= nwg) return false;
        int wgid = (int)L; { const int q = nwg / NXCD, r = nwg % NXCD, xcd = wgid % NXCD, off = wgid / NXCD; wgid = (xcd < r ? xcd * (q + 1) : r * (q + 1) + (xcd - r) * q) + off; }
        const int nig = WGM * nN, gid = wgid / nig, fm = gid * WGM, gsz = (nM - fm) < WGM ? (nM - fm) : WGM;
        u.pm = fm + ((wgid % nig) % gsz); u.pn = (wgid % nig) / gsz; return true;
    }
};

template <class Epi>
__device__ __forceinline__ void gemm_phase(LAS unsigned char* lds, const Gemm g, const StaticOrder& S, const Epi& E) {
    const int tid = otid(), wid = __builtin_amdgcn_readfirstlane(tid >> 6), lane = tid & 63, wr = wid >> 2, wc = wid & 3, fr = lane & 15, fq = lane >> 4;
    const int K = g.K, nt = K / BK;
    unsigned voffA[2], voffB[2];
#pragma unroll
    for (int i = 0; i < 2; ++i) { int R, C; stage_rc(tid * 16 + i * 8192, R, C); const int Rb = (R & ~31) + perm32(R & 31);
        voffA[i] = (unsigned)(R * g.lda + C) * 2u; voffB[i] = (unsigned)(Rb * g.ldb + C) * 2u; }
    const size_t kstep = (size_t)(BK * 2);
    const size_t hstepA = (size_t)HALF * g.lda * 2, hstepB = (size_t)HALF * g.ldb * 2;
    const size_t tstepA = 2 * hstepA, tstepB = 2 * hstepB;
    const unsigned ldsw = (unsigned)wid * 1024u;
    const int aoff = lds_byte(wr * 64 + fr, fq * 8), boff = lds_byte(wc * 32 + fr, fq * 8);
#define PG8_SA(b, h) (((b) * 2 + (h)) * HTB)
#define PG8_SB(b, h) ((4 + (b) * 2 + (h)) * HTB)
#define PG8_STAGE(bufoff, gbase, voff) do { _Pragma("unroll") for (int _i = 0; _i < 2; ++_i) \
        __builtin_amdgcn_global_load_lds((const unsigned*)((const char*)(gbase) + (voff)[_i]), (LAS unsigned*)(lds + (bufoff) + ldsw + _i * 8192), 16, 0, 0); } while (0)
#define PG8_LDA(dst, b, h) do { _Pragma("unroll") for (int m = 0; m < 4; ++m) _Pragma("unroll") for (int k = 0; k < 2; ++k) dst[m][k] = *(const LAS bf16x8*)(lds + PG8_SA(b, h) + aoff + m * 2048 + k * 1024); } while (0)
#define PG8_LDB(dst, b, h) do { _Pragma("unroll") for (int n = 0; n < 2; ++n) _Pragma("unroll") for (int k = 0; k < 2; ++k) dst[n][k] = *(const LAS bf16x8*)(lds + PG8_SB(b, h) + boff + n * 2048 + k * 1024); } while (0)
#define PG8_MMA(ai, bj, At, Bt) do { __builtin_amdgcn_s_setprio(1); _Pragma("unroll") for (int m = 0; m < 4; ++m) _Pragma("unroll") for (int n = 0; n < 2; ++n) _Pragma("unroll") for (int k = 0; k < 2; ++k) \
        acc[ai][bj][m][n] = __builtin_amdgcn_mfma_f32_16x16x32_bf16(Bt[n][k], At[m][k], acc[ai][bj][m][n], 0, 0, 0); __builtin_amdgcn_s_setprio(0); } while (0)
#define PG8_WAIT_V(n) asm volatile("s_waitcnt vmcnt(" #n ")" ::: "memory")
#define PG8_WAIT_L(n) asm volatile("s_waitcnt lgkmcnt(" #n ")" ::: "memory")
#define PG8_BAR __builtin_amdgcn_s_barrier()
#define PG8_SCHED __builtin_amdgcn_sched_barrier(0)
    Unit cur, nxt; int ui = 0;
    if (!S.next(0, cur)) return;
    f32x4 acc[2][2][4][2];
#pragma unroll
    for (int a = 0; a < 2; ++a)
#pragma unroll
        for (int b = 0; b < 2; ++b)
#pragma unroll
            for (int m = 0; m < 4; ++m)
#pragma unroll
                for (int n = 0; n < 2; ++n) acc[a][b][m][n] = (f32x4){0.f, 0.f, 0.f, 0.f};
    bf16x8 At[4][2], B0[2][2], B1[2][2];
    const char* cA = (const char*)g.A + (size_t)cur.pm * tstepA + a_off_bytes(g, cur.pn); const char* cB = (const char*)g.Bt + (size_t)cur.pn * tstepB;
    PG8_STAGE(PG8_SB(0, 0), cB, voffB); PG8_STAGE(PG8_SA(0, 0), cA, voffA); PG8_STAGE(PG8_SB(0, 1), cB + hstepB, voffB); PG8_STAGE(PG8_SA(0, 1), cA + hstepA, voffA);
    if (wr == 1) PG8_BAR;
    PG8_WAIT_V(4); PG8_BAR;
    PG8_STAGE(PG8_SB(1, 0), cB + kstep, voffB); PG8_STAGE(PG8_SA(1, 0), cA + kstep, voffA); PG8_STAGE(PG8_SB(1, 1), cB + hstepB + kstep, voffB);
    PG8_WAIT_V(6); PG8_BAR;
    for (;;) {
        const bool has_next = S.next(ui + 1, nxt);
        const char* nA = has_next ? (const char*)g.A + (size_t)nxt.pm * tstepA + a_off_bytes(g, nxt.pn) : cA; const char* nB = has_next ? (const char*)g.Bt + (size_t)nxt.pn * tstepB : cB;
        for (int t = 0; t < nt; t += 2) {
            const bool last = (t == nt - 2);
            const char* a1 = cA + (size_t)(t + 1) * kstep;
            const char* a2 = last ? nA : cA + (size_t)(t + 2) * kstep; const char* b2 = last ? nB : cB + (size_t)(t + 2) * kstep;
            const char* a3 = a2 + kstep; const char* b3 = b2 + kstep;
            PG8_LDB(B0, 0, 0); PG8_SCHED; PG8_LDA(At, 0, 0); PG8_STAGE(PG8_SA(1, 1), a1 + hstepA, voffA);
            PG8_WAIT_L(8); PG8_BAR; PG8_WAIT_L(0); PG8_MMA(0, 0, At, B0); PG8_BAR; PG8_SCHED;
            PG8_LDB(B1, 0, 1); PG8_STAGE(PG8_SB(0, 0), b2, voffB);
            PG8_BAR; PG8_WAIT_L(0); PG8_MMA(0, 1, At, B1); PG8_BAR;
            PG8_LDA(At, 0, 1); PG8_STAGE(PG8_SA(0, 0), a2, voffA);
            PG8_BAR; PG8_WAIT_L(0); PG8_MMA(1, 0, At, B0); PG8_BAR; PG8_SCHED;
            PG8_STAGE(PG8_SB(0, 1), b2 + hstepB, voffB);
            PG8_WAIT_V(6); PG8_BAR; PG8_MMA(1, 1, At, B1); PG8_BAR;
            PG8_LDB(B0, 1, 0); PG8_SCHED; PG8_LDA(At, 1, 0); PG8_STAGE(PG8_SA(0, 1), a2 + hstepA, voffA);
            PG8_WAIT_L(8); PG8_BAR; PG8_WAIT_L(0); PG8_MMA(0, 0, At, B0); PG8_BAR; PG8_SCHED;
            PG8_LDB(B1, 1, 1); PG8_STAGE(PG8_SB(1, 0), b3, voffB);
            PG8_BAR; PG8_WAIT_L(0); PG8_MMA(0, 1, At, B1); PG8_BAR;
            PG8_LDA(At, 1, 1); PG8_STAGE(PG8_SA(1, 0), a3, voffA);
            PG8_BAR; PG8_WAIT_L(0); PG8_MMA(1, 0, At, B0); PG8_BAR; PG8_SCHED;
            PG8_STAGE(PG8_SB(1, 1), b3 + hstepB, voffB);
            PG8_WAIT_V(6); PG8_BAR; PG8_MMA(1, 1, At, B1); PG8_BAR;
        }
        E(acc, cur, wr, wc, fr, fq);
        if (!has_next) break;
#pragma unroll
        for (int a = 0; a < 2; ++a)
#pragma unroll
            for (int b = 0; b < 2; ++b)
#pragma unroll
                for (int m = 0; m < 4; ++m)
#pragma unroll
                    for (int n = 0; n < 2; ++n) acc[a][b][m][n] = (f32x4){0.f, 0.f, 0.f, 0.f};
        cur = nxt; cA = nA; cB = nB; ++ui;
    }
    PG8_WAIT_V(0);
    if (wr == 0) PG8_BAR;
    PG8_BAR;
#undef PG8_SA
#undef PG8_SB
#undef PG8_STAGE
#undef PG8_LDA
#undef PG8_LDB
#undef PG8_MMA
#undef PG8_WAIT_V
#undef PG8_WAIT_L
#undef PG8_BAR
#undef PG8_SCHED
}
}

enum { M_F32 = 0, M_BF16 = 1, M_QROPE = 2, M_RESID = 3, M_RELU2 = 4, M_L1A = 5, M_L1B = 6 };
__device__ __forceinline__ float sigmoidf_(float x) { return 1.f / (1.f + __expf(-x)); }
__device__ __forceinline__ float tanhf_(float x) { const float e = __expf(-2.f * fabsf(x)); const float t = (1.f - e) / (1.f + e); return x < 0.f ? -t : t; }
__device__ __forceinline__ void st_bf16x8(bf16_t* p, const f32x4& a, const f32x4& b) {
    u32x4 o; o[0] = cvt_pk_bf16(a[0], a[1]); o[1] = cvt_pk_bf16(a[2], a[3]); o[2] = cvt_pk_bf16(b[0], b[1]); o[3] = cvt_pk_bf16(b[2], b[3]); *(u32x4*)p = o;
}
template <int MODE> struct Epi {
    void* o0; void* o1; void* o2; void* o3; void* o4; const float* f0; const float* f1; const float* f2; const float* f3; int ldc;
    __device__ __forceinline__ void operator()(const f32x4 (&acc)[2][2][4][2], const pg8::Unit& u, int wr, int wc, int fr, int fq) const {
        const int row0 = u.pm * 256 + wr * 64 + fr, colb = u.pn * 256 + wc * 32 + 8 * fq;
        if constexpr (MODE == M_RESID) {
            const int b = (u.pm * 256) >> 11;
            f32x4 gt[2][2];
#pragma unroll
            for (int bj = 0; bj < 2; ++bj) { const float* gp = f1 + (size_t)b * 12288 + colb + bj * 128; gt[bj][0] = *(const f32x4*)gp; gt[bj][1] = *(const f32x4*)(gp + 4); }
#pragma unroll
            for (int ai = 0; ai < 2; ++ai) {
                f32x4 xv[4][2][2];
#pragma unroll
                for (int m = 0; m < 4; ++m)
#pragma unroll
                    for (int bj = 0; bj < 2; ++bj) { const float* xin = f0 + (size_t)(row0 + ai * 128 + m * 16) * D_ + colb + bj * 128; xv[m][bj][0] = *(const f32x4*)xin; xv[m][bj][1] = *(const f32x4*)(xin + 4); }
                asm volatile("" ::: "memory");
#pragma unroll
                for (int m = 0; m < 4; ++m)
#pragma unroll
                    for (int bj = 0; bj < 2; ++bj) { float* dst = (float*)o0 + (size_t)(row0 + ai * 128 + m * 16) * D_ + colb + bj * 128;
                        *(f32x4*)dst = xv[m][bj][0] + gt[bj][0] * acc[ai][bj][m][0]; *(f32x4*)(dst + 4) = xv[m][bj][1] + gt[bj][1] * acc[ai][bj][m][1]; }
                asm volatile("" ::: "memory");
            }
            return;
        }
        if constexpr (MODE == M_QROPE) {
            const bool isq = u.pn < 12; const int gpar = wc & 1;
            if (u.pn >= 8 && (isq || gpar == 0)) {
#pragma unroll
                for (int ai = 0; ai < 2; ++ai) {
                    f32x4 cv[4], sn[4];
#pragma unroll
                    for (int m = 0; m < 4; ++m) { const int row = row0 + ai * 128 + m * 16;
                        cv[m] = *(const f32x4*)(isq ? f0 + (size_t)row * 32 + gpar * 16 + 4 * fq : f2 + (size_t)row * 16 + 4 * fq);
                        sn[m] = *(const f32x4*)(isq ? f1 + (size_t)row * 32 + gpar * 16 + 4 * fq : f3 + (size_t)row * 16 + 4 * fq); }
                    asm volatile("" ::: "memory");
#pragma unroll
                    for (int m = 0; m < 4; ++m)
#pragma unroll
                        for (int bj = 0; bj < 2; ++bj) { const f32x4 v0 = acc[ai][bj][m][0], v1 = acc[ai][bj][m][1];
                            st_bf16x8((bf16_t*)o0 + (size_t)(row0 + ai * 128 + m * 16) * ldc + colb + bj * 128, v0 * cv[m] - v1 * sn[m], v1 * cv[m] + v0 * sn[m]); }
                    asm volatile("" ::: "memory");
                }
                return;
            }
        }
#pragma unroll
        for (int ai = 0; ai < 2; ++ai)
#pragma unroll
            for (int m = 0; m < 4; ++m) {
                const int row = row0 + ai * 128 + m * 16;
#pragma unroll
                for (int bj = 0; bj < 2; ++bj) {
                    const int col = colb + bj * 128;
                    f32x4 v0 = acc[ai][bj][m][0], v1 = acc[ai][bj][m][1];
                    if constexpr (MODE == M_F32) {
                        float* dst = (float*)o0 + (size_t)row * ldc + col; *(f32x4*)dst = v0; *(f32x4*)(dst + 4) = v1;
                    } else if constexpr (MODE == M_BF16) {
                        st_bf16x8((bf16_t*)o0 + (size_t)row * ldc + col, v0, v1);
                    } else if constexpr (MODE == M_QROPE) {
                        if (u.pn >= 8) {
                            const bool isq = u.pn < 12; const int gpar = wc & 1;
                            if (isq || gpar == 0) {
                                const float* ct = isq ? f0 + (size_t)row * 32 + gpar * 16 + 4 * fq : f2 + (size_t)row * 16 + 4 * fq;
                                const float* st = isq ? f1 + (size_t)row * 32 + gpar * 16 + 4 * fq : f3 + (size_t)row * 16 + 4 * fq;
                                const f32x4 c = *(const f32x4*)ct, s = *(const f32x4*)st;
                                const f32x4 a = v0 * c - v1 * s, b = v1 * c + v0 * s; v0 = a; v1 = b;
                            }
                        }
                        st_bf16x8((bf16_t*)o0 + (size_t)row * ldc + col, v0, v1);
                    } else if constexpr (MODE == M_RESID) {
                        const int b = row >> 11;
                        const float* gp = f1 + (size_t)b * 12288 + col; const float* xin = f0 + (size_t)row * D_ + col;
                        const f32x4 g0 = *(const f32x4*)gp, g1 = *(const f32x4*)(gp + 4), x0 = *(const f32x4*)xin, x1 = *(const f32x4*)(xin + 4);
                        float* dst = (float*)o0 + (size_t)row * D_ + col; *(f32x4*)dst = x0 + g0 * v0; *(f32x4*)(dst + 4) = x1 + g1 * v1;
                    } else if constexpr (MODE == M_RELU2) {
#pragma unroll
                        for (int i = 0; i < 4; ++i) { float a = fmaxf(v0[i], 0.f), b = fmaxf(v1[i], 0.f); v0[i] = a * a; v1[i] = b * b; }
                        st_bf16x8((bf16_t*)o0 + (size_t)row * ldc + col, v0, v1);
                    } else if constexpr (MODE == M_L1A) {
                        if (u.pn < 16) { bf16_t* base = (bf16_t*)(u.pn < 8 ? o0 : o1); st_bf16x8(base + (size_t)row * D_ + (col & 2047), v0, v1); }
                        else {
                            bf16_t* base = (bf16_t*)(u.pn == 16 ? o2 : (u.pn == 17 ? o3 : o4));
                            if (u.pn == 16) {
#pragma unroll
                                for (int i = 0; i < 4; ++i) { v0[i] = tanhf_(v0[i]); v1[i] = tanhf_(v1[i]); }
                            } else if (u.pn == 18) {
#pragma unroll
                                for (int i = 0; i < 4; ++i) { v0[i] = sigmoidf_(v0[i]); v1[i] = sigmoidf_(v1[i]); }
                            }
                            st_bf16x8(base + (size_t)row * 256 + (col & 255), v0, v1);
                        }
                    } else if constexpr (MODE == M_L1B) {
                        const int c = col & 2047;
                        if (u.pn < 8) { float* dst = (float*)o0 + (size_t)row * D_ + c; *(f32x4*)dst = v0; *(f32x4*)(dst + 4) = v1; }
                        else if (u.pn < 16) { st_bf16x8((bf16_t*)o1 + (size_t)row * D_ + c, v0, v1);
                        } else st_bf16x8((bf16_t*)o2 + (size_t)row * D_ + c, v0, v1);
                    }
                }
            }
    }
};
template <int MODE> __device__ __forceinline__ void run_gemm(int vbid, LAS unsigned char* lds, const void* A, int lda, const void* Bt, int ldb, int M, int N, int K, int amode, const Epi<MODE>& E) {
    pg8::Gemm g; g.A = (const bf16_t*)A; g.Bt = (const bf16_t*)Bt; g.M = M; g.N = N; g.K = K; g.lda = lda; g.ldb = ldb; g.amode = amode;
    pg8::StaticOrder S; S.init(M, N, ogrid(), vbid);
    pg8::gemm_phase<Epi<MODE>>(lds, g, S, E);
}

__device__ __forceinline__ void p0_mod(const Params& p, unsigned char* shm) {
    const int bid = obid(), nb = ogrid();
    if (bid >= 384) return;
    float* cact = (float*)shm; float* red = cact + 8 * 2048;
    const int tid = otid(), wid = tid >> 6, lane = tid & 63;
    for (int i = tid; i < 8 * 2048; i += 512) { const float v = p.in[1][i]; cact[i] = v / (1.f + __expf(-v)); }
    __syncthreads();
    float* mod = (float*)(p.ws + WS_MOD);
    for (int item = bid; item < 384; item += nb) {
        const int l = item / 192, c0 = (item % 192) * 64;
        const float* W = p.in[3] + (size_t)l * 2048 * 12288 + c0 + lane;
        float acc[8];
#pragma unroll
        for (int b = 0; b < 8; ++b) acc[b] = 0.f;
        const int k0 = wid * 256;
#pragma unroll 16
        for (int k = 0; k < 256; ++k) {
            const float wv = W[(size_t)(k0 + k) * 12288];
#pragma unroll
            for (int b = 0; b < 8; ++b) acc[b] += cact[b * 2048 + k0 + k] * wv;
        }
#pragma unroll
        for (int b = 0; b < 8; ++b) red[(wid * 8 + b) * 64 + lane] = acc[b];
        __syncthreads();
        { const int b = tid >> 6; float s = 0.f;
#pragma unroll
          for (int w = 0; w < 8; ++w) s += red[(w * 8 + b) * 64 + lane];
          mod[(size_t)(l * 8 + b) * 12288 + c0 + lane] = s + p.in[4][l * 12288 + c0 + lane]; }
        __syncthreads();
    }
}
__device__ __forceinline__ void p0_rope(const Params& p) {
    float* cosA = (float*)(p.ws + WS_COSA); float* sinA = (float*)(p.ws + WS_SINA); float* cosI = (float*)(p.ws + WS_COSI); float* sinI = (float*)(p.ws + WS_SINI);
    const int* pos = (const int*)p.in[2];
    const int nb_ = ogrid(); for (int i = obid() * 512 + otid(); i < T_ * 32; i += nb_ * 512) {
        const int t = i >> 5, f = i & 31; const float ps = (float)pos[t];
        { const float inv = 1.0f / powf(10000.f, (float)(2 * f) / 64.f); const float ang = ps * inv; const double a = (double)ang; const double k = rint(a * 0.15915494309189535);
          const float r = (float)(a - k * 6.283185307179586); cosA[i] = __cosf(r); sinA[i] = __sinf(r); }
        if (f < 16) { const float inv = 1.0f / powf(10000.f, (float)(2 * f) / 32.f); const float ang = ps * inv; const double a = (double)ang; const double k = rint(a * 0.15915494309189535);
          const float r = (float)(a - k * 6.283185307179586); cosI[t * 16 + f] = __cosf(r); sinI[t * 16 + f] = __sinf(r); }
    }
}
__device__ __forceinline__ int ropeperm(int j) { const int half = j >> 5, f = j & 31; return (f >> 4) * 32 + 8 * ((f & 15) >> 2) + 4 * half + (f & 3); }
__device__ __forceinline__ int idxperm(int j) { if (j >= 32) return j; const int half = j >> 4, f = j & 15; return 8 * (f >> 2) + 4 * half + (f & 3); }

struct Job { const float* src; bf16_t* dst; int modeC, sK, sN, skst, snst, dN, dK, dld, k0, nblk, kblk, rowmap; };
__device__ __forceinline__ Job mkjob(const float* src, void* dst, int sK, int sN, int skst, int dN, int dK) {
    Job J; J.src = src; J.dst = (bf16_t*)dst; J.modeC = 0; J.sK = sK; J.sN = sN; J.skst = skst; J.snst = 1; J.dN = dN; J.dK = dK; J.dld = dK; J.k0 = 0; J.nblk = 1 << 30; J.kblk = 0; J.rowmap = 0; return J;
}
constexpr int NJOBS_EARLY = 40, NJOBS_ALL = 42;
__device__ __forceinline__ Job get_job(const Params& p, int j) {
    unsigned char* ws = p.ws;
    if (j == 0) return mkjob(p.in[8], ws + WS_WT_IN, 2048, 912, 912, 1024, 2048);
    if (j == 1) { Job J = mkjob(p.in[11], ws + WS_WT_Q, 512, 3072, 3072, 3072, 512); J.rowmap = 1; return J; }
    if (j == 2) { Job J = mkjob(p.in[12], ws + WS_WT_Q, 512, 1024, 1024, 1024, 512); J.rowmap = 2; return J; }
    if (j < 19) { const int h = j - 3; Job J = mkjob(p.in[15] + h * 128, (bf16_t*)(ws + WS_WT_UK) + (size_t)h * 256 * 256, 128, 256, 1, 256, 256); J.modeC = 1; J.snst = 2048; J.k0 = (h & 1) * 128; return J; }
    if (j < 27) { const int hp = j - 19; Job J = mkjob(p.in[16] + hp * 256, (bf16_t*)(ws + WS_WT_UV) + (size_t)hp * 256 * 512, 256, 256, 2048, 256, 512); J.nblk = 128; J.kblk = 256; return J; }
    if (j == 27) return mkjob(p.in[17], ws + WS_WT_O, 2048, 2048, 2048, 2048, 2048);
    if (j == 28) return mkjob(p.in[5], ws + WS_WT_1_0, 2048, 8192, 8192, 8192, 2048);
    if (j == 29) return mkjob(p.in[6], ws + WS_WT_2_0, 8192, 2048, 2048, 2048, 8192);
    if (j == 30) return mkjob(p.in[19], (bf16_t*)(ws + WS_WT_RKV), 2048, 2048, 2048, 2048, 2048);
    if (j == 31) return mkjob(p.in[20], (bf16_t*)(ws + WS_WT_RKV) + (size_t)2048 * 2048, 2048, 2048, 2048, 2048, 2048);
    if (j == 32) return mkjob(p.in[21], (bf16_t*)(ws + WS_WT_RKV) + (size_t)4096 * 2048, 2048, 2048, 2048, 2048, 2048);
    if (j == 33) return mkjob(p.in[24], (bf16_t*)(ws + WS_WT_RKV) + (size_t)6144 * 2048, 2048, 96, 96, 256, 2048);
    if (j == 34) return mkjob(p.in[27], (bf16_t*)(ws + WS_WT_RKV) + (size_t)6400 * 2048, 2048, 96, 96, 256, 2048);
    if (j == 35) return mkjob(p.in[29], (bf16_t*)(ws + WS_WT_RKV) + (size_t)6656 * 2048, 2048, 256, 256, 256, 2048);
    if (j == 36) return mkjob(p.in[25], (bf16_t*)(ws + WS_WT_L2), 96, 2048, 2048, 2048, 256);
    if (j == 37) return mkjob(p.in[28], (bf16_t*)(ws + WS_WT_L2) + (size_t)2048 * 256, 96, 2048, 2048, 2048, 256);
    if (j == 38) return mkjob(p.in[30], (bf16_t*)(ws + WS_WT_L2) + (size_t)4096 * 256, 256, 2048, 2048, 2048, 256);
    if (j == 39) return mkjob(p.in[22], ws + WS_WT_BO, 2048, 2048, 2048, 2048, 2048);
    if (j == 40) return mkjob(p.in[5] + (size_t)2048 * 8192, ws + WS_WT_1_1, 2048, 8192, 8192, 8192, 2048);
    return mkjob(p.in[6] + (size_t)8192 * 2048, ws + WS_WT_2_1, 8192, 2048, 2048, 2048, 8192);
}
__device__ __forceinline__ int job_rowmap(const Job& J, int n) {
    if (J.rowmap == 1) { const int h = n / 192, d = n % 192; return d < 128 ? h * 128 + d : 2048 + h * 64 + ropeperm(d - 128); }
    if (J.rowmap == 2) { const int h = n >> 6, jj = n & 63; return 3072 + h * 64 + idxperm(jj); }
    return n;
}
__device__ __forceinline__ void conv_decode(const Params& p, int jlo, int ti, Job& J, int& n0, int& k0t, const volatile int* jtab) {
    int j = jlo; while (ti >= jtab[j + 1]) ++j;
    const int rem = ti - jtab[j]; J = get_job(p, j);
    const int nnt = J.dN >> 8; k0t = (rem / nnt) * 64; n0 = (rem % nnt) * 256;
}
__device__ __forceinline__ void conv_load(const Job& J, int n0, int k0t, int tid, f32x4 (&R)[8]) {
    if (!J.modeC) {
#pragma unroll
        for (int i = 0; i < 8; ++i) {
            const int kr = (tid >> 6) + 8 * i, n = n0 + (tid & 63) * 4; const int kk = k0t + kr - (J.k0 + (n / J.nblk) * J.kblk);
            R[i] = (f32x4){0.f, 0.f, 0.f, 0.f};
            if (n < J.sN && kk >= 0 && kk < J.sK) R[i] = *(const f32x4*)(J.src + (size_t)kk * J.skst + n);
        }
    } else {
#pragma unroll
        for (int i = 0; i < 4; ++i) {
            const int n = (tid >> 3) + 64 * i, k8 = (tid & 7) * 8; const int kk = k0t + k8 - J.k0;
            R[2 * i] = (f32x4){0.f, 0.f, 0.f, 0.f}; R[2 * i + 1] = R[2 * i];
            if (n0 + n < J.sN && kk >= 0 && kk + 7 < J.sK) { const float* sp = J.src + (size_t)(n0 + n) * J.snst + kk; R[2 * i] = *(const f32x4*)sp; R[2 * i + 1] = *(const f32x4*)(sp + 4); }
        }
    }
}
__device__ __forceinline__ void convert_jobs(const Params& p, unsigned char* shm, int jlo, int jhi, unsigned* ctr) {
    float* tile = (float*)shm;
    volatile int* nextp = (volatile int*)(shm + 66048);
    const int tid = otid();
    volatile int* jtab = (volatile int*)(shm + 66112);
    __syncthreads();
    if (tid == 0) { int acc = 0; for (int j = jlo; j < jhi; ++j) { jtab[j] = acc; const Job Jt = get_job(p, j); acc += (Jt.dN >> 8) * (Jt.dK >> 6); } jtab[jhi] = acc; }
    __syncthreads();
    const int total = jtab[jhi];
    if (tid == 0) *nextp = (int)__hip_atomic_fetch_add(ctr, 1u, __ATOMIC_RELAXED, __HIP_MEMORY_SCOPE_AGENT);
    __syncthreads();
    int ti = *nextp;
    Job J; int n0 = 0, k0t = 0; f32x4 R[8];
    if (ti < total) { conv_decode(p, jlo, ti, J, n0, k0t, jtab); conv_load(J, n0, k0t, tid, R); }
    while (ti < total) {
        if (!J.modeC) {
#pragma unroll
            for (int i = 0; i < 8; ++i) { const int kr = (tid >> 6) + 8 * i, n4 = (tid & 63) * 4; float* d = tile + kr * 257 + n4; d[0] = R[i][0]; d[1] = R[i][1]; d[2] = R[i][2]; d[3] = R[i][3]; }
        } else {
#pragma unroll
            for (int i = 0; i < 4; ++i) { const int n = (tid >> 3) + 64 * i, k8 = (tid & 7) * 8;
#pragma unroll
                for (int e = 0; e < 4; ++e) { tile[(k8 + e) * 257 + n] = R[2 * i][e]; tile[(k8 + 4 + e) * 257 + n] = R[2 * i + 1][e]; } }
        }
        if (tid == 0) *nextp = (int)__hip_atomic_fetch_add(ctr, 1u, __ATOMIC_RELAXED, __HIP_MEMORY_SCOPE_AGENT);
        __syncthreads();
        const int tnx = *nextp;
        const Job Jc = J; const int n0c = n0, k0c = k0t;
        if (tnx < total) { conv_decode(p, jlo, tnx, J, n0, k0t, jtab); conv_load(J, n0, k0t, tid, R); }
#pragma unroll
        for (int i = 0; i < 4; ++i) {
            const int n = (tid >> 3) + 64 * i, k8 = (tid & 7) * 8;
            float v[8];
#pragma unroll
            for (int e = 0; e < 8; ++e) v[e] = tile[(k8 + e) * 257 + n];
            u32x4 o; o[0] = cvt_pk_bf16(v[0], v[1]); o[1] = cvt_pk_bf16(v[2], v[3]); o[2] = cvt_pk_bf16(v[4], v[5]); o[3] = cvt_pk_bf16(v[6], v[7]);
            *(u32x4*)(Jc.dst + (size_t)job_rowmap(Jc, n0c + n) * Jc.dld + k0c + k8) = o;
        }
        __syncthreads();
        ti = tnx;
    }
}

__device__ __forceinline__ void norm_phase(int vbx, const float* xin, const float* sh, const float* sc, bf16_t* outb, float* outf, const float* fg, unsigned char* shm) {
    const int tid_ = otid(); const int lane = tid_ & 63; const int gw = obid() * 8 + (tid_ >> 6), nw = ogrid() * 8; (void)vbx;
    float* lsc = (float*)shm; float* lsh = lsc + 8 * 2048;
    __syncthreads();
    if (outf) {
        *(f32x4*)(lsc + tid_ * 4) = *(const f32x4*)(fg + tid_ * 4);
    } else {
#pragma unroll
        for (int i = 0; i < 8; ++i) { const int idx = tid_ + 512 * i, bb = idx >> 9, c4 = (idx & 511) * 4;
            *(f32x4*)(lsc + bb * 2048 + c4) = *(const f32x4*)(sc + (size_t)bb * 12288 + c4); *(f32x4*)(lsh + bb * 2048 + c4) = *(const f32x4*)(sh + (size_t)bb * 12288 + c4); }
    }
    __syncthreads();
    for (int row = gw; row < T_; row += nw) {
        const float* xr = xin + (size_t)row * D_; const int b = row >> 11;
        f32x4 v[8]; float ss = 0.f;
#pragma unroll
        for (int j = 0; j < 8; ++j) { v[j] = *(const f32x4*)(xr + (lane + 64 * j) * 4); ss += v[j][0] * v[j][0] + v[j][1] * v[j][1] + v[j][2] * v[j][2] + v[j][3] * v[j][3]; }
        ss = red64(ss); const float rstd = rsqrtf(ss * (1.f / D_) + 1e-6f);
#pragma unroll
        for (int j = 0; j < 8; ++j) {
            const int c = (lane + 64 * j) * 4;
            if (outf) { const f32x4 g = *(const f32x4*)(lsc + c); *(f32x4*)(outf + (size_t)row * D_ + c) = v[j] * rstd * g; }
            else { const f32x4 s1 = *(const f32x4*)(lsc + b * 2048 + c), s0 = *(const f32x4*)(lsh + b * 2048 + c);
                const f32x4 o = v[j] * rstd * (s1 + 1.f) + s0; u32x2 pk; pk[0] = cvt_pk_bf16(o[0], o[1]); pk[1] = cvt_pk_bf16(o[2], o[3]); *(u32x2*)(outb + (size_t)row * D_ + c) = pk; }
        }
    }
}
__device__ __forceinline__ void mix_phase(const Params& p, const float* xin, const float* sh, const float* sc, unsigned char* shm) {
    const int tid_ = otid(); const int lane = tid_ & 63; const int gw = obid() * 8 + (tid_ >> 6), nw = ogrid() * 8;
    bf16_t* mix = (bf16_t*)(p.ws + WS_MIX); const float* mu = p.in[18];
    float* lmu = (float*)shm;
    __syncthreads();
#pragma unroll
    for (int i = 0; i < 6; ++i) *(f32x4*)(lmu + (tid_ + 512 * i) * 4) = *(const f32x4*)(mu + (tid_ + 512 * i) * 4);
    __syncthreads();
    for (int r0 = gw * 8; r0 < T_; r0 += nw * 8) {
        const int b = r0 >> 11;
        f32x4 hp[8];
        for (int rr = -1; rr < 8; ++rr) {
            const int row = r0 + rr;
            f32x4 h[8];
            if (rr < 0 && (r0 & 2047) == 0) {
#pragma unroll
                for (int j = 0; j < 8; ++j) h[j] = (f32x4){0.f, 0.f, 0.f, 0.f};
            } else {
                const float* xr = xin + (size_t)row * D_; float ss = 0.f;
#pragma unroll
                for (int j = 0; j < 8; ++j) { h[j] = *(const f32x4*)(xr + (lane + 64 * j) * 4); ss += h[j][0] * h[j][0] + h[j][1] * h[j][1] + h[j][2] * h[j][2] + h[j][3] * h[j][3]; }
                ss = red64(ss); const float rstd = rsqrtf(ss * (1.f / D_) + 1e-6f);
#pragma unroll
                for (int j = 0; j < 8; ++j) { const int c = (lane + 64 * j) * 4; const f32x4 s1 = *(const f32x4*)(sc + (size_t)b * 12288 + c), s0 = *(const f32x4*)(sh + (size_t)b * 12288 + c); h[j] = h[j] * rstd * (s1 + 1.f) + s0; }
            }
            if (rr >= 0) {
#pragma unroll 1
                for (int q = 0; q < 6; ++q) {
                    const int mq = (q == 1) ? 2 : (q == 2) ? 3 : (q == 3) ? 1 : q;
                    f32x4 m[8];
#pragma unroll
                    for (int j = 0; j < 8; ++j) m[j] = *(const f32x4*)(lmu + mq * D_ + (lane + 64 * j) * 4);
#pragma unroll
                    for (int j = 0; j < 8; ++j) {
                        const int c = (lane + 64 * j) * 4; const f32x4 o = h[j] + (hp[j] - h[j]) * m[j]; u32x2 pk; pk[0] = cvt_pk_bf16(o[0], o[1]); pk[1] = cvt_pk_bf16(o[2], o[3]);
                        *(u32x2*)(mix + (size_t)q * T_ * D_ + (size_t)row * D_ + c) = pk;
                    }
                }
            }
#pragma unroll
            for (int j = 0; j < 8; ++j) hp[j] = h[j];
        }
    }
}
__device__ __forceinline__ void projrow_phase(const Params& p) {
    const int tid_ = otid(); const int lane = tid_ & 63; const int gw = obid() * 8 + (tid_ >> 6), nw = ogrid() * 8;
    const float* proj = (const float*)(p.ws + WS_PROJ); bf16_t* cq = (bf16_t*)(p.ws + WS_CQ); bf16_t* keys = (bf16_t*)(p.ws + WS_KEYS); bf16_t* kidx = (bf16_t*)(p.ws + WS_KIDX); float* widx = (float*)(p.ws + WS_WIDX);
    const float* cosA = (const float*)(p.ws + WS_COSA); const float* sinA = (const float*)(p.ws + WS_SINA); const float* cosI = (const float*)(p.ws + WS_COSI); const float* sinI = (const float*)(p.ws + WS_SINI);
    const float* qg = p.in[9]; const float* kvg = p.in[10]; const float* lng = p.in[13]; const float* lnb = p.in[14];
    for (int row = gw; row < T_; row += nw) {
        const float* pr = proj + (size_t)row * 1024;
        f32x4 v[4];
#pragma unroll
        for (int j = 0; j < 4; ++j) v[j] = *(const f32x4*)(pr + (lane + 64 * j) * 4);
        float sq = 0.f, skv = 0.f;
#pragma unroll
        for (int e = 0; e < 4; ++e) { sq += v[0][e] * v[0][e] + v[1][e] * v[1][e]; skv += v[2][e] * v[2][e]; }
        sq = red64(sq); skv = red64(skv);
        const float rq = rsqrtf(sq * (1.f / 512.f) + 1e-6f), rkv = rsqrtf(skv * (1.f / 256.f) + 1e-6f);
#pragma unroll
        for (int j = 0; j < 2; ++j) { const int c = (lane + 64 * j) * 4; const f32x4 g = *(const f32x4*)(qg + c); const f32x4 o = v[j] * rq * g; u32x2 pk; pk[0] = cvt_pk_bf16(o[0], o[1]); pk[1] = cvt_pk_bf16(o[2], o[3]); *(u32x2*)(cq + (size_t)row * 512 + c) = pk; }
        { const int c = lane * 4; const f32x4 g = *(const f32x4*)(kvg + c); const f32x4 o = v[2] * rkv * g; u32x2 pk; pk[0] = cvt_pk_bf16(o[0], o[1]); pk[1] = cvt_pk_bf16(o[2], o[3]); *(u32x2*)(keys + (size_t)row * 320 + c) = pk; }
        f32x4 x = v[3];
        float s1 = x[0] + x[1] + x[2] + x[3]; s1 = red16(s1); const float mean = s1 * (1.f / 64.f);
        f32x4 xc = x - mean; float s2 = xc[0] * xc[0] + xc[1] * xc[1] + xc[2] * xc[2] + xc[3] * xc[3]; s2 = red16(s2); const float rs = rsqrtf(s2 * (1.f / 64.f) + 1e-6f);
        f32x4 y = x;
        if (lane >= 16 && lane < 32) { const int jj = (lane - 16) * 4; const f32x4 g = *(const f32x4*)(lng + jj), bb = *(const f32x4*)(lnb + jj); y = xc * rs * g + bb; }
        f32x4 part8, part4;
#pragma unroll
        for (int e = 0; e < 4; ++e) { part8[e] = __shfl_xor(y[e], 8); part4[e] = __shfl_xor(y[e], 4); }
        if (lane < 16) {
            const int l2 = lane & 7; const f32x4 c = *(const f32x4*)(cosA + (size_t)row * 32 + 4 * l2), s = *(const f32x4*)(sinA + (size_t)row * 32 + 4 * l2);
            f32x4 o; if (lane < 8) o = y * c - part8 * s; else o = y * c + part8 * s;
            const int pphys = (l2 >> 2) * 32 + 8 * (l2 & 3) + (lane < 8 ? 0 : 4);
            u32x2 pk; pk[0] = cvt_pk_bf16(o[0], o[1]); pk[1] = cvt_pk_bf16(o[2], o[3]); *(u32x2*)(keys + (size_t)row * 320 + 256 + pphys) = pk;
        } else if (lane < 32) {
            const int ll = lane - 16; f32x4 o = y; int pphys = ll * 4;
            if (ll < 8) { const int l2 = ll & 3; const f32x4 c = *(const f32x4*)(cosI + (size_t)row * 16 + 4 * l2), s = *(const f32x4*)(sinI + (size_t)row * 16 + 4 * l2);
                if (ll < 4) o = y * c - part4 * s; else o = y * c + part4 * s; pphys = 8 * l2 + (ll < 4 ? 0 : 4); }
            u32x2 pk; pk[0] = cvt_pk_bf16(o[0], o[1]); pk[1] = cvt_pk_bf16(o[2], o[3]); *(u32x2*)(kidx + (size_t)row * 64 + pphys) = pk;
        } else if (lane < 36) {
            *(f32x4*)(widx + (size_t)row * 16 + (lane - 32) * 4) = x * (1.f / 32.f);
        }
    }
}

__device__ __forceinline__ void score_phase(const Params& p, int vbx) {
    const int tid_ = otid(); const int lane = tid_ & 63, l32 = lane & 31, hh = lane >> 5; const int gw = obid() * 8 + (tid_ >> 6), nw = ogrid() * 8;
    const bf16_t* qall = (const bf16_t*)(p.ws + WS_QALL); const bf16_t* kidx = (const bf16_t*)(p.ws + WS_KIDX); const float* widx = (const float*)(p.ws + WS_WIDX); float* scores = (float*)(p.ws + WS_SCORES);
    const int xb_ = vbx >> 5;
    unsigned* sctr = (unsigned*)(p.ws + WS_BAR) + 48 + 16 * (xb_ & 7);
    for (;;) {
        int tile = 0; if (lane == 0) tile = (int)__hip_atomic_fetch_add(sctr, 1u, __ATOMIC_RELAXED, __HIP_MEMORY_SCOPE_AGENT);
        tile = __builtin_amdgcn_readfirstlane(tile); if (tile >= 528) break;
        const int b = xb_ & 7, L = 527 - tile;
        int qc = (int)((sqrtf(8.f * (float)L + 1.f) - 1.f) * 0.5f); while ((qc + 1) * (qc + 2) / 2 <= L) ++qc; while (qc * (qc + 1) / 2 > L) --qc;
        const int kt = L - qc * (qc + 1) / 2;
        const int t0 = b * S_ + qc * 64, key0 = b * S_ + kt * 64;
        bf16x8 kf[2][4];
#pragma unroll
        for (int mt = 0; mt < 2; ++mt)
#pragma unroll
            for (int ks = 0; ks < 4; ++ks) kf[mt][ks] = *(const bf16x8*)(kidx + (size_t)(key0 + mt * 32 + l32) * 64 + ks * 16 + hh * 8);
        f32x16 sc[2][2];
#pragma unroll
        for (int mt = 0; mt < 2; ++mt)
#pragma unroll
            for (int nt = 0; nt < 2; ++nt)
#pragma unroll
                for (int i = 0; i < 16; ++i) sc[mt][nt][i] = 0.f;
        bf16x8 qn[2][4]; float wn[2];
#pragma unroll
        for (int nt = 0; nt < 2; ++nt) {
#pragma unroll
            for (int ks = 0; ks < 4; ++ks) qn[nt][ks] = *(const bf16x8*)(qall + (size_t)(t0 + nt * 32 + l32) * 4096 + 3072 + ks * 16 + hh * 8);
            wn[nt] = widx[(size_t)(t0 + nt * 32 + l32) * 16];
        }
        for (int h = 0; h < 16; ++h) {
            bf16x8 qf[2][4]; float w[2];
#pragma unroll
            for (int nt = 0; nt < 2; ++nt) {
#pragma unroll
                for (int ks = 0; ks < 4; ++ks) qf[nt][ks] = qn[nt][ks];
                w[nt] = wn[nt];
            }
            { const int h1 = (h + 1) & 15;
#pragma unroll
              for (int nt = 0; nt < 2; ++nt) {
#pragma unroll
                for (int ks = 0; ks < 4; ++ks) qn[nt][ks] = *(const bf16x8*)(qall + (size_t)(t0 + nt * 32 + l32) * 4096 + 3072 + h1 * 64 + ks * 16 + hh * 8);
                wn[nt] = widx[(size_t)(t0 + nt * 32 + l32) * 16 + h1];
              } }
#pragma unroll
            for (int mt = 0; mt < 2; ++mt)
#pragma unroll
                for (int nt = 0; nt < 2; ++nt) {
                    f32x16 a;
#pragma unroll
                    for (int i = 0; i < 16; ++i) a[i] = 0.f;
#pragma unroll
                    for (int ks = 0; ks < 4; ++ks) a = __builtin_amdgcn_mfma_f32_32x32x16_bf16(kf[mt][ks], qf[nt][ks], a, 0, 0, 0);
#pragma unroll
                    for (int i = 0; i < 16; ++i) sc[mt][nt][i] += w[nt] * fmaxf(a[i], 0.f);
                }
        }
#pragma unroll
        for (int mt = 0; mt < 2; ++mt)
#pragma unroll
            for (int nt = 0; nt < 2; ++nt)
#pragma unroll
                for (int q4 = 0; q4 < 4; ++q4) {
                    f32x4 o; o[0] = sc[mt][nt][q4 * 4]; o[1] = sc[mt][nt][q4 * 4 + 1]; o[2] = sc[mt][nt][q4 * 4 + 2]; o[3] = sc[mt][nt][q4 * 4 + 3];
                    *(f32x4*)(scores + (size_t)(t0 + nt * 32 + l32) * S_ + kt * 64 + mt * 32 + q4 * 8 + hh * 4) = o;
                }
    }
}
template <int NI> __device__ __forceinline__ void topk_select(const float* sr, unsigned short* srow, int qc, int lane, unsigned long long ltmask) {
    unsigned u[NI];
#pragma unroll
    for (int i = 0; i < NI; ++i) {
        unsigned bits = 0u;
        if (i <= qc) { bits = __float_as_uint(sr[i * 64 + lane]); bits = (bits & 0x80000000u) ? ~bits : (bits | 0x80000000u); if (bits == 0u) bits = 1u; }
        u[i] = bits;
    }
    unsigned thr = 0u;
    for (int bit = 31; bit >= 0; --bit) {
        const unsigned cand = thr | (1u << bit); int c = 0;
#pragma unroll
        for (int i = 0; i < NI; ++i) c += __popcll(__ballot(u[i] >= cand));
        if (c >= 256) { thr = cand; if (c == 256) break; }
    }
    int cgt = 0;
#pragma unroll
    for (int i = 0; i < NI; ++i) cgt += __popcll(__ballot(u[i] > thr));
    const int need = 256 - cgt; int eqtaken = 0, base = 0;
#pragma unroll
    for (int i = 0; i < NI; ++i) {
        const bool eq = (u[i] == thr); const unsigned long long em = __ballot(eq);
        const int rank = eqtaken + __popcll(em & ltmask);
        const bool take = (u[i] > thr) || (eq && rank < need);
        const unsigned long long tm = __ballot(take);
        if (take) srow[base + __popcll(tm & ltmask)] = (unsigned short)(i * 64 + lane);
        base += __popcll(tm); eqtaken += __popcll(em);
    }
}
__device__ __forceinline__ void topk_phase(const Params& p) {
    const int tid_ = otid(); const int lane = tid_ & 63; const int gw = obid() * 8 + (tid_ >> 6), nw = ogrid() * 8;
    const float* scores = (const float*)(p.ws + WS_SCORES); unsigned short* sel = (unsigned short*)(p.ws + WS_SEL); int* cnt = (int*)(p.ws + WS_CNT);
    const unsigned long long ltmask = (1ull << lane) - 1ull;
    for (int t0 = gw; t0 < T_; t0 += nw) {
        const int bq = t0 >> 11; const int t = (bq << 11) | (((t0 & 2047) + 261 * bq) & 2047);
        const int s = t & 2047, qc = s >> 6; const int nvalid = (qc + 1) * 64;
        unsigned short* srow = sel + (size_t)t * 256;
        if (nvalid <= 256) {
#pragma unroll
            for (int i = 0; i < 4; ++i) { const int k = i * 64 + lane; srow[k] = (unsigned short)(k < nvalid ? k : 0); }
            if (lane == 0) cnt[t] = nvalid;
            continue;
        }
        const float* sr = scores + (size_t)t * S_;
        if (qc < 8) topk_select<8>(sr, srow, qc, lane, ltmask);
        else if (qc < 16) topk_select<16>(sr, srow, qc, lane, ltmask);
        else if (qc < 24) topk_select<24>(sr, srow, qc, lane, ltmask);
        else topk_select<32>(sr, srow, qc, lane, ltmask);
        if (lane == 0) cnt[t] = 256;
    }
}


constexpr int SROW = 2052;
__device__ __forceinline__ void scoretopk_phase(const Params& p, unsigned char* shm, int vbx) {
    float* scl = (float*)shm;
    volatile int* nextp = (volatile int*)(shm + 16 * SROW * 4);
    const int tid = otid(); const int wid = tid >> 6, lane = tid & 63, l16 = lane & 15, g = lane >> 4;
    const bf16_t* qall = (const bf16_t*)(p.ws + WS_QALL); const bf16_t* kidx = (const bf16_t*)(p.ws + WS_KIDX); const float* widx = (const float*)(p.ws + WS_WIDX);
    unsigned short* sel = (unsigned short*)(p.ws + WS_SEL); int* cnt = (int*)(p.ws + WS_CNT);
    const unsigned long long ltmask = (1ull << lane) - 1ull;
    for (int bi = 0; bi < 8; ++bi) {
    const int b = ((vbx >> 5) + bi) & 7;
    unsigned* sctr = (unsigned*)(p.ws + WS_BAR) + 48 + 16 * b;
    for (;;) {
        __syncthreads();
        if (tid == 0) *nextp = (int)__hip_atomic_fetch_add(sctr, 1u, __ATOMIC_RELAXED, __HIP_MEMORY_SCOPE_AGENT);
        __syncthreads();
        const int task = *nextp; if (task >= 128) break;
        const int qg = 127 - task; const int t0 = b * S_ + qg * 16; const int qc = qg >> 2; const int nvalid = (qc + 1) * 64;
        if (nvalid <= 256) {
#pragma unroll
            for (int qq = 0; qq < 2; ++qq) {
                const int t = t0 + 2 * wid + qq; unsigned short* srow = sel + (size_t)t * 256;
#pragma unroll
                for (int i = 0; i < 4; ++i) { const int k = i * 64 + lane; srow[k] = (unsigned short)(k < nvalid ? k : 0); }
                if (lane == 0) cnt[t] = nvalid;
            }
            continue;
        }
#pragma unroll 1
        for (int hp = 0; hp < 2; ++hp) {
            bf16x8 qf[8][2]; float w[8];
#pragma unroll
            for (int h = 0; h < 8; ++h) {
#pragma unroll
                for (int ks = 0; ks < 2; ++ks) qf[h][ks] = *(const bf16x8*)(qall + (size_t)(t0 + l16) * 4096 + 3072 + (hp * 8 + h) * 64 + ks * 32 + g * 8);
            }
#pragma unroll
            for (int h4 = 0; h4 < 2; ++h4) { const f32x4 wv = *(const f32x4*)(widx + (size_t)(t0 + l16) * 16 + hp * 8 + h4 * 4); w[h4 * 4] = wv[0]; w[h4 * 4 + 1] = wv[1]; w[h4 * 4 + 2] = wv[2]; w[h4 * 4 + 3] = wv[3]; }
            const int nkt = nvalid >> 4;
            const bf16_t* kr0 = kidx + (size_t)(b * S_ + l16) * 64 + g * 8;
            bf16x8 k0n = *(const bf16x8*)(kr0 + (size_t)wid * 1024), k1n = *(const bf16x8*)(kr0 + (size_t)wid * 1024 + 32);
            for (int kt = wid; kt < nkt; kt += 8) {
                const bf16x8 k0 = k0n, k1 = k1n;
                { const int ktn = (kt + 8 < nkt) ? kt + 8 : kt; k0n = *(const bf16x8*)(kr0 + (size_t)ktn * 1024); k1n = *(const bf16x8*)(kr0 + (size_t)ktn * 1024 + 32); }
                float* dst = scl + l16 * SROW + kt * 16 + g * 4;
                f32x4 sacc = (f32x4){0.f, 0.f, 0.f, 0.f};
                if (hp) sacc = *(const f32x4*)dst;
#pragma unroll
                for (int h = 0; h < 8; ++h) {
                    f32x4 a = (f32x4){0.f, 0.f, 0.f, 0.f};
                    a = __builtin_amdgcn_mfma_f32_16x16x32_bf16(k0, qf[h][0], a, 0, 0, 0);
                    a = __builtin_amdgcn_mfma_f32_16x16x32_bf16(k1, qf[h][1], a, 0, 0, 0);
#pragma unroll
                    for (int i = 0; i < 4; ++i) sacc[i] += w[h] * fmaxf(a[i], 0.f);
                }
                *(f32x4*)dst = sacc;
            }
        }
        __syncthreads();
#pragma unroll 1
        for (int qq = 0; qq < 2; ++qq) {
            const int q = 2 * wid + qq; const int t = t0 + q; unsigned short* srow = sel + (size_t)t * 256; const float* sr = scl + q * SROW;
            if (qc < 8) topk_select<8>(sr, srow, qc, lane, ltmask);
            else if (qc < 16) topk_select<16>(sr, srow, qc, lane, ltmask);
            else if (qc < 24) topk_select<24>(sr, srow, qc, lane, ltmask);
            else topk_select<32>(sr, srow, qc, lane, ltmask);
            if (lane == 0) cnt[t] = 256;
        }
    }
    }
}
typedef short bf16x4v __attribute__((ext_vector_type(4)));
constexpr int ABUF_BYTES = 8 * 1024, AWAVE = 2 * ABUF_BYTES;
__device__ __forceinline__ void attn_phase(const Params& p, LAS unsigned char* lds, int vbx) {
    const int tid_ = otid(); const int wid = __builtin_amdgcn_readfirstlane(tid_ >> 6), lane = tid_ & 63, l16 = lane & 15, g = lane >> 4;
    const int gw = vbx * 8 + wid, nw = ogrid() * 8;
    LAS unsigned char* vl = lds + wid * AWAVE;
    LAS unsigned char* rl = lds + 8 * AWAVE + wid * 2048;
    const unsigned r_rd0 = (unsigned)((l16 >> 3) * 1024 + (l16 & 7) * 128 + ((g ^ (l16 & 7)) * 16)), r_rd1 = (unsigned)((l16 >> 3) * 1024 + (l16 & 7) * 128 + (((4 + g) ^ (l16 & 7)) * 16));
    const bf16_t* qlat = (const bf16_t*)(p.ws + WS_QLAT); const bf16_t* qall = (const bf16_t*)(p.ws + WS_QALL); const bf16_t* keys = (const bf16_t*)(p.ws + WS_KEYS);
    const unsigned short* sel = (const unsigned short*)(p.ws + WS_SEL); bf16_t* olat = (bf16_t*)(p.ws + WS_OLAT);
    const float cs = 0.07216878364870322f * 1.4426950408889634f;
    const float NEG = -1e30f;
    const unsigned a_rd0 = (unsigned)((l16 >> 3) * 1024 + (l16 & 7) * 128 + ((g ^ (l16 & 7)) * 16)), a_rd1 = (unsigned)((l16 >> 3) * 1024 + (l16 & 7) * 128 + (((4 + g) ^ (l16 & 7)) * 16));
    const int trow = g * 4 + ((lane & 15) >> 2), tp = lane & 3;
    unsigned tr_rdk[4];
#pragma unroll
    for (int k = 0; k < 4; ++k) tr_rdk[k] = (unsigned)((trow >> 3) * 1024 + (trow & 7) * 128 + (((2 * k + (tp >> 1)) ^ (trow & 7)) * 16) + (tp & 1) * 8);
    const int dr8 = lane >> 3, dpiece = ((lane & 7) ^ (lane >> 3)) * 16;
    for (int t = gw * 8; t < T_; t += nw * 8)
    for (int qi = 0; qi < 8; ++qi) {
        const int tq = t + qi; const int b = tq >> 11; const int nv_ = ((((tq & 2047) >> 6) + 1) * 64); const int cnt = nv_ < 256 ? nv_ : 256;
        bf16x8 qf[10];
#pragma unroll
        for (int ks = 0; ks < 8; ++ks) qf[ks] = *(const bf16x8*)(qlat + (size_t)tq * 4096 + l16 * 256 + ks * 32 + g * 8);
#pragma unroll
        for (int ks = 0; ks < 2; ++ks) qf[8 + ks] = *(const bf16x8*)(qall + (size_t)tq * 4096 + 2048 + l16 * 64 + ks * 32 + g * 8);
        f32x4 oacc[16];
#pragma unroll
        for (int rt = 0; rt < 16; ++rt) oacc[rt] = (f32x4){0.f, 0.f, 0.f, 0.f};
        float m = NEG, lsum = 0.f;
        const int nch = cnt >> 4;
        const unsigned short* selr = sel + (size_t)tq * 256;
        const bf16_t* kbase = keys + (size_t)(b * S_) * 320;
        int jr0 = selr[dr8], jr1 = selr[8 + dr8];
        { const char* s0 = (const char*)(kbase + (size_t)jr0 * 320) + dpiece; const char* s1 = (const char*)(kbase + (size_t)jr1 * 320) + dpiece;
#pragma unroll
          for (int lh = 0; lh < 5; ++lh) {
              LAS unsigned char* d = (lh < 4) ? vl + lh * 2048 : rl;
              __builtin_amdgcn_global_load_lds((const unsigned*)(s0 + lh * 128), (LAS unsigned*)(d), 16, 0, 0);
              __builtin_amdgcn_global_load_lds((const unsigned*)(s1 + lh * 128), (LAS unsigned*)(d + 1024), 16, 0, 0); } }
        jr0 = selr[16 + dr8]; jr1 = selr[24 + dr8];
        for (int c = 0; c < nch; ++c) {
            LAS unsigned char* buf = vl + (c & 1) * ABUF_BYTES;
            asm volatile("s_waitcnt vmcnt(0)" ::: "memory");
            const bf16x8 r0 = *(const LAS bf16x8*)(rl + r_rd0), r1 = *(const LAS bf16x8*)(rl + r_rd1);
            asm volatile("s_waitcnt lgkmcnt(0)" ::: "memory");
            if (c + 1 < nch) {
                LAS unsigned char* nb = vl + ((c + 1) & 1) * ABUF_BYTES;
                const char* s0 = (const char*)(kbase + (size_t)jr0 * 320) + dpiece; const char* s1 = (const char*)(kbase + (size_t)jr1 * 320) + dpiece;
#pragma unroll
                for (int lh = 0; lh < 5; ++lh) {
                    LAS unsigned char* d = (lh < 4) ? nb + lh * 2048 : rl;
                    __builtin_amdgcn_global_load_lds((const unsigned*)(s0 + lh * 128), (LAS unsigned*)(d), 16, 0, 0);
                    __builtin_amdgcn_global_load_lds((const unsigned*)(s1 + lh * 128), (LAS unsigned*)(d + 1024), 16, 0, 0); }
                const int cn = (c + 2 < 16) ? c + 2 : 15; jr0 = selr[cn * 16 + dr8]; jr1 = selr[cn * 16 + 8 + dr8];
            }
            f32x4 sv = (f32x4){0.f, 0.f, 0.f, 0.f};
#pragma unroll
            for (int ks = 0; ks < 8; ++ks) { const bf16x8 a = *(const LAS bf16x8*)(buf + (ks >> 1) * 2048 + ((ks & 1) ? a_rd1 : a_rd0)); sv = __builtin_amdgcn_mfma_f32_16x16x32_bf16(a, qf[ks], sv, 0, 0, 0); }
            sv = __builtin_amdgcn_mfma_f32_16x16x32_bf16(r0, qf[8], sv, 0, 0, 0); sv = __builtin_amdgcn_mfma_f32_16x16x32_bf16(r1, qf[9], sv, 0, 0, 0);
            float cmax = NEG;
#pragma unroll
            for (int i = 0; i < 4; ++i) { if (c * 16 + g * 4 + i >= cnt) sv[i] = NEG; cmax = fmaxf(cmax, sv[i]); }
            cmax = fmaxf(cmax, __shfl_xor(cmax, 16)); cmax = fmaxf(cmax, __shfl_xor(cmax, 32));
            if (__any((cmax - m) * cs > 6.f)) {
                const float mn = fmaxf(m, cmax); const float alpha = exp2f((m - mn) * cs); m = mn;
                lsum *= alpha;
#pragma unroll
                for (int rt = 0; rt < 16; ++rt) oacc[rt] *= alpha;
            }
            float ps = 0.f;
#pragma unroll
            for (int i = 0; i < 4; ++i) { sv[i] = exp2f((sv[i] - m) * cs); ps += sv[i]; }
            lsum += ps;
            u32x2 pfu; pfu[0] = cvt_pk_bf16(sv[0], sv[1]); pfu[1] = cvt_pk_bf16(sv[2], sv[3]);
            const bf16x4v pf = __builtin_bit_cast(bf16x4v, pfu);
            const unsigned tbb = (unsigned)(size_t)buf; const unsigned tb0 = tbb + tr_rdk[0], tb1 = tbb + tr_rdk[1], tb2 = tbb + tr_rdk[2], tb3 = tbb + tr_rdk[3];
#define TRG4(R4) { bf16x4v a0, a1, a2, a3; \
                asm volatile("ds_read_b64_tr_b16 %0, %4 offset:%8\n\tds_read_b64_tr_b16 %1, %5 offset:%8\n\tds_read_b64_tr_b16 %2, %6 offset:%8\n\tds_read_b64_tr_b16 %3, %7 offset:%8\n\ts_waitcnt lgkmcnt(0)" \
                             : "=&v"(a0), "=&v"(a1), "=&v"(a2), "=&v"(a3) \
                             : "v"(tb0), "v"(tb1), "v"(tb2), "v"(tb3), "i"((R4) * 2048) : "memory"); \
                oacc[(R4) * 4 + 0] = __builtin_amdgcn_mfma_f32_16x16x16bf16_1k(a0, pf, oacc[(R4) * 4 + 0], 0, 0, 0); \
                oacc[(R4) * 4 + 1] = __builtin_amdgcn_mfma_f32_16x16x16bf16_1k(a1, pf, oacc[(R4) * 4 + 1], 0, 0, 0); \
                oacc[(R4) * 4 + 2] = __builtin_amdgcn_mfma_f32_16x16x16bf16_1k(a2, pf, oacc[(R4) * 4 + 2], 0, 0, 0); \
                oacc[(R4) * 4 + 3] = __builtin_amdgcn_mfma_f32_16x16x16bf16_1k(a3, pf, oacc[(R4) * 4 + 3], 0, 0, 0); }
            TRG4(0) TRG4(1) TRG4(2) TRG4(3)
#undef TRG4
        }
        lsum += __shfl_xor(lsum, 16); lsum += __shfl_xor(lsum, 32);
        const float inv = 1.f / lsum;
#pragma unroll
        for (int rt = 0; rt < 16; ++rt) { const f32x4 o = oacc[rt] * inv; u32x2 pk; pk[0] = cvt_pk_bf16(o[0], o[1]); pk[1] = cvt_pk_bf16(o[2], o[3]); *(u32x2*)(olat + (size_t)tq * 4096 + l16 * 256 + rt * 16 + g * 4) = pk; }
    }
}

__device__ __forceinline__ void red8x2(float& x0, float& x1) {
    float y0, y1;
    asm volatile("s_nop 1\n\t"
                 "v_add_f32_dpp %0, %2, %2 quad_perm:[1,0,3,2] row_mask:0xf bank_mask:0xf\n\t"
                 "v_add_f32_dpp %1, %3, %3 quad_perm:[1,0,3,2] row_mask:0xf bank_mask:0xf\n\t"
                 "s_nop 0\n\t"
                 "v_add_f32_dpp %0, %0, %0 quad_perm:[2,3,0,1] row_mask:0xf bank_mask:0xf\n\t"
                 "v_add_f32_dpp %1, %1, %1 quad_perm:[2,3,0,1] row_mask:0xf bank_mask:0xf\n\t"
                 "s_nop 0\n\t"
                 "v_add_f32_dpp %0, %0, %0 row_half_mirror row_mask:0xf bank_mask:0xf\n\t"
                 "v_add_f32_dpp %1, %1, %1 row_half_mirror row_mask:0xf bank_mask:0xf\n\t"
                 "s_nop 0"
                 : "=&v"(y0), "=&v"(y1) : "v"(x0), "v"(x1));
    x0 = y0; x1 = y1;
}
constexpr int TC = 32;
typedef float f32x2 __attribute__((ext_vector_type(2)));
__device__ __forceinline__ void scan_phase(const Params& p, unsigned char* shm) {
    const int tid = otid(); const bool seq = tid < 256;
    float* bufs = (float*)shm;
    float* obuf = bufs + 2 * 6 * TC * 64;
    const bf16_t* rbuf = (const bf16_t*)(p.ws + WS_RBUF); const bf16_t* kbuf = (const bf16_t*)(p.ws + WS_KBUF); const bf16_t* vbuf = (const bf16_t*)(p.ws + WS_VBUF);
    const bf16_t* abuf = (const bf16_t*)(p.ws + WS_ABUF); const bf16_t* gbuf = (const bf16_t*)(p.ws + WS_GBUF); const float* wdec = (const float*)(p.ws + WS_WDEC);
    bf16_t* outb = (bf16_t*)(p.ws + WS_SCANOUT);
    const int nb_ = ogrid();
    for (int pair = obid(); pair < 256; pair += nb_) {
        const int b = pair >> 5, h = pair & 31;
        if (seq) {
            const int rp = tid >> 3, cgp = tid & 7;
            f32x2 A0[4], A1[4];
#pragma unroll
            for (int q = 0; q < 4; ++q) { A0[q] = (f32x2){0.f, 0.f}; A1[q] = (f32x2){0.f, 0.f}; }
            __syncthreads();
            for (int c = 0; c <= S_ / TC; ++c) {
                if (c < S_ / TC) {
                    const float* B = bufs + (c & 1) * 6 * TC * 64 + cgp * 8; float* ob = obuf + (c & 1) * TC * 64 + 2 * rp;
                    const float* Bv = bufs + (c & 1) * 6 * TC * 64 + 5 * TC * 64 + 2 * rp;
                    f32x4 xw0 = *(const f32x4*)(B), xw1 = *(const f32x4*)(B + 4), xn0 = *(const f32x4*)(B + TC * 64), xn1 = *(const f32x4*)(B + TC * 64 + 4);
                    f32x4 xb0 = *(const f32x4*)(B + 2 * TC * 64), xb1 = *(const f32x4*)(B + 2 * TC * 64 + 4), xk0 = *(const f32x4*)(B + 3 * TC * 64), xk1 = *(const f32x4*)(B + 3 * TC * 64 + 4);
                    f32x4 xr0 = *(const f32x4*)(B + 4 * TC * 64), xr1 = *(const f32x4*)(B + 4 * TC * 64 + 4); f32x2 xvv = *(const f32x2*)(Bv);
#pragma unroll 4
                    for (int s = 0; s < TC; ++s) {
                        const f32x4 w0 = xw0, w1 = xw1, n0 = xn0, n1 = xn1, b0 = xb0, b1 = xb1, k0 = xk0, k1 = xk1, r0 = xr0, r1 = xr1; const f32x2 vv = xvv;
                        { const float* Bs = B + (s + 1) * 64;
                          xw0 = *(const f32x4*)(Bs); xw1 = *(const f32x4*)(Bs + 4); xn0 = *(const f32x4*)(Bs + TC * 64); xn1 = *(const f32x4*)(Bs + TC * 64 + 4);
                          xb0 = *(const f32x4*)(Bs + 2 * TC * 64); xb1 = *(const f32x4*)(Bs + 2 * TC * 64 + 4); xk0 = *(const f32x4*)(Bs + 3 * TC * 64); xk1 = *(const f32x4*)(Bs + 3 * TC * 64 + 4);
                          xr0 = *(const f32x4*)(Bs + 4 * TC * 64); xr1 = *(const f32x4*)(Bs + 4 * TC * 64 + 4); xvv = *(const f32x2*)(Bv + (s + 1) * 64); }
                        const f32x2 wp[4] = {{w0[0], w0[1]}, {w0[2], w0[3]}, {w1[0], w1[1]}, {w1[2], w1[3]}};
                        const f32x2 np[4] = {{n0[0], n0[1]}, {n0[2], n0[3]}, {n1[0], n1[1]}, {n1[2], n1[3]}};
                        const f32x2 bp[4] = {{b0[0], b0[1]}, {b0[2], b0[3]}, {b1[0], b1[1]}, {b1[2], b1[3]}};
                        const f32x2 kp[4] = {{k0[0], k0[1]}, {k0[2], k0[3]}, {k1[0], k1[1]}, {k1[2], k1[3]}};
                        const f32x2 rq[4] = {{r0[0], r0[1]}, {r0[2], r0[3]}, {r1[0], r1[1]}, {r1[2], r1[3]}};
                        f32x2 t0 = A0[0] * np[0], t1 = A1[0] * np[0];
#pragma unroll
                        for (int q = 1; q < 4; ++q) { t0 = __builtin_elementwise_fma(A0[q], np[q], t0); t1 = __builtin_elementwise_fma(A1[q], np[q], t1); }
                        float sa0 = t0[0] + t0[1], sa1 = t1[0] + t1[1];
                        red8x2(sa0, sa1);
                        const f32x2 s0v = {sa0, sa0}, s1v = {sa1, sa1}, v0v = {vv[0], vv[0]}, v1v = {vv[1], vv[1]};
#pragma unroll
                        for (int q = 0; q < 4; ++q) { A0[q] = __builtin_elementwise_fma(v0v, kp[q], __builtin_elementwise_fma(s0v, bp[q], A0[q] * wp[q])); A1[q] = __builtin_elementwise_fma(v1v, kp[q], __builtin_elementwise_fma(s1v, bp[q], A1[q] * wp[q])); }
                        f32x2 u0 = A0[0] * rq[0], u1 = A1[0] * rq[0];
#pragma unroll
                        for (int q = 1; q < 4; ++q) { u0 = __builtin_elementwise_fma(A0[q], rq[q], u0); u1 = __builtin_elementwise_fma(A1[q], rq[q], u1); }
                        float o0 = u0[0] + u0[1], o1 = u1[0] + u1[1];
                        red8x2(o0, o1);
                        if (cgp == 0) *(f32x2*)(ob + s * 64) = (f32x2){o0, o1};
                    }
                }
                __syncthreads();
            }
        } else {
            const int ht = tid - 256; const int ss0 = ht >> 4, c4 = (ht & 15) * 4; const int ch = h * 64 + c4;
            const f32x4 w0v = *(const f32x4*)(p.in[23] + ch), a0v = *(const f32x4*)(p.in[26] + ch); const f32x4 kkv = *(const f32x4*)(p.in[31] + ch), kav = *(const f32x4*)(p.in[32] + ch), rkv = *(const f32x4*)(p.in[33] + ch), gng = *(const f32x4*)(p.in[34] + ch), gnb = *(const f32x4*)(p.in[35] + ch);
            for (int c = -1; c <= S_ / TC; ++c) {
                const bool do_post = (c >= 1), do_stage = (c + 1 < S_ / TC);
                u32x2 lr[2], lk[2], lv[2], la[2], lg[2]; f32x4 lw[2];
#pragma unroll
                for (int i = 0; i < 2; ++i) {
                    const int ss = ss0 + 16 * i;
                    if (do_stage) { const size_t off = (size_t)(b * S_ + (c + 1) * TC + ss) * D_ + ch; lr[i] = *(const u32x2*)(rbuf + off); lk[i] = *(const u32x2*)(kbuf + off); lv[i] = *(const u32x2*)(vbuf + off); la[i] = *(const u32x2*)(abuf + off); lw[i] = *(const f32x4*)(wdec + off); }
                    if (do_post) { const size_t off = (size_t)(b * S_ + (c - 1) * TC + ss) * D_ + ch; lg[i] = *(const u32x2*)(gbuf + off); }
                }
#pragma unroll
                for (int i = 0; i < 2; ++i) {
                    const int ss = ss0 + 16 * i; const int o = ss * 64 + c4;
                    float* B = bufs + ((c + 1) & 1) * 6 * TC * 64;
                    if (do_post) {
                        const float* obr = obuf + ((c - 1) & 1) * TC * 64;
                        const f32x4 ov = *(const f32x4*)(obr + o), km = *(const f32x4*)(B + 3 * TC * 64 + o), r = *(const f32x4*)(B + 4 * TC * 64 + o), v = *(const f32x4*)(B + 5 * TC * 64 + o);
                        float s1 = ov[0] + ov[1] + ov[2] + ov[3]; s1 = red16(s1); const float mean = s1 * (1.f / 64.f);
                        const f32x4 oc = ov - mean; float s2 = oc[0] * oc[0] + oc[1] * oc[1] + oc[2] * oc[2] + oc[3] * oc[3]; s2 = red16(s2); const float rs = rsqrtf(s2 * (1.f / 64.f) + 64e-5f);
                        const f32x4 rk = r * km * rkv; float bs = rk[0] + rk[1] + rk[2] + rk[3]; bs = red16(bs);
                        const size_t off = (size_t)(b * S_ + (c - 1) * TC + ss) * D_ + ch;
                        f32x4 gg; gg[0] = bf2f(lg[i][0] & 0xffffu); gg[1] = bf2f(lg[i][0] >> 16); gg[2] = bf2f(lg[i][1] & 0xffffu); gg[3] = bf2f(lg[i][1] >> 16);
                        const f32x4 y = (oc * rs * gng + gnb + v * bs) * gg;
                        u32x2 pk; pk[0] = cvt_pk_bf16(y[0], y[1]); pk[1] = cvt_pk_bf16(y[2], y[3]); *(u32x2*)(outb + off) = pk;
                    }
                    if (do_stage) {
                        f32x4 r, k, v, a, wv;
                        r[0] = bf2f(lr[i][0] & 0xffffu); r[1] = bf2f(lr[i][0] >> 16); r[2] = bf2f(lr[i][1] & 0xffffu); r[3] = bf2f(lr[i][1] >> 16);
                        k[0] = bf2f(lk[i][0] & 0xffffu); k[1] = bf2f(lk[i][0] >> 16); k[2] = bf2f(lk[i][1] & 0xffffu); k[3] = bf2f(lk[i][1] >> 16);
                        v[0] = bf2f(lv[i][0] & 0xffffu); v[1] = bf2f(lv[i][0] >> 16); v[2] = bf2f(lv[i][1] & 0xffffu); v[3] = bf2f(lv[i][1] >> 16);
                        a[0] = bf2f(la[i][0] & 0xffffu); a[1] = bf2f(la[i][0] >> 16); a[2] = bf2f(la[i][1] & 0xffffu); a[3] = bf2f(la[i][1] >> 16);
#pragma unroll
                        for (int e = 0; e < 4; ++e) { a[e] = sigmoidf_(a0v[e] + a[e]); const float z = -(w0v[e] + lw[i][e]); const float sp = fmaxf(z, 0.f) + __logf(1.f + __expf(-fabsf(z))); wv[e] = __expf(-__expf(-sp - 0.5f)); }
                        f32x4 kk = k * kkv; float n2 = kk[0] * kk[0] + kk[1] * kk[1] + kk[2] * kk[2] + kk[3] * kk[3]; n2 = red16(n2);
                        const float invn = 1.f / fmaxf(sqrtf(n2), 1e-12f); kk = kk * invn;
                        const f32x4 km = k * ((a - 1.f) * kav + 1.f);
                        *(f32x4*)(B + 0 * TC * 64 + o) = wv; *(f32x4*)(B + 1 * TC * 64 + o) = -kk; *(f32x4*)(B + 2 * TC * 64 + o) = kk * a; *(f32x4*)(B + 3 * TC * 64 + o) = km; *(f32x4*)(B + 4 * TC * 64 + o) = r; *(f32x4*)(B + 5 * TC * 64 + o) = v;
                    }
                }
                __syncthreads();
            }
        }
        __syncthreads();
    }
}

__global__ void __launch_bounds__(512, 2) mega(Params p) {
    extern __shared__ __attribute__((aligned(16))) unsigned char shm[];
    LAS unsigned char* lds = (LAS unsigned char*)shm;
    cg::grid_group grid = cg::this_grid();
    unsigned char* ws = p.ws;
    float* mod = (float*)(ws + WS_MOD); float* X = (float*)(ws + WS_X);
    volatile LAS unsigned* xst = (volatile LAS unsigned*)(lds + LDS_BYTES - 16);
    if (threadIdx.x == 0) { xst[0] = 0u; xst[1] = 0u; xst[2] = 0u; xst[3] = 0u; }
    __syncthreads();
    const XcdBarrier xb = xcd_barrier_post((unsigned*)(ws + WS_BAR + 4096), xst);
    p0_mod(p, shm); p0_rope(p); __syncthreads(); convert_jobs(p, shm, 0, NJOBS_EARLY, (unsigned*)(ws + WS_BAR) + 16);
    if (p.ws == nullptr) grid.sync();
    xcd_barrier(xb);
    if (threadIdx.x == 0) {
        bool ok = (gridDim.x == 256);
        for (int j = 0; j < 16; ++j) ok = ok && (xb_ld(&xb.bar[XB_XCNT(j)]) == (j < 8 ? 32u : 0u));
        if (!ok) xst[2] = 0xFFFFFFFFu;
    }
    __syncthreads();
    int vb; { const unsigned rk = xst[2], xc = xst[3]; vb = (gridDim.x == 256 && rk < 32u && xc < 8u) ? (int)(rk * 8u + xc) : (int)blockIdx.x; asm volatile("" : "+s"(vb)); }
    int vbx; { const unsigned rk = xst[2], xc = xst[3]; vbx = (gridDim.x == 256 && rk < 32u && xc < 8u) ? (int)(xc * 32u + rk) : (int)blockIdx.x; asm volatile("" : "+s"(vbx)); }
    norm_phase(vbx, p.in[0], mod + 0 * 2048, mod + 1 * 2048, (bf16_t*)(ws + WS_HMIX), nullptr, nullptr, shm);
    xcd_barrier(xb);
    { Epi<M_F32> E{}; E.o0 = ws + WS_PROJ; E.ldc = 1024; run_gemm<M_F32>(vb, lds, ws + WS_HMIX, 2048, ws + WS_WT_IN, 2048, T_, 1024, 2048, 0, E); }
    xcd_barrier(xb);
    projrow_phase(p);
    xcd_barrier(xb);
    { Epi<M_QROPE> E{}; E.o0 = ws + WS_QALL; E.ldc = 4096; E.f0 = (const float*)(ws + WS_COSA); E.f1 = (const float*)(ws + WS_SINA); E.f2 = (const float*)(ws + WS_COSI); E.f3 = (const float*)(ws + WS_SINI);
      run_gemm<M_QROPE>(vb, lds, ws + WS_CQ, 512, ws + WS_WT_Q, 512, T_, 4096, 512, 0, E); }
    xcd_barrier(xb);
    { Epi<M_BF16> E{}; E.o0 = ws + WS_QLAT; E.ldc = 4096; run_gemm<M_BF16>(vb, lds, ws + WS_QALL, 4096, ws + WS_WT_UK, 256, T_, 4096, 256, 1, E); }
    scoretopk_phase(p, shm, vbx);
    xcd_barrier(xb);
    attn_phase(p, lds, vbx);
    xcd_barrier(xb);
    { Epi<M_BF16> E{}; E.o0 = ws + WS_O; E.ldc = 2048; run_gemm<M_BF16>(vb, lds, ws + WS_OLAT, 4096, ws + WS_WT_UV, 512, T_, 2048, 512, 2, E); }
    xcd_barrier(xb);
    { Epi<M_RESID> E{}; E.o0 = X; E.f0 = p.in[0]; E.f1 = mod + 2 * 2048; run_gemm<M_RESID>(vb, lds, ws + WS_O, 2048, ws + WS_WT_O, 2048, T_, 2048, 2048, 0, E); }
    xcd_barrier(xb);
    norm_phase(vbx, X, mod + 3 * 2048, mod + 4 * 2048, (bf16_t*)(ws + WS_HFF), nullptr, nullptr, shm);
    xcd_barrier(xb);
    { Epi<M_RELU2> E{}; E.o0 = ws + WS_H1; E.ldc = 8192; run_gemm<M_RELU2>(vb, lds, ws + WS_HFF, 2048, ws + WS_WT_1_0, 2048, T_, 8192, 2048, 0, E); }
    xcd_barrier(xb);
    { Epi<M_RESID> E{}; E.o0 = X; E.f0 = X; E.f1 = mod + 5 * 2048; run_gemm<M_RESID>(vb, lds, ws + WS_H1, 8192, ws + WS_WT_2_0, 8192, T_, 2048, 8192, 0, E); }
    xcd_barrier(xb);
    const float* mod1 = mod + 8 * 12288;
    mix_phase(p, X, mod1 + 0 * 2048, mod1 + 1 * 2048, shm);
    xcd_barrier(xb);
    { Epi<M_L1A> E{}; E.o0 = ws + WS_KBUF; E.o1 = ws + WS_VBUF; E.o2 = ws + WS_MID; E.o3 = ws + WS_MID + 8 * MiB; E.o4 = ws + WS_MID + 16 * MiB;
      run_gemm<M_L1A>(vb, lds, ws + WS_MIX + 64 * MiB, 2048, (bf16_t*)(ws + WS_WT_RKV) + (size_t)2048 * 2048, 2048, T_, 4864, 2048, 3, E); }
    xcd_barrier(xb);
    { Epi<M_BF16> E{}; E.o0 = ws + WS_RBUF; E.ldc = 2048; run_gemm<M_BF16>(vb, lds, ws + WS_MIX, 2048, ws + WS_WT_RKV, 2048, T_, 2048, 2048, 0, E); }
    { Epi<M_F32> E{}; E.o0 = ws + WS_WDEC; E.ldc = 2048; run_gemm<M_F32>(vb, lds, ws + WS_MID, 256, ws + WS_WT_L2, 256, T_, 2048, 256, 0, E); }
    { Epi<M_BF16> E{}; E.o0 = ws + WS_ABUF; E.ldc = 2048; run_gemm<M_BF16>(vb, lds, ws + WS_MID + 8 * MiB, 256, (bf16_t*)(ws + WS_WT_L2) + (size_t)2048 * 256, 256, T_, 2048, 256, 0, E); }
    { Epi<M_BF16> E{}; E.o0 = ws + WS_GBUF; E.ldc = 2048; run_gemm<M_BF16>(vb, lds, ws + WS_MID + 16 * MiB, 256, (bf16_t*)(ws + WS_WT_L2) + (size_t)4096 * 256, 256, T_, 2048, 256, 0, E); }
    xcd_barrier(xb);
    scan_phase(p, shm);
    xcd_barrier(xb);
    { Epi<M_RESID> E{}; E.o0 = X; E.f0 = X; E.f1 = mod1 + 2 * 2048; run_gemm<M_RESID>(vb, lds, ws + WS_SCANOUT, 2048, ws + WS_WT_BO, 2048, T_, 2048, 2048, 0, E); }
    xcd_barrier(xb);
    norm_phase(vbx, X, mod1 + 3 * 2048, mod1 + 4 * 2048, (bf16_t*)(ws + WS_HFF), nullptr, nullptr, shm);
    __syncthreads(); convert_jobs(p, shm, NJOBS_EARLY, NJOBS_ALL, (unsigned*)(ws + WS_BAR) + 32);
    xcd_barrier(xb);
    { Epi<M_RELU2> E{}; E.o0 = ws + WS_H1; E.ldc = 8192; run_gemm<M_RELU2>(vb, lds, ws + WS_HFF, 2048, ws + WS_WT_1_1, 2048, T_, 8192, 2048, 0, E); }
    xcd_barrier(xb);
    { Epi<M_RESID> E{}; E.o0 = X; E.f0 = X; E.f1 = mod1 + 5 * 2048; run_gemm<M_RESID>(vb, lds, ws + WS_H1, 8192, ws + WS_WT_2_1, 8192, T_, 2048, 8192, 0, E); }
    xcd_barrier(xb);
    norm_phase(vbx, X, nullptr, nullptr, nullptr, p.out, p.in[7], shm);
}

extern "C" void kernel_launch(void* const* d_in, const int* in_sizes, int n_in, void* d_out, int out_size, void* d_ws, size_t ws_size, hipStream_t stream) {
    static int grid = 0;
    if (grid == 0) {
        int dev = 0, cus = 0, per_cu = 0;
        hipGetDevice(&dev); hipDeviceGetAttribute(&cus, hipDeviceAttributeMultiprocessorCount, dev);
        if (hipFuncSetAttribute((const void*)mega, hipFuncAttributeMaxDynamicSharedMemorySize, LDS_BYTES) != hipSuccess) fprintf(stderr, "hipFuncSetAttribute failed\n");
        hipOccupancyMaxActiveBlocksPerMultiprocessor(&per_cu, (const void*)mega, 512, LDS_BYTES);
        if (per_cu < 1) per_cu = 1;
        grid = cus * 1;
        (void)hipGetLastError();
    }
    Params p{};
    for (int i = 0; i < 36; ++i) p.in[i] = (const float*)d_in[i];
    p.out = (float*)d_out; p.ws = (unsigned char*)d_ws;
    (void)hipMemsetAsync((unsigned char*)d_ws + WS_BAR, 0, 32768, stream);
    void* args[] = {&p};
    hipError_t e = hipLaunchCooperativeKernel((const void*)mega, dim3(grid), dim3(512), args, LDS_BYTES, stream);
    if (e != hipSuccess) fprintf(stderr, "cooperative launch failed: %s (grid %d)\n", hipGetErrorString(e), grid);
}
```
